# Optimizing an MI355X kernel written in HIP

```python
import math
import jax, jax.numpy as jnp
from jax import lax
import numpy as np

D_MODEL = 1024
BATCH = 8
SEQ = 8192
DEPTH = 1

SSM_GROUP_SIZE = 16
SSM_GROUPS = 32
SSM_WIDTH = SSM_GROUP_SIZE * SSM_GROUPS
SSM_STATE = 64
SSM_CHUNK = 128
SSM_DT_MIN = 1e-3
SSM_DT_MAX = 1e-1
ATTN_PATTERNS = ((128, 1), (512, 4), (2048, 16))
ATTN_HEADS_PER_GROUP = 4
ATTN_HEAD_DIM = 64
ATTN_HEADS = ATTN_HEADS_PER_GROUP * len(ATTN_PATTERNS)
ATTN_WIDTH = ATTN_HEADS * ATTN_HEAD_DIM
ATTN_OUT_WIDTH = ATTN_HEADS_PER_GROUP * ATTN_HEAD_DIM
MEM_LEN = 256
MEM_HEADS = 4
MEM_HEAD_DIM = 128
MEM_WIDTH = MEM_HEADS * MEM_HEAD_DIM
N_BRANCHES = 3
D_FF = 4 * D_MODEL
IN_SPLITS = (SSM_WIDTH, ATTN_WIDTH, ATTN_WIDTH, ATTN_WIDTH, MEM_WIDTH, N_BRANCHES * D_MODEL)
IN_WIDTH = sum(IN_SPLITS)
IN_OFFSETS = tuple(int(o) for o in np.cumsum(IN_SPLITS)[:-1])
RMS_EPS = 1e-6
NEG_INF = -1e30

kernel_name = "hybrid_s5_dilated_attn_memory_gated_block"


def rms_norm(x, g):
    xf = x.astype(jnp.float32)
    y = xf * lax.rsqrt(jnp.mean(xf * xf, axis=-1, keepdims=True) + RMS_EPS)
    return (y * g.astype(jnp.float32)).astype(x.dtype)


def _complex_affine_combine(e1, e2):
    a1r, a1i, b1r, b1i = e1
    a2r, a2i, b2r, b2i = e2
    ar = a2r * a1r - a2i * a1i
    ai = a2r * a1i + a2i * a1r
    br = a2r * b1r - a2i * b1i + b2r
    bi = a2r * b1i + a2i * b1r + b2i
    return ar, ai, br, bi


def s5_ssm(u, lam_re, lam_im, log_dt, b_re, b_im, c_re, c_im, d_skip):
    f32 = jnp.float32
    bsz, l, _ = u.shape
    n_chunks = l // SSM_CHUNK
    u = u.astype(f32).reshape(bsz, n_chunks, SSM_CHUNK, SSM_GROUPS, SSM_GROUP_SIZE)
    u = u.transpose(1, 0, 2, 3, 4)
    lr, li = lam_re.astype(f32), lam_im.astype(f32)
    dt = jnp.exp(log_dt.astype(f32))[:, None]
    mag = jnp.exp(lr * dt)
    a_re, a_im = mag * jnp.cos(li * dt), mag * jnp.sin(li * dt)
    nr, ni = a_re - 1.0, a_im
    den = lr * lr + li * li
    coef_re = (nr * lr + ni * li) / den
    coef_im = (ni * lr - nr * li) / den
    br_, bi_ = b_re.astype(f32), b_im.astype(f32)
    bb_re = coef_re[..., None] * br_ - coef_im[..., None] * bi_
    bb_im = coef_re[..., None] * bi_ + coef_im[..., None] * br_
    cr, ci = c_re.astype(f32), c_im.astype(f32)
    dd = d_skip.astype(f32)

    def chunk_step(carry, u_c):
        s_re0, s_im0 = carry
        bu_re = jnp.einsum('bcgh,gph->bcgp', u_c, bb_re)
        bu_im = jnp.einsum('bcgh,gph->bcgp', u_c, bb_im)
        ar = jnp.broadcast_to(a_re, bu_re.shape)
        ai = jnp.broadcast_to(a_im, bu_re.shape)
        pr, pi, hr, hi = lax.associative_scan(_complex_affine_combine, (ar, ai, bu_re, bu_im), axis=1)
        s_re = hr + pr * s_re0[:, None] - pi * s_im0[:, None]
        s_im = hi + pr * s_im0[:, None] + pi * s_re0[:, None]
        y = (jnp.einsum('bcgp,ghp->bcgh', s_re, cr)
             - jnp.einsum('bcgp,ghp->bcgh', s_im, ci)
             + dd * u_c)
        return (s_re[:, -1], s_im[:, -1]), y

    init = (jnp.zeros((bsz, SSM_GROUPS, SSM_STATE), f32), jnp.zeros((bsz, SSM_GROUPS, SSM_STATE), f32))
    _, y = lax.scan(chunk_step, init, u)
    return y.transpose(1, 0, 2, 3, 4).reshape(bsz, l, SSM_WIDTH)


def dilated_window_attention(q, k, v, window, dilation):
    f32 = jnp.float32
    b, l, h, e = q.shape
    w = window // dilation
    m = l // dilation
    nb = -(-m // w)
    mp = nb * w

    def to_sub(t):
        t = t.reshape(b, m, dilation, h, e).transpose(0, 2, 3, 1, 4)
        t = jnp.pad(t, ((0, 0), (0, 0), (0, 0), (0, mp - m), (0, 0)))
        return t.reshape(b, dilation, h, nb, w, e)

    def with_prev(t):
        prev = jnp.pad(t, ((0, 0), (0, 0), (0, 0), (1, 0), (0, 0), (0, 0)))[:, :, :, :-1]
        return jnp.concatenate([prev, t], axis=4)

    qs, ks, vs = to_sub(q), to_sub(k), to_sub(v)
    kb, vb = with_prev(ks), with_prev(vs)
    s = jnp.einsum('bdhnqe,bdhnke->bdhnqk', qs, kb).astype(f32) * (e ** -0.5)
    qi = jnp.arange(w)[:, None]
    kj = jnp.arange(2 * w)[None, :]
    dist = w + qi - kj
    blk = jnp.arange(nb)[:, None, None]
    valid = (dist >= 0) & (dist <= w) & ((blk > 0) | (kj >= w))
    s = jnp.where(valid, s, NEG_INF)
    mx = jnp.max(s, axis=-1, keepdims=True)
    p = jnp.exp(s - mx)
    den = jnp.sum(p, axis=-1)
    o = jnp.einsum('bdhnqk,bdhnke->bdhnqe', p, vb.astype(f32)) / den[..., None]
    lse = mx[..., 0] + jnp.log(den)
    o = o.reshape(b, dilation, h, mp, e)[:, :, :, :m].transpose(0, 3, 1, 2, 4).reshape(b, l, h, e)
    lse = lse.reshape(b, dilation, h, mp)[..., :m].transpose(0, 3, 1, 2).reshape(b, l, h)
    return o, lse


def memory_cross_attention(q, k, v):
    b, l, hm, e = q.shape
    s = jnp.einsum('blhe,bmhe->bhlm', q, k).astype(jnp.float32) * (e ** -0.5)
    p = jax.nn.softmax(s, axis=-1)
    o = jnp.einsum('bhlm,bmhe->blhe', p, v.astype(jnp.float32))
    return o.astype(q.dtype).reshape(b, l, hm * e)


def setup_inputs(seed: int = 0) -> dict:
    key = jax.random.key(seed)
    ks = jax.random.split(key, 26)
    f32 = jnp.float32

    def nrm(k, shape, scale):
        return jax.random.normal(k, shape, f32) * scale

    G, P, H = SSM_GROUPS, SSM_STATE, SSM_GROUP_SIZE
    return {
        "x": nrm(ks[0], (BATCH, SEQ, D_MODEL), 1.0),
        "mem": nrm(ks[1], (BATCH, MEM_LEN, D_MODEL), 1.0),
        "norm1_g": 1.0 + nrm(ks[2], (DEPTH, D_MODEL), 0.02),
        "mem_norm_g": 1.0 + nrm(ks[3], (DEPTH, D_MODEL), 0.02),
        "w_in": nrm(ks[4], (DEPTH, D_MODEL, IN_WIDTH), D_MODEL ** -0.5),
        "b_gate": nrm(ks[5], (DEPTH, N_BRANCHES * D_MODEL), 0.02),
        "ssm_lambda_re": -0.5 + nrm(ks[6], (DEPTH, G, P), 0.01),
        "ssm_lambda_im": math.pi * jnp.arange(P, dtype=f32) + nrm(ks[7], (DEPTH, G, P), 0.01),
        "ssm_log_dt": jax.random.uniform(ks[8], (DEPTH, G), f32, math.log(SSM_DT_MIN), math.log(SSM_DT_MAX)),
        "ssm_b_re": nrm(ks[9], (DEPTH, G, P, H), (2 * H) ** -0.5),
        "ssm_b_im": nrm(ks[10], (DEPTH, G, P, H), (2 * H) ** -0.5),
        "ssm_c_re": nrm(ks[11], (DEPTH, G, H, P), P ** -0.5),
        "ssm_c_im": nrm(ks[12], (DEPTH, G, H, P), P ** -0.5),
        "ssm_d": nrm(ks[13], (DEPTH, G, H), 1.0),
        "w_glu": nrm(ks[14], (DEPTH, SSM_WIDTH, SSM_WIDTH), SSM_WIDTH ** -0.5),
        "b_glu": nrm(ks[15], (DEPTH, SSM_WIDTH), 0.02),
        "w_ssm_br": nrm(ks[16], (DEPTH, SSM_WIDTH, D_MODEL), SSM_WIDTH ** -0.5),
        "w_attn_br": nrm(ks[17], (DEPTH, ATTN_OUT_WIDTH, D_MODEL), ATTN_OUT_WIDTH ** -0.5),
        "w_mem_kv": nrm(ks[18], (DEPTH, D_MODEL, 2 * MEM_WIDTH), D_MODEL ** -0.5),
        "w_mem_br": nrm(ks[19], (DEPTH, MEM_WIDTH, D_MODEL), MEM_WIDTH ** -0.5),
        "w_o": nrm(ks[20], (DEPTH, D_MODEL, D_MODEL), D_MODEL ** -0.5),
        "norm2_g": 1.0 + nrm(ks[21], (DEPTH, D_MODEL), 0.02),
        "w_up": nrm(ks[22], (DEPTH, D_MODEL, D_FF), D_MODEL ** -0.5),
        "w_down": nrm(ks[23], (DEPTH, D_FF, D_MODEL), D_FF ** -0.5),
        "final_g": 1.0 + nrm(ks[24], (D_MODEL,), 0.02),
    }


def reference(x, mem, norm1_g, mem_norm_g, w_in, b_gate, ssm_lambda_re, ssm_lambda_im, ssm_log_dt,
              ssm_b_re, ssm_b_im, ssm_c_re, ssm_c_im, ssm_d, w_glu, b_glu, w_ssm_br, w_attn_br,
              w_mem_kv, w_mem_br, w_o, norm2_g, w_up, w_down, final_g):
    bsz, seq, _ = x.shape
    h = x
    for i in range(DEPTH):
        n = rms_norm(h, norm1_g[i])
        z = n @ w_in[i]
        u, q, k, v, mq, zg = jnp.split(z, IN_OFFSETS, axis=-1)
        gates = jax.nn.sigmoid(zg + b_gate[i]).reshape(bsz, seq, N_BRANCHES, D_MODEL)

        y = s5_ssm(u, ssm_lambda_re[i], ssm_lambda_im[i], ssm_log_dt[i], ssm_b_re[i], ssm_b_im[i],
                   ssm_c_re[i], ssm_c_im[i], ssm_d[i]).astype(x.dtype)
        y = jax.nn.gelu(y)
        y = y * jax.nn.sigmoid(y @ w_glu[i] + b_glu[i])
        br_ssm = y @ w_ssm_br[i]

        q = q.reshape(bsz, seq, ATTN_HEADS, ATTN_HEAD_DIM)
        k = k.reshape(bsz, seq, ATTN_HEADS, ATTN_HEAD_DIM)
        v = v.reshape(bsz, seq, ATTN_HEADS, ATTN_HEAD_DIM)
        outs, lses = [], []
        for g, (window, dilation) in enumerate(ATTN_PATTERNS):
            sl = slice(g * ATTN_HEADS_PER_GROUP, (g + 1) * ATTN_HEADS_PER_GROUP)
            o_g, lse_g = dilated_window_attention(q[:, :, sl], k[:, :, sl], v[:, :, sl], window, dilation)
            outs.append(o_g)
            lses.append(lse_g)
        wts = jax.nn.softmax(jnp.stack(lses, axis=0), axis=0)
        o = jnp.sum(wts[..., None] * jnp.stack(outs, axis=0), axis=0)
        br_attn = o.astype(x.dtype).reshape(bsz, seq, ATTN_OUT_WIDTH) @ w_attn_br[i]

        kv = rms_norm(mem, mem_norm_g[i]) @ w_mem_kv[i]
        mk, mv = jnp.split(kv, 2, axis=-1)
        mk = mk.reshape(bsz, MEM_LEN, MEM_HEADS, MEM_HEAD_DIM)
        mv = mv.reshape(bsz, MEM_LEN, MEM_HEADS, MEM_HEAD_DIM)
        mq = mq.reshape(bsz, seq, MEM_HEADS, MEM_HEAD_DIM)
        br_mem = memory_cross_attention(mq, mk, mv) @ w_mem_br[i]

        merged = gates[:, :, 0] * br_ssm + gates[:, :, 1] * br_attn + gates[:, :, 2] * br_mem
        h = h + merged @ w_o[i]

        n2 = rms_norm(h, norm2_g[i])
        h = h + jnp.square(jax.nn.relu(n2 @ w_up[i])) @ w_down[i]
    return rms_norm(h, final_g)
```

```cpp
#include <hip/hip_runtime.h>
#include <hip/hip_cooperative_groups.h>
#include <cstdio>
#include <cstdint>
namespace cg = cooperative_groups;

#define DBG_PH 0
#define DBG_SEGS da.s[0] = {WS_GATES, 12u << 20, 0}; da.s[1] = {WS_OG, 12u << 20, 0}; da.s[2] = {WS_MQ, 12u << 20, 0}; da.s[3] = {WS_YG, 8u << 20, 0}; da.s[4] = {WS_OMRG, 8u << 20, 0}; da.s[5] = {WS_MG, 12u << 20, 0};
#ifndef PROBE_G7
#define PROBE_G7 1
#endif
#ifndef PROBE_REP
#define PROBE_REP 1
#define PROBE_P3 1
#endif
#ifndef MK_N_LAUNCHES
#define MK_N_LAUNCHES 1
#endif

namespace pg8 {
#define PG8_LAS __attribute__((address_space(3)))
typedef unsigned short bf16_t;
typedef short bf16x8 __attribute__((ext_vector_type(8)));
typedef float f32x4 __attribute__((ext_vector_type(4)));
typedef unsigned u32x4 __attribute__((ext_vector_type(4)));
constexpr int BM = 256, BK = 64, HALF = 128, HTB = HALF * BK * 2, STAGE_BYTES = 8 * HTB, NXCD = 8, WGM = 8;

__host__ __device__ __forceinline__ int lds_byte(int r, int c) { const int st = (r >> 4) * 2 + (c >> 5), rr = r & 15, cc = c & 31, ob = rr * 64 + cc * 2; return st * 1024 + (ob ^ (((ob >> 9) & 1) << 5)); }
__host__ __device__ __forceinline__ void stage_rc(int b, int& R, int& C) { const int st = b / 1024, sb = b % 1024, swz = sb ^ (((sb >> 9) & 1) << 5); R = (st >> 1) * 16 + swz / 64; C = (st & 1) * 32 + (swz % 64) / 2; }
__host__ __device__ __forceinline__ int perm32(int rho) { const int n = rho >> 4, i = rho & 15; return 8 * (i >> 2) + 4 * n + (i & 3); }

struct Unit { int pm, pn; };
struct Gemm { const bf16_t* A; const bf16_t* Bt; int M, N, K; int lda, ldb; int wid; };
template <int DIL> __device__ __forceinline__ size_t dil_tile_row(int t) {
    if (DIL == 0) return (size_t)t * 256;
    constexpr int Ld = DIL ? 8192 / DIL : 1; const int b = t >> 5, pp0 = (t & 31) * 256, r = pp0 / Ld, j0 = pp0 % Ld;
    return (size_t)b * 8192 + (size_t)j0 * DIL + r;
}
template <int ADIL> __device__ __forceinline__ const char* a_tile(const Gemm& g, int pm) { return (const char*)g.A + dil_tile_row<ADIL>(pm) * (size_t)(ADIL ? 1024 : g.lda) * 2; }
template <int BDIL> __device__ __forceinline__ const char* b_tile(const Gemm& g, int pn) { return (const char*)g.Bt + dil_tile_row<BDIL>(pn) * (size_t)(BDIL ? 1024 : g.ldb) * 2; }

struct StaticOrder {
    int nM, nN, nwg, G, c;
    __host__ __device__ void init(int M, int N, int G_, int c_) { nM = M / BM; nN = N / BM; nwg = nM * nN; G = G_; c = c_; }
    __host__ __device__ bool next(int i, Unit& u) const {
        const long L = (long)i * G + c; if (L >= nwg) return false;
        int wgid = (int)L; { const int q = nwg / NXCD, r = nwg % NXCD, xcd = wgid % NXCD, off = wgid / NXCD; wgid = (xcd < r ? xcd * (q + 1) : r * (q + 1) + (xcd - r) * q) + off; }
        const int nig = WGM * nN, gid = wgid / nig, fm = gid * WGM, gsz = (nM - fm) < WGM ? (nM - fm) : WGM;
        u.pm = fm + ((wgid % nig) % gsz); u.pn = (wgid % nig) / gsz; return true;
    }
};

typedef float f32x2_ __attribute__((ext_vector_type(2))); typedef __bf16 bf16x2_ __attribute__((ext_vector_type(2)));
__device__ __forceinline__ unsigned cvt_pk_bf16(float lo, float hi) { f32x2_ v = {lo, hi}; bf16x2_ b = __builtin_convertvector(v, bf16x2_); return __builtin_bit_cast(unsigned, b); }
__device__ __forceinline__ float bf_lo(unsigned w) { return __builtin_bit_cast(float, w << 16); }
__device__ __forceinline__ float bf_hi(unsigned w) { return __builtin_bit_cast(float, w & 0xffff0000u); }
__device__ __forceinline__ u32x4 pack8(const f32x4 v0, const f32x4 v1) { u32x4 w; w.x = cvt_pk_bf16(v0[0], v0[1]); w.y = cvt_pk_bf16(v0[2], v0[3]); w.z = cvt_pk_bf16(v1[0], v1[1]); w.w = cvt_pk_bf16(v1[2], v1[3]); return w; }
__device__ __forceinline__ void unpack8(const u32x4 w, f32x4& v0, f32x4& v1) { v0 = (f32x4){bf_lo(w.x), bf_hi(w.x), bf_lo(w.y), bf_hi(w.y)}; v1 = (f32x4){bf_lo(w.z), bf_hi(w.z), bf_lo(w.w), bf_hi(w.w)}; }
__device__ __forceinline__ float sigm(float x) { return __builtin_amdgcn_rcpf(1.f + __builtin_amdgcn_exp2f(-1.4426950408889634f * x)); }

#define EPI_LOOP _Pragma("unroll") for (int ai = 0; ai < 2; ++ai) _Pragma("unroll") for (int m = 0; m < 4; ++m) _Pragma("unroll") for (int bj = 0; bj < 2; ++bj)
#define EPI_ROW (u.pm * 256 + ai * 128 + wr * 64 + m * 16 + fr)
#define EPI_COL (u.pn * 256 + bj * 128 + wc * 32 + 8 * fq)
typedef f32x4 AccT[2][2][4][2];

struct EpiPlain {
    bf16_t* O; size_t ldc;
    __device__ __forceinline__ void operator()(const AccT& acc, const Unit& u, int wr, int wc, int fr, int fq) const {
        EPI_LOOP { const int row = EPI_ROW, col = EPI_COL; *(u32x4*)(O + (size_t)row * ldc + col) = pack8(acc[ai][bj][m][0], acc[ai][bj][m][1]); }
    }
};
struct EpiVTf {
    bf16_t* O; int mem; int g;
    __device__ __forceinline__ void operator()(const AccT& acc, const Unit& u, int wr, int wc, int fr, int fq) const {
        EPI_LOOP { const int row = EPI_ROW, col = EPI_COL;
            int e, kk; size_t tb;
            if (mem) { const int h = row >> 7, b = col >> 8; e = row & 127; kk = col & 255; tb = ((size_t)((b * 4 + h) * 8 + (kk >> 5))) * 4096; }
            else { const int hh = row >> 6, b = col >> 13; e = row & 63; kk = col & 8191; tb = (((size_t)(g * 8 + b) * 4 + hh) * 8192) * 64 + (size_t)(kk >> 5) * 2048; }
            const int t = e >> 5, c = e & 31, k0 = kk & 31, s2 = k0 >> 4, half = (k0 >> 3) & 1;
            bf16_t* d0 = O + tb + (((t * 2 + s2) * 2 + 0) * 32 + c) * 8 + half * 4;
            const f32x4 v0 = acc[ai][bj][m][0], v1 = acc[ai][bj][m][1];
            typedef unsigned u32x2 __attribute__((ext_vector_type(2)));
            u32x2 w0, w1; w0.x = cvt_pk_bf16(v0[0], v0[1]); w0.y = cvt_pk_bf16(v0[2], v0[3]); w1.x = cvt_pk_bf16(v1[0], v1[1]); w1.y = cvt_pk_bf16(v1[2], v1[3]);
            *(u32x2*)d0 = w0; *(u32x2*)(d0 + 256) = w1; }
    }
};
struct EpiMKf {
    bf16_t* O;
    __device__ __forceinline__ void operator()(const AccT& acc, const Unit& u, int wr, int wc, int fr, int fq) const {
        EPI_LOOP { const int row = EPI_ROW, col = EPI_COL; const int b = row >> 8, key = row & 255, h = col >> 7, e = col & 127;
            *(u32x4*)(O + ((size_t)((b * 4 + h) * 8 + (key >> 5))) * 4096 + (((e >> 4) * 2 + ((e >> 3) & 1)) * 32 + (key & 31)) * 8) = pack8(acc[ai][bj][m][0], acc[ai][bj][m][1]); }
    }
};
struct EpiMain {
    bf16_t *U, *MQ, *GATES; const float* b_gate;
    __device__ __forceinline__ void operator()(const AccT& acc, const Unit& u, int wr, int wc, int fr, int fq) const {
        const int pn = u.pn;
        if (pn < 2) { EPI_LOOP { const int row = EPI_ROW, col = EPI_COL; *(u32x4*)(U + (size_t)row * 512 + col) = pack8(acc[ai][bj][m][0], acc[ai][bj][m][1]); } }
        else if (pn < 4) { EPI_LOOP { const int row = EPI_ROW, col = EPI_COL - 512; *(u32x4*)(MQ + (size_t)row * 512 + col) = pack8(acc[ai][bj][m][0], acc[ai][bj][m][1]); } }
        else {
            f32x4 bb0[2], bb1[2];
#pragma unroll
            for (int bj = 0; bj < 2; ++bj) { const int col = EPI_COL - 1024; bb0[bj] = *(const f32x4*)(b_gate + col); bb1[bj] = *(const f32x4*)(b_gate + col + 4); }
            EPI_LOOP { const int row = EPI_ROW, col = EPI_COL - 1024;
                f32x4 v0 = acc[ai][bj][m][0] + bb0[bj], v1 = acc[ai][bj][m][1] + bb1[bj];
#pragma unroll
                for (int i = 0; i < 4; ++i) { v0[i] = sigm(v0[i]); v1[i] = sigm(v1[i]); }
                *(u32x4*)(GATES + (size_t)row * 3072 + col) = pack8(v0, v1); }
        }
    }
};
struct EpiQK {
    bf16_t *Q, *Kb; int g;
    __device__ __forceinline__ void operator()(const AccT& acc, const Unit& u, int wr, int wc, int fr, int fq) const {
        const bool isk = (u.pn == 1); bf16_t* base = isk ? Kb : Q;
        EPI_LOOP { const int row = EPI_ROW, colw = bj * 128 + wc * 32 + 8 * fq; const int hh = colw >> 6, e = colw & 63, b = row >> 13, pp = row & 8191;
            const size_t hbase = (((size_t)(g * 8 + b) * 4 + hh) * 8192) * 64;
            const size_t off = isk ? hbase + (size_t)(pp >> 5) * 2048 + ((((e >> 4) * 2 + ((e >> 3) & 1)) * 32 + (pp & 31)) * 8) : hbase + (size_t)pp * 64 + e;
            *(u32x4*)(base + off) = pack8(acc[ai][bj][m][0], acc[ai][bj][m][1]); }
    }
};
struct EpiGlu {
    const bf16_t* YG; bf16_t* Y2; const float* b;
    __device__ __forceinline__ void operator()(const AccT& acc, const Unit& u, int wr, int wc, int fr, int fq) const {
        f32x4 bb0[2], bb1[2];
#pragma unroll
        for (int bj = 0; bj < 2; ++bj) { const int col = EPI_COL; bb0[bj] = *(const f32x4*)(b + col); bb1[bj] = *(const f32x4*)(b + col + 4); }
#pragma unroll
        for (int ai = 0; ai < 2; ++ai) {
            u32x4 yv[4][2];
#pragma unroll
            for (int m = 0; m < 4; ++m)
#pragma unroll
                for (int bj = 0; bj < 2; ++bj) { const int row = EPI_ROW, col = EPI_COL; yv[m][bj] = *(const u32x4*)(YG + (size_t)row * 512 + col); }
#pragma unroll
            for (int m = 0; m < 4; ++m)
#pragma unroll
                for (int bj = 0; bj < 2; ++bj) { const int row = EPI_ROW, col = EPI_COL;
                    f32x4 y0, y1; unpack8(yv[m][bj], y0, y1);
                    f32x4 v0 = acc[ai][bj][m][0] + bb0[bj], v1 = acc[ai][bj][m][1] + bb1[bj];
#pragma unroll
                    for (int i = 0; i < 4; ++i) { v0[i] = y0[i] * sigm(v0[i]); v1[i] = y1[i] * sigm(v1[i]); }
                    *(u32x4*)(Y2 + (size_t)row * 512 + col) = pack8(v0, v1); }
        }
    }
};
template <int MODE> struct EpiBranch {
    const bf16_t* GATES; bf16_t* MG; int goff;
    __device__ __forceinline__ void operator()(const AccT& acc, const Unit& u, int wr, int wc, int fr, int fq) const {
#pragma unroll
        for (int ai = 0; ai < 2; ++ai) {
            u32x4 gv[4][2], pv[4][2];
#pragma unroll
            for (int m = 0; m < 4; ++m)
#pragma unroll
                for (int bj = 0; bj < 2; ++bj) { const int row = EPI_ROW, col = EPI_COL; gv[m][bj] = *(const u32x4*)(GATES + (size_t)row * 3072 + goff + col);
                    if (MODE == 1) pv[m][bj] = *(const u32x4*)(MG + (size_t)row * 1024 + col); }
#pragma unroll
            for (int m = 0; m < 4; ++m)
#pragma unroll
                for (int bj = 0; bj < 2; ++bj) { const int row = EPI_ROW, col = EPI_COL; f32x4 g0, g1; unpack8(gv[m][bj], g0, g1);
                    f32x4 v0 = acc[ai][bj][m][0] * g0, v1 = acc[ai][bj][m][1] * g1;
                    if (MODE == 1) { f32x4 p0, p1; unpack8(pv[m][bj], p0, p1); v0 += p0; v1 += p1; }
                    *(u32x4*)(MG + (size_t)row * 1024 + col) = pack8(v0, v1); }
        }
    }
};
template <int MODE> struct EpiResid {
    const float* X; bf16_t* HB; float* SS;
    __device__ __forceinline__ void operator()(const AccT& acc, const Unit& u, int wr, int wc, int fr, int fq) const {
#pragma unroll
        for (int ai = 0; ai < 2; ++ai) {
            f32x4 ra[4][2], rb[4][2]; u32x4 hv[4][2];
#pragma unroll
            for (int m = 0; m < 4; ++m)
#pragma unroll
                for (int bj = 0; bj < 2; ++bj) { const int row = EPI_ROW, col = EPI_COL; const size_t o = (size_t)row * 1024 + col;
                    if (MODE == 0) { ra[m][bj] = *(const f32x4*)(X + o); rb[m][bj] = *(const f32x4*)(X + o + 4); } else hv[m][bj] = *(const u32x4*)(HB + o); }
#pragma unroll
            for (int m = 0; m < 4; ++m) { const int row = EPI_ROW; float ss = 0.f;
#pragma unroll
                for (int bj = 0; bj < 2; ++bj) { const int col = EPI_COL; const size_t o = (size_t)row * 1024 + col;
                    f32x4 r0, r1;
                    if (MODE == 0) { r0 = ra[m][bj]; r1 = rb[m][bj]; } else unpack8(hv[m][bj], r0, r1);
                    const f32x4 v0 = acc[ai][bj][m][0] + r0, v1 = acc[ai][bj][m][1] + r1;
                    *(u32x4*)(HB + o) = pack8(v0, v1);
                    ss += (v0[0] * v0[0] + v0[1] * v0[1]) + (v0[2] * v0[2] + v0[3] * v0[3]) + (v1[0] * v1[0] + v1[1] * v1[1]) + (v1[2] * v1[2] + v1[3] * v1[3]); }
                ss += __shfl_xor(ss, 16); ss += __shfl_xor(ss, 32);
                if (fq == 0) SS[(size_t)row * 16 + u.pn * 4 + wc] = ss; }
        }
    }
};
struct EpiUp {
    const float* SS; bf16_t* ACT;
    __device__ __forceinline__ void operator()(const AccT& acc, const Unit& u, int wr, int wc, int fr, int fq) const {
        float rsv[2][4];
#pragma unroll
        for (int ai = 0; ai < 2; ++ai) { f32x4 q[4][4];
#pragma unroll
            for (int m = 0; m < 4; ++m) { const int row = EPI_ROW; const f32x4* sp = (const f32x4*)(SS + (size_t)row * 16);
#pragma unroll
                for (int k = 0; k < 4; ++k) q[m][k] = sp[k]; }
#pragma unroll
            for (int m = 0; m < 4; ++m) { const float tot = ((q[m][0][0] + q[m][0][1]) + (q[m][0][2] + q[m][0][3])) + ((q[m][1][0] + q[m][1][1]) + (q[m][1][2] + q[m][1][3])) + ((q[m][2][0] + q[m][2][1]) + (q[m][2][2] + q[m][2][3])) + ((q[m][3][0] + q[m][3][1]) + (q[m][3][2] + q[m][3][3]));
                rsv[ai][m] = 1.0f / sqrtf(tot * (1.f / 1024.f) + 1e-6f); } }
#pragma unroll
        for (int ai = 0; ai < 2; ++ai)
#pragma unroll
            for (int m = 0; m < 4; ++m) { const int row = EPI_ROW; const float rs = rsv[ai][m];
#pragma unroll
                for (int bj = 0; bj < 2; ++bj) { const int col = EPI_COL; f32x4 v0 = acc[ai][bj][m][0] * rs, v1 = acc[ai][bj][m][1] * rs;
#pragma unroll
                    for (int i = 0; i < 4; ++i) { const float a = fmaxf(v0[i], 0.f), b = fmaxf(v1[i], 0.f); v0[i] = a * a; v1[i] = b * b; }
                    *(u32x4*)(ACT + (size_t)row * 4096 + col) = pack8(v0, v1); } }
    }
};

template <class Epi, int ADIL = 0, int BDIL = 0>
__device__ __forceinline__ void gemm_phase(PG8_LAS unsigned char* lds, const Gemm g, const StaticOrder& S, const Epi& E) {
    const int wid = g.wid, lane = (int)__builtin_amdgcn_mbcnt_hi(~0u, __builtin_amdgcn_mbcnt_lo(~0u, 0u)), tid = wid * 64 + lane, wr = wid >> 2, wc = wid & 3, fr = lane & 15, fq = lane >> 4;
    const int K = g.K, nt = K / BK;
    unsigned voffA[2], voffB[2];
#pragma unroll
    for (int i = 0; i < 2; ++i) { int R, C; stage_rc(tid * 16 + i * 8192, R, C); const int Rb = (R & ~31) + perm32(R & 31);
        voffA[i] = (unsigned)(R * g.lda + C) * 2u; voffB[i] = (unsigned)(Rb * g.ldb + C) * 2u; }
    const size_t kstep = (size_t)(BK * 2);
    const size_t hstepA = (size_t)HALF * g.lda * 2, hstepB = (size_t)HALF * g.ldb * 2;
    const unsigned ldsw = (unsigned)wid * 1024u;
    const int aoff = lds_byte(wr * 64 + fr, fq * 8), boff = lds_byte(wc * 32 + fr, fq * 8);
#define PG8_SA(b, h) (((b) * 2 + (h)) * HTB)
#define PG8_SB(b, h) ((4 + (b) * 2 + (h)) * HTB)
#define PG8_STAGE(bufoff, gbase, voff) do { _Pragma("unroll") for (int _i = 0; _i < 2; ++_i) \
        __builtin_amdgcn_global_load_lds((const unsigned*)((const char*)(gbase) + (voff)[_i]), (PG8_LAS unsigned*)(lds + (bufoff) + ldsw + _i * 8192), 16, 0, 0); } while (0)
#define PG8_LDA(dst, b, h) do { _Pragma("unroll") for (int m = 0; m < 4; ++m) _Pragma("unroll") for (int k = 0; k < 2; ++k) dst[m][k] = *(const PG8_LAS bf16x8*)(lds + PG8_SA(b, h) + aoff + m * 2048 + k * 1024); } while (0)
#define PG8_LDB(dst, b, h) do { _Pragma("unroll") for (int n = 0; n < 2; ++n) _Pragma("unroll") for (int k = 0; k < 2; ++k) dst[n][k] = *(const PG8_LAS bf16x8*)(lds + PG8_SB(b, h) + boff + n * 2048 + k * 1024); } while (0)
#define PG8_MMA(ai, bj, At, Bt) do { __builtin_amdgcn_s_setprio(1); _Pragma("unroll") for (int m = 0; m < 4; ++m) _Pragma("unroll") for (int n = 0; n < 2; ++n) _Pragma("unroll") for (int k = 0; k < 2; ++k) \
        acc[ai][bj][m][n] = __builtin_amdgcn_mfma_f32_16x16x32_bf16(Bt[n][k], At[m][k], acc[ai][bj][m][n], 0, 0, 0); __builtin_amdgcn_s_setprio(0); } while (0)
#define PG8_WAIT_V(n) asm volatile("s_waitcnt vmcnt(" #n ")" ::: "memory")
#define PG8_WAIT_L(n) asm volatile("s_waitcnt lgkmcnt(" #n ")" ::: "memory")
#define PG8_BAR __builtin_amdgcn_s_barrier()
#define PG8_SCHED __builtin_amdgcn_sched_barrier(0)
    Unit cur, nxt; int ui = 0;
    if (!S.next(0, cur)) return;
    f32x4 acc[2][2][4][2];
#pragma unroll
    for (int a = 0; a < 2; ++a)
#pragma unroll
        for (int b = 0; b < 2; ++b)
#pragma unroll
            for (int m = 0; m < 4; ++m)
#pragma unroll
                for (int n = 0; n < 2; ++n) acc[a][b][m][n] = (f32x4){0.f, 0.f, 0.f, 0.f};
    bf16x8 At[4][2], B0[2][2], B1[2][2];
    const char* cA = a_tile<ADIL>(g, cur.pm); const char* cB = b_tile<BDIL>(g, cur.pn);
    PG8_STAGE(PG8_SB(0, 0), cB, voffB); PG8_STAGE(PG8_SB(0, 1), cB + hstepB, voffB); PG8_STAGE(PG8_SA(0, 0), cA, voffA); PG8_STAGE(PG8_SA(0, 1), cA + hstepA, voffA);
    if (wr == 1) PG8_BAR;
    PG8_WAIT_V(2); PG8_BAR;
    PG8_STAGE(PG8_SB(1, 0), cB + kstep, voffB); PG8_STAGE(PG8_SA(1, 0), cA + kstep, voffA); PG8_STAGE(PG8_SB(1, 1), cB + hstepB + kstep, voffB);
    PG8_WAIT_V(6); PG8_BAR;
    for (;;) {
        const bool has_next = S.next(ui + 1, nxt);
        const char* nA = has_next ? a_tile<ADIL>(g, nxt.pm) : cA; const char* nB = has_next ? b_tile<BDIL>(g, nxt.pn) : cB;
        for (int t = 0; t < nt; t += 2) {
            const bool last = (t == nt - 2);
            const char* a1 = cA + (size_t)(t + 1) * kstep;
            const char* a2 = last ? nA : cA + (size_t)(t + 2) * kstep; const char* b2 = last ? nB : cB + (size_t)(t + 2) * kstep;
            const char* a3 = a2 + kstep; const char* b3 = b2 + kstep;
            PG8_LDB(B0, 0, 0); PG8_LDB(B1, 0, 1); PG8_SCHED; PG8_LDA(At, 0, 0); PG8_STAGE(PG8_SA(1, 1), a1 + hstepA, voffA);
            PG8_WAIT_V(8); PG8_WAIT_L(0); PG8_BAR; PG8_MMA(0, 0, At, B0); PG8_MMA(0, 1, At, B1); PG8_BAR; PG8_SCHED;
            PG8_LDA(At, 0, 1); PG8_STAGE(PG8_SB(0, 0), b2, voffB); PG8_STAGE(PG8_SB(0, 1), b2 + hstepB, voffB); PG8_STAGE(PG8_SA(0, 0), a2, voffA);
            PG8_WAIT_V(8); PG8_WAIT_L(0); PG8_BAR; PG8_MMA(1, 0, At, B0); PG8_MMA(1, 1, At, B1); PG8_BAR; PG8_SCHED;
            PG8_LDB(B0, 1, 0); PG8_LDB(B1, 1, 1); PG8_SCHED; PG8_LDA(At, 1, 0); PG8_STAGE(PG8_SA(0, 1), a2 + hstepA, voffA);
            PG8_WAIT_V(8); PG8_WAIT_L(0); PG8_BAR; PG8_MMA(0, 0, At, B0); PG8_MMA(0, 1, At, B1); PG8_BAR; PG8_SCHED;
            PG8_LDA(At, 1, 1); PG8_STAGE(PG8_SB(1, 0), b3, voffB); PG8_STAGE(PG8_SB(1, 1), b3 + hstepB, voffB); PG8_STAGE(PG8_SA(1, 0), a3, voffA);
            PG8_WAIT_V(8); PG8_WAIT_L(0); PG8_BAR; PG8_MMA(1, 0, At, B0); PG8_MMA(1, 1, At, B1); PG8_BAR; PG8_SCHED;
        }
        if (wr == 0) PG8_BAR;
        E(acc, cur, wr, wc, fr, fq);
        if (!has_next) break;
#pragma unroll
        for (int a = 0; a < 2; ++a)
#pragma unroll
            for (int b = 0; b < 2; ++b)
#pragma unroll
                for (int m = 0; m < 4; ++m)
#pragma unroll
                    for (int n = 0; n < 2; ++n) acc[a][b][m][n] = (f32x4){0.f, 0.f, 0.f, 0.f};
        cur = nxt; cA = nA; cB = nB; ++ui;
        if (wr == 1) PG8_BAR;
    }
    PG8_WAIT_V(0);
    PG8_BAR;
#undef PG8_SA
#undef PG8_SB
#undef PG8_STAGE
#undef PG8_LDA
#undef PG8_LDB
#undef PG8_MMA
#undef PG8_WAIT_V
#undef PG8_WAIT_L
#undef PG8_BAR
#undef PG8_SCHED
}
}

constexpr int NWAVES = 8;
constexpr int BATCH = 8, SEQ = 8192, D = 1024, M = BATCH * SEQ, FF = 4096;
constexpr int NIN = 4096;
constexpr int N_PHASES = 10;

constexpr size_t MiB = 1u << 20;
constexpr size_t WS_BAR = 0;
constexpr size_t WS_SSMA = 512 * 1024;
constexpr size_t WS_SSMB = 576 * 1024;
constexpr size_t WS_SSMC = 704 * 1024;
constexpr size_t WS_WIN = 2 * MiB;
constexpr size_t WS_WQK = 10 * MiB;
constexpr size_t WS_WV = 13 * MiB;
constexpr size_t WS_WGLU = 15 * MiB;
constexpr size_t WS_WSSM = 16 * MiB;
constexpr size_t WS_WATT = 17 * MiB;
constexpr size_t WS_WMKV = 18 * MiB;
constexpr size_t WS_WMEM = 20 * MiB;
constexpr size_t WS_WO = 21 * MiB;
constexpr size_t WS_WUP = 23 * MiB;
constexpr size_t WS_WDN = 31 * MiB;
constexpr size_t WS_MEMN = 40 * MiB;
constexpr size_t WS_MK = 44 * MiB;
constexpr size_t WS_MVT = 46 * MiB;
constexpr size_t WS_E = 48 * MiB;
constexpr size_t WS_SSP1 = 56 * MiB, WS_SSP2 = 60 * MiB;
constexpr size_t WS_XN = 64 * MiB;
constexpr size_t WS_OG = 64 * MiB, WS_LSE = 160 * MiB;
constexpr size_t WS_U = 192 * MiB;
constexpr size_t WS_MQ = 256 * MiB;
constexpr size_t WS_HB = 192 * MiB;
constexpr size_t WS_GATES = 320 * MiB;
constexpr size_t WS_Q = 704 * MiB, WS_K = 800 * MiB, WS_VT = 896 * MiB;
constexpr size_t WS_YG = 704 * MiB, WS_Y2 = 768 * MiB, WS_OMRG = 832 * MiB, WS_MG = 864 * MiB;
constexpr size_t WS_ACT = 320 * MiB;
constexpr size_t WS_END = 992 * MiB;

constexpr int LDS_BYTES = 147456;

#define LAS __attribute__((address_space(3)))
typedef unsigned short bf16;
typedef unsigned v4u __attribute__((ext_vector_type(4)));
typedef unsigned v2u __attribute__((ext_vector_type(2)));
typedef float f32x4 __attribute__((ext_vector_type(4)));
typedef float f32x2 __attribute__((ext_vector_type(2)));
typedef float f32x16 __attribute__((ext_vector_type(16)));
typedef short bf16x8 __attribute__((ext_vector_type(8)));
typedef short s16x4 __attribute__((ext_vector_type(4)));
typedef __bf16 bf16x2_t __attribute__((ext_vector_type(2)));
__device__ __forceinline__ unsigned cvtpk(float lo, float hi) { f32x2 v = {lo, hi}; bf16x2_t b = __builtin_convertvector(v, bf16x2_t); return __builtin_bit_cast(unsigned, b); }
__device__ __forceinline__ float wave_sum(float v) {
#pragma unroll
    for (int o = 1; o < 64; o <<= 1) v += __shfl_xor(v, o);
    return v;
}
__device__ __forceinline__ float bf2f(bf16 b) { return __builtin_bit_cast(float, (unsigned)b << 16); }

struct Args { const float* in[25]; float* out; unsigned char* ws; int ph_lo, ph_hi; };

__device__ __forceinline__ void p0_transpose_item(const float* W, int ldw, int c0, int K, int nblk, bf16* WT, int row_off, const float* scale, LAS float* scr, int item, int lane) {
    const int kb = item / nblk, nb = item % nblk, k0 = 64 * kb, n0 = 32 * nb;
#pragma unroll 8
    for (int i = 0; i < 32; ++i) { const int kk = 2 * i + (lane >> 5); float v = W[(size_t)(k0 + kk) * ldw + c0 + n0 + (lane & 31)]; if (scale) v *= scale[k0 + kk]; scr[kk * 33 + (lane & 31)] = v; }
    asm volatile("s_waitcnt lgkmcnt(0)" ::: "memory");
    const int c = lane & 7;
#pragma unroll
    for (int j = 0; j < 4; ++j) { const int n = (lane >> 3) + 8 * j; const LAS float* s = scr + (8 * c) * 33 + n;
        v4u o; o.x = cvtpk(s[0 * 33], s[1 * 33]); o.y = cvtpk(s[2 * 33], s[3 * 33]); o.z = cvtpk(s[4 * 33], s[5 * 33]); o.w = cvtpk(s[6 * 33], s[7 * 33]);
        *(v4u*)(WT + (size_t)(row_off + n0 + n) * K + k0 + 8 * c) = o; }
    asm volatile("s_waitcnt lgkmcnt(0)" ::: "memory");
}
template <int NR>
__device__ __forceinline__ void rms_rows_to_bf16(const float* xrow, size_t rs, const float* g, bf16* orow, int lane) {
    const f32x4* gr = (const f32x4*)g + lane;
    f32x4 v[NR][4]; float s[NR];
#pragma unroll
    for (int r = 0; r < NR; ++r) { const f32x4* xr = (const f32x4*)(xrow + r * rs) + lane; s[r] = 0.f;
#pragma unroll
        for (int j = 0; j < 4; ++j) v[r][j] = xr[64 * j]; }
    f32x4 gg[4];
#pragma unroll
    for (int j = 0; j < 4; ++j) gg[j] = gr[64 * j];
#pragma unroll
    for (int r = 0; r < NR; ++r) {
#pragma unroll
        for (int j = 0; j < 4; ++j) s[r] += (v[r][j].x * v[r][j].x + v[r][j].y * v[r][j].y) + (v[r][j].z * v[r][j].z + v[r][j].w * v[r][j].w);
        const float rstd = 1.f / sqrtf(wave_sum(s[r]) * (1.f / 1024.f) + 1e-6f);
        unsigned long long* o8 = (unsigned long long*)(orow + r * rs) + lane;
#pragma unroll
        for (int j = 0; j < 4; ++j)
            o8[64 * j] = (unsigned long long)cvtpk(v[r][j].x * rstd * gg[j].x, v[r][j].y * rstd * gg[j].y) | ((unsigned long long)cvtpk(v[r][j].z * rstd * gg[j].z, v[r][j].w * rstd * gg[j].w) << 32); }
}
__device__ __forceinline__ void sincos_d(double x, double& s, double& c) {
    const double k = rint(x * 0.15915494309189535); const double y = (x - k * 6.283185307179586) - k * 2.4492935982947064e-16;
    const double y2 = y * y; double ts = 1.0, tc = 1.0;
#pragma unroll 1
    for (int n = 27; n >= 3; n -= 2) { ts = 1.0 - ts * y2 / (double)(n * (n - 1)); tc = 1.0 - tc * y2 / (double)((n - 1) * (n - 2)); }
    s = y * ts; c = tc;
}

template <int E, bool MASK>
__device__ __forceinline__ void attn_wave(const bf16* Qp, int ldq, const bf16* Kt, const bf16* Vt,
                                          int kt0, int kt1, int j0, int lane, f32x16 (&O)[E / 32], float& m_out, float& l_out) {
    constexpr int TE = 32 * E;
    const int c = lane & 31, hi = lane >> 5;
    bf16x8 qf[E / 16];
#pragma unroll
    for (int s = 0; s < E / 16; ++s) qf[s] = *(const bf16x8*)(Qp + (size_t)c * ldq + 16 * s + 8 * hi);
    float mrun = -1e30f, l = 0.f;
#pragma unroll
    for (int t = 0; t < E / 32; ++t)
#pragma unroll
        for (int i = 0; i < 16; ++i) O[t][i] = 0.f;
    const float c2 = (E == 64 ? 0.125f : 0.08838834764831845f) * 1.4426950408889634f;
    bf16x8 kf[E / 16];
#pragma unroll
    for (int s = 0; s < E / 16; ++s) kf[s] = *(const bf16x8*)(Kt + (size_t)kt0 * TE + s * 512 + lane * 8);
    for (int kt = kt0; kt <= kt1; ++kt) {
        bf16x8 vfr[E / 32][2];
#pragma unroll
        for (int t = 0; t < E / 32; ++t)
#pragma unroll
            for (int s2 = 0; s2 < 2; ++s2) vfr[t][s2] = *(const bf16x8*)(Vt + (size_t)kt * TE + (t * 2 + s2) * 512 + lane * 8);
        bf16x8 kn[E / 16];
        { const int ktn = (kt < kt1) ? kt + 1 : kt1;
#pragma unroll
          for (int s = 0; s < E / 16; ++s) kn[s] = *(const bf16x8*)(Kt + (size_t)ktn * TE + s * 512 + lane * 8); }
        f32x16 S;
#pragma unroll
        for (int i = 0; i < 16; ++i) S[i] = 0.f;
#pragma unroll
        for (int s = 0; s < E / 16; ++s) S = __builtin_amdgcn_mfma_f32_32x32x16_bf16(kf[s], qf[s], S, 0, 0, 0);
        if (MASK) {
            const bool full = (kt * 32 + 31 <= j0) && (kt * 32 + 128 >= j0 + 31);
            if (!full) { const int qj = j0 + c;
#pragma unroll
                for (int i = 0; i < 16; ++i) { const int kj = kt * 32 + (i & 3) + 8 * (i >> 2) + 4 * hi; const bool valid = (kj <= qj) && (kj + 128 >= qj); S[i] = valid ? S[i] : -1e30f; } }
        }
        float mx = S[0];
#pragma unroll
        for (int i = 1; i < 16; ++i) mx = fmaxf(mx, S[i]);
        mx = fmaxf(mx, __shfl_xor(mx, 32));
        const float mn = fmaxf(mrun, mx); const float alpha = __builtin_amdgcn_exp2f((mrun - mn) * c2); mrun = mn;
        float ps = 0.f;
#pragma unroll
        for (int i = 0; i < 16; ++i) { const float p = __builtin_amdgcn_exp2f((S[i] - mn) * c2); S[i] = p; ps += p; }
        l = l * alpha + ps;
#pragma unroll
        for (int t = 0; t < E / 32; ++t)
#pragma unroll
            for (int i = 0; i < 16; ++i) O[t][i] *= alpha;
        bf16x8 pk[2];
#pragma unroll
        for (int s2 = 0; s2 < 2; ++s2) { v4u w; w.x = cvtpk(S[8 * s2 + 0], S[8 * s2 + 1]); w.y = cvtpk(S[8 * s2 + 2], S[8 * s2 + 3]); w.z = cvtpk(S[8 * s2 + 4], S[8 * s2 + 5]); w.w = cvtpk(S[8 * s2 + 6], S[8 * s2 + 7]); pk[s2] = __builtin_bit_cast(bf16x8, w); }
#pragma unroll
        for (int t = 0; t < E / 32; ++t)
#pragma unroll
            for (int s2 = 0; s2 < 2; ++s2) O[t] = __builtin_amdgcn_mfma_f32_32x32x16_bf16(vfr[t][s2], pk[s2], O[t], 0, 0, 0);
#pragma unroll
        for (int s = 0; s < E / 16; ++s) kf[s] = kn[s];
    }
    l += __shfl_xor(l, 32);
    m_out = mrun; l_out = l;
}

__device__ __forceinline__ void sattn_wave(const bf16* Qp, const bf16* Kt, const bf16* Vt, int j0, int lane, f32x16 (&O)[2][2], float (&m_out)[2], float (&l_out)[2]) {
    const int c = lane & 31, hi = lane >> 5;
    bf16x8 qf[2][4];
#pragma unroll
    for (int q = 0; q < 2; ++q)
#pragma unroll
        for (int s = 0; s < 4; ++s) qf[q][s] = *(const bf16x8*)(Qp + (size_t)(32 * q + c) * 64 + 16 * s + 8 * hi);
    float mrun[2] = {-1e30f, -1e30f}, l[2] = {0.f, 0.f};
#pragma unroll
    for (int q = 0; q < 2; ++q)
#pragma unroll
        for (int t = 0; t < 2; ++t)
#pragma unroll
            for (int i = 0; i < 16; ++i) O[q][t][i] = 0.f;
    const float c2 = 0.125f * 1.4426950408889634f;
    const int kb = j0 >> 5, kt_end = kb + 1, kt_beg = (kb >= 4) ? kb - 4 : 0;
    bf16x8 kf[4], vfr[2][2];
#pragma unroll
    for (int s = 0; s < 4; ++s) kf[s] = *(const bf16x8*)(Kt + (size_t)kt_beg * 2048 + s * 512 + lane * 8);
#pragma unroll
    for (int t = 0; t < 2; ++t)
#pragma unroll
        for (int s2 = 0; s2 < 2; ++s2) vfr[t][s2] = *(const bf16x8*)(Vt + (size_t)kt_beg * 2048 + (t * 2 + s2) * 512 + lane * 8);
    for (int kt = kt_beg; kt <= kt_end; ++kt) {
        const int ktn = (kt < kt_end) ? kt + 1 : kt_end;
        bf16x8 kn[4], vn[2][2];
#pragma unroll
        for (int s = 0; s < 4; ++s) kn[s] = *(const bf16x8*)(Kt + (size_t)ktn * 2048 + s * 512 + lane * 8);
#pragma unroll
        for (int t = 0; t < 2; ++t)
#pragma unroll
            for (int s2 = 0; s2 < 2; ++s2) vn[t][s2] = *(const bf16x8*)(Vt + (size_t)ktn * 2048 + (t * 2 + s2) * 512 + lane * 8);
#pragma unroll
        for (int q = 0; q < 2; ++q) {
            const int kq = kb + q;
            if (kt <= kq && kt + 4 >= kq) {
                f32x16 S;
#pragma unroll
                for (int i = 0; i < 16; ++i) S[i] = 0.f;
#pragma unroll
                for (int s = 0; s < 4; ++s) S = __builtin_amdgcn_mfma_f32_32x32x16_bf16(kf[s], qf[q][s], S, 0, 0, 0);
                const int jq = j0 + 32 * q;
                const bool full = (kt * 32 + 31 <= jq) && (kt * 32 + 128 >= jq + 31);
                if (!full) { const int qj = jq + c;
#pragma unroll
                    for (int i = 0; i < 16; ++i) { const int kj = kt * 32 + (i & 3) + 8 * (i >> 2) + 4 * hi; const bool valid = (kj <= qj) && (kj + 128 >= qj); S[i] = valid ? S[i] : -1e30f; } }
                float mx = S[0];
#pragma unroll
                for (int i = 1; i < 16; ++i) mx = fmaxf(mx, S[i]);
                mx = fmaxf(mx, __shfl_xor(mx, 32));
                const float mn = fmaxf(mrun[q], mx); const float alpha = __builtin_amdgcn_exp2f((mrun[q] - mn) * c2); mrun[q] = mn;
                float ps = 0.f;
#pragma unroll
                for (int i = 0; i < 16; ++i) { const float p = __builtin_amdgcn_exp2f((S[i] - mn) * c2); S[i] = p; ps += p; }
                l[q] = l[q] * alpha + ps;
#pragma unroll
                for (int t = 0; t < 2; ++t)
#pragma unroll
                    for (int i = 0; i < 16; ++i) O[q][t][i] *= alpha;
                bf16x8 pk[2];
#pragma unroll
                for (int s2 = 0; s2 < 2; ++s2) { v4u w; w.x = cvtpk(S[8 * s2 + 0], S[8 * s2 + 1]); w.y = cvtpk(S[8 * s2 + 2], S[8 * s2 + 3]); w.z = cvtpk(S[8 * s2 + 4], S[8 * s2 + 5]); w.w = cvtpk(S[8 * s2 + 6], S[8 * s2 + 7]); pk[s2] = __builtin_bit_cast(bf16x8, w); }
#pragma unroll
                for (int t = 0; t < 2; ++t)
#pragma unroll
                    for (int s2 = 0; s2 < 2; ++s2) O[q][t] = __builtin_amdgcn_mfma_f32_32x32x16_bf16(vfr[t][s2], pk[s2], O[q][t], 0, 0, 0);
            }
        }
#pragma unroll
        for (int s = 0; s < 4; ++s) kf[s] = kn[s];
#pragma unroll
        for (int t = 0; t < 2; ++t)
#pragma unroll
            for (int s2 = 0; s2 < 2; ++s2) vfr[t][s2] = vn[t][s2];
    }
#pragma unroll
    for (int q = 0; q < 2; ++q) { l[q] += __shfl_xor(l[q], 32); m_out[q] = mrun[q]; l_out[q] = l[q]; }
}

constexpr int SSM_LROW = 272;
template <bool PASSB>
__device__ __forceinline__ void ssm_wave(const unsigned char* ws, const float* dd, int b, int g, int segbase, int hstride, int nsp, LAS unsigned char* sb, int lane) {
    const int c = lane & 31, hi = lane >> 5;
    const f32x4 pa0 = *(const f32x4*)(ws + WS_SSMA + (size_t)(g * 64 + c) * 16), pa1 = *(const f32x4*)(ws + WS_SSMA + (size_t)(g * 64 + c + 32) * 16);
    bf16x8 bfr[4];
#pragma unroll
    for (int n = 0; n < 4; ++n) bfr[n] = *(const bf16x8*)(ws + WS_SSMB + ((size_t)((g * 4 + n) * 32 + c) * 16 + 8 * hi) * 2);
    const bf16* U = (const bf16*)(ws + WS_U);
    float s0r = 0.f, s0i = 0.f, s1r = 0.f, s1i = 0.f;
    f32x2* Eb = (f32x2*)(ws + WS_E) + (size_t)(b * 32 + g) * 64 * 64;
    if (PASSB) {
        const int seg = segbase + hstride * hi;
#pragma unroll 8
        for (int sq = 0; sq < seg; ++sq) { const f32x2 e0 = Eb[sq * 64 + c], e1 = Eb[sq * 64 + c + 32];
            const float n0r = pa0.z * s0r - pa0.w * s0i + e0.x, n0i = pa0.z * s0i + pa0.w * s0r + e0.y; s0r = n0r; s0i = n0i;
            const float n1r = pa1.z * s1r - pa1.w * s1i + e1.x, n1i = pa1.z * s1i + pa1.w * s1r + e1.y; s1r = n1r; s1i = n1i; }
    }
    bf16x8 cfr[4];
    if (PASSB) {
#pragma unroll
        for (int ks = 0; ks < 4; ++ks) cfr[ks] = *(const bf16x8*)(ws + WS_SSMC + ((size_t)(g * 16 + (lane & 15)) * 128 + 32 * ks + 8 * (lane >> 4)) * 2);
    }
    const int segsel = (c >> 2) & 1, toff = (c & 3) + 4 * (c >> 3);
    const float dsk = dd[g * 16 + (lane & 15)];
    for (int kp = 0; kp < nsp; ++kp) {
        if (!PASSB) { s0r = 0.f; s0i = 0.f; s1r = 0.f; s1i = 0.f; }
        const int seg0 = segbase + kp;
        const size_t tokA = (size_t)b * 8192 + (size_t)(seg0 + hstride * segsel) * 128 + toff;
        bf16x8 ufn = *(const bf16x8*)(U + tokA * 512 + g * 16 + 8 * hi);
        for (int blk = 0; blk < 8; ++blk) {
            const bf16x8 uf = ufn; { const int bn = (blk < 7) ? blk + 1 : 7; ufn = *(const bf16x8*)(U + (tokA + bn * 16) * 512 + g * 16 + 8 * hi); }
            bf16 uu[2][4];
            if (PASSB) {
#pragma unroll
                for (int ss = 0; ss < 2; ++ss)
#pragma unroll
                    for (int rg = 0; rg < 4; ++rg) uu[ss][rg] = U[((size_t)b * 8192 + (size_t)(seg0 + hstride * ss) * 128 + blk * 16 + (lane >> 4) * 4 + rg) * 512 + g * 16 + (lane & 15)];
            }
            f32x16 z;
#pragma unroll
            for (int i = 0; i < 16; ++i) z[i] = 0.f;
            const f32x16 BU0 = __builtin_amdgcn_mfma_f32_32x32x16_bf16(uf, bfr[0], z, 0, 0, 0), BU1 = __builtin_amdgcn_mfma_f32_32x32x16_bf16(uf, bfr[1], z, 0, 0, 0);
            const f32x16 BU2 = __builtin_amdgcn_mfma_f32_32x32x16_bf16(uf, bfr[2], z, 0, 0, 0), BU3 = __builtin_amdgcn_mfma_f32_32x32x16_bf16(uf, bfr[3], z, 0, 0, 0);
#pragma unroll
            for (int i = 0; i < 16; ++i) {
                const float n0r = pa0.x * s0r - pa0.y * s0i + BU0[i], n0i = pa0.x * s0i + pa0.y * s0r + BU1[i]; s0r = n0r; s0i = n0i;
                const float n1r = pa1.x * s1r - pa1.y * s1i + BU2[i], n1i = pa1.x * s1i + pa1.y * s1r + BU3[i]; s1r = n1r; s1i = n1i;
                if (PASSB) { LAS unsigned char* rowp = sb + (hi * 16 + i) * SSM_LROW + 4 * c;
                    *(LAS unsigned*)rowp = cvtpk(s0r, s0i); *(LAS unsigned*)(rowp + 128) = cvtpk(s1r, s1i); }
            }
            if (PASSB) {
                asm volatile("s_waitcnt lgkmcnt(0)" ::: "memory");
#pragma unroll
                for (int ss = 0; ss < 2; ++ss) {
                    pg8::f32x4 Y = {0.f, 0.f, 0.f, 0.f};
#pragma unroll
                    for (int ks = 0; ks < 4; ++ks) { const bf16x8 af = *(const LAS bf16x8*)(sb + (ss * 16 + (lane & 15)) * SSM_LROW + (32 * ks + 8 * (lane >> 4)) * 2);
                        Y = __builtin_amdgcn_mfma_f32_16x16x32_bf16(af, cfr[ks], Y, 0, 0, 0); }
#pragma unroll
                    for (int rg = 0; rg < 4; ++rg) { const size_t tok = (size_t)b * 8192 + (size_t)(seg0 + hstride * ss) * 128 + blk * 16 + (lane >> 4) * 4 + rg; const size_t o = tok * 512 + g * 16 + (lane & 15);
                        const float y = Y[rg] + dsk * bf2f(uu[ss][rg]);
                        const float zz = 0.7978845608028654f * (y + 0.044715f * y * y * y);
                        const float gl = y * __builtin_amdgcn_rcpf(1.f + __builtin_amdgcn_exp2f(-2.885390081777927f * zz));
                        ((bf16*)(ws + WS_YG))[o] = (bf16)(cvtpk(gl, 0.f) & 0xffffu); }
                }
                asm volatile("s_waitcnt lgkmcnt(0)" ::: "memory");
            }
        }
        if (!PASSB) { const int seg = seg0 + hstride * hi; Eb[seg * 64 + c] = (f32x2){s0r, s0i}; Eb[seg * 64 + c + 32] = (f32x2){s1r, s1i}; }
    }
}

#define RLX_AGENT __ATOMIC_RELAXED, __HIP_MEMORY_SCOPE_AGENT
#define XB_TMO      128
#define XB_XCNT(j)  (256  + 64 * (j))
#define XB_XSUB(j)  (1280 + 64 * (j))
#define XB_XGEN(j)  (2304 + 64 * (j))
#define XB_TOP      3328
#define XB_TOPGEN   3392
#define XCD_BAR_WORDS 3456
#define XB_SPIN_CAP (1u << 18)

__device__ __forceinline__ unsigned xb_ld(unsigned* p)              { return __hip_atomic_load(p, __ATOMIC_RELAXED, __HIP_MEMORY_SCOPE_AGENT); }
__device__ __forceinline__ unsigned xb_add(unsigned* p, unsigned v) { return __hip_atomic_fetch_add(p, v, __ATOMIC_RELAXED, __HIP_MEMORY_SCOPE_AGENT); }
__device__ __forceinline__ unsigned xb_xcc_id() { return (unsigned)__builtin_amdgcn_s_getreg((3 << 11) | 20) & 0xFu; }
#define XB_SPIN(cond, bar) do { unsigned _sp = 0; while (cond) { __builtin_amdgcn_s_sleep(1); \
    if ((++_sp & 255u) == 0u) { if (xb_ld(&(bar)[XB_TMO])) break; if (_sp > XB_SPIN_CAP) { atomicAdd(&(bar)[XB_TMO], 1u); break; } } } } while (0)

struct XcdBarrier {
    unsigned* bar; unsigned x;
    volatile LAS unsigned* st;
};

__device__ __forceinline__ XcdBarrier xcd_barrier_post(unsigned* bar, volatile LAS unsigned* st, bool tid0) {
    XcdBarrier b; b.bar = bar; b.x = xb_xcc_id(); b.st = st;
    if (tid0) (void)xb_add(&bar[XB_XCNT(b.x)], 1u);
    return b;
}
__device__ __forceinline__ void xcd_barrier_complete(unsigned* bar, unsigned x, unsigned& nloc, unsigned& nx) {
    const unsigned G = gridDim.x * gridDim.y * gridDim.z;
    unsigned sum, cnt, mine, sp = 0u;
    for (;;) {
        sum = 0u; cnt = 0u; mine = 0u;
#pragma unroll
        for (unsigned j = 0; j < 16; ++j) { const unsigned c = xb_ld(&bar[XB_XCNT(j)]); sum += c; cnt += (c > 0u) ? 1u : 0u; mine = (j == x) ? c : mine; }
        if (sum == G) break;
        __builtin_amdgcn_s_sleep(1);
        if ((++sp & 255u) == 0u) { if (xb_ld(&bar[XB_TMO])) break; if (sp > XB_SPIN_CAP) { atomicAdd(&bar[XB_TMO], 1u); break; } }
    }
    nloc = mine > 0u ? mine : 1u; nx = cnt > 0u ? cnt : 1u;
}

__device__ __forceinline__ void xcd_barrier(const XcdBarrier& b, bool tid0) {
    asm volatile("s_waitcnt vmcnt(0)" ::: "memory");
    __syncthreads();
    if (tid0) {
        unsigned* bar = b.bar;
        __builtin_amdgcn_s_waitcnt(0);
        unsigned nloc = b.st[0], nx = b.st[1];
        if (nloc == 0u) { xcd_barrier_complete(bar, b.x, nloc, nx); b.st[0] = nloc; b.st[1] = nx; }
        const unsigned old = xb_add(&bar[XB_XSUB(b.x)], 1u);
        const unsigned gen = old / nloc;
        if (old + 1u == (gen + 1u) * nloc) {
            __builtin_amdgcn_fence(__ATOMIC_RELEASE, "agent");
            asm volatile("s_waitcnt vmcnt(0)" ::: "memory");
            const unsigned og = xb_add(&bar[XB_TOP], 1u);
            const unsigned tg = og / nx;
            if (og + 1u == (tg + 1u) * nx) xb_add(&bar[XB_TOPGEN], 1u);
            else XB_SPIN(xb_ld(&bar[XB_TOPGEN]) == tg, bar);
            __builtin_amdgcn_fence(__ATOMIC_ACQUIRE, "agent");
            xb_add(&bar[XB_XGEN(b.x)], 1u);
            asm volatile("s_waitcnt vmcnt(0)" ::: "memory");
        } else {
            XB_SPIN(xb_ld(&bar[XB_XGEN(b.x)]) == gen, bar);
            __builtin_amdgcn_fence(__ATOMIC_ACQUIRE, "agent");
            asm volatile("s_waitcnt vmcnt(0)" ::: "memory");
        }
    }
    __syncthreads();
}

template <int GI> __device__ __forceinline__ void p1_group(LAS unsigned char* lds, unsigned char* ws, int G, int bx, int wave) {
    constexpr int d = 1 << (2 * GI);
    { pg8::Gemm g{(const bf16*)(ws + WS_XN), (const bf16*)(ws + WS_WQK) + (size_t)GI * 512 * 1024, M, 512, 1024, d * 1024, 1024, wave}; pg8::StaticOrder S; S.init(M, 512, G, bx);
      pg8::EpiQK E{(bf16*)(ws + WS_Q), (bf16*)(ws + WS_K), GI}; pg8::gemm_phase<pg8::EpiQK, d, 0>(lds, g, S, E); }
    { pg8::Gemm g{(const bf16*)(ws + WS_WV) + (size_t)GI * 256 * 1024, (const bf16*)(ws + WS_XN), 256, M, 1024, 1024, d * 1024, wave}; pg8::StaticOrder S; S.init(256, M, G, bx);
      pg8::EpiVTf E{(bf16*)(ws + WS_VT), 0, GI}; pg8::gemm_phase<pg8::EpiVTf, 0, d>(lds, g, S, E); }
}

__global__ void __launch_bounds__(NWAVES * 64, 2) fwd_megakernel(Args args) {
    __shared__ __attribute__((aligned(16))) unsigned char lds_raw[LDS_BYTES];
    LAS unsigned char* lds = (LAS unsigned char*)lds_raw;
    const int wave = __builtin_amdgcn_readfirstlane((int)threadIdx.x >> 6), lane = (int)__builtin_amdgcn_mbcnt_hi(~0u, __builtin_amdgcn_mbcnt_lo(~0u, 0u)), tid = wave * 64 + lane;
    const int G = gridDim.x; const int bx = blockIdx.x; const int vcu = (G % 8 == 0) ? (bx % 8) * (G / 8) + bx / 8 : bx;
    const int gw = vcu * NWAVES + wave, NGW = G * NWAVES;
    unsigned char* ws = args.ws;
    const int lo = args.ph_lo, hi_ph = args.ph_hi;
    volatile LAS unsigned* MISC = (volatile LAS unsigned*)(lds + 131072 + 320);
    if (tid < 32) MISC[tid] = 0u;
    __syncthreads();
    XcdBarrier bar; bar.bar = (unsigned*)ws; bar.x = 0; bar.st = nullptr;
    if (hi_ph - lo > 1) bar = xcd_barrier_post((unsigned*)ws, MISC + 8, tid == 0);
    if (lo == 0x7fffffff) cg::this_grid().sync();
#define IN(k) (lo <= (k) && (k) < hi_ph)
#define SEAM(k) do { if (IN(k) && IN((k) + 1)) { xcd_barrier(bar, tid == 0); } } while (0)

    if (IN(0)) {
        LAS float* scr = (LAS float*)(lds + wave * 16384);
        const float* w_in = args.in[4];
        constexpr int I0 = 16 * 16, I1 = 16 * 24, I2 = 16 * 112, IQK = 6 * 16 * 8, I3 = 8 * 16, I4 = 8 * 32, I5 = 4 * 32, I6 = 16 * 32, I7 = 8 * 32, I8 = 16 * 32, I9 = 16 * 128, I10 = 64 * 32;
        constexpr int NITEMS = I0 + I1 + I2 + IQK + I3 + I4 + I5 + I6 + I7 + I8 + I9 + I10;
        for (int it = gw; it < NITEMS; it += NGW) {
            int r = it;
            if (r < I0) { p0_transpose_item(w_in, 6400, 0, 1024, 16, (bf16*)(ws + WS_WIN), 0, nullptr, scr, r, lane); continue; } r -= I0;
            if (r < I1) { p0_transpose_item(w_in, 6400, 2048, 1024, 24, (bf16*)(ws + WS_WV), 0, nullptr, scr, r, lane); continue; } r -= I1;
            if (r < I2) { p0_transpose_item(w_in, 6400, 2816, 1024, 112, (bf16*)(ws + WS_WIN), 512, nullptr, scr, r, lane); continue; } r -= I2;
            if (r < IQK) { const int part = r >> 7, gq = part >> 1, isk = part & 1;
                p0_transpose_item(w_in, 6400, 512 + isk * 768 + gq * 256, 1024, 8, (bf16*)(ws + WS_WQK), gq * 512 + isk * 256, nullptr, scr, r & 127, lane); continue; } r -= IQK;
            if (r < I3) { p0_transpose_item(args.in[14], 512, 0, 512, 16, (bf16*)(ws + WS_WGLU), 0, nullptr, scr, r, lane); continue; } r -= I3;
            if (r < I4) { p0_transpose_item(args.in[16], 1024, 0, 512, 32, (bf16*)(ws + WS_WSSM), 0, nullptr, scr, r, lane); continue; } r -= I4;
            if (r < I5) { p0_transpose_item(args.in[17], 1024, 0, 256, 32, (bf16*)(ws + WS_WATT), 0, nullptr, scr, r, lane); continue; } r -= I5;
            if (r < I6) { p0_transpose_item(args.in[18], 1024, 0, 1024, 32, (bf16*)(ws + WS_WMKV), 0, nullptr, scr, r, lane); continue; } r -= I6;
            if (r < I7) { p0_transpose_item(args.in[19], 1024, 0, 512, 32, (bf16*)(ws + WS_WMEM), 0, nullptr, scr, r, lane); continue; } r -= I7;
            if (r < I8) { p0_transpose_item(args.in[20], 1024, 0, 1024, 32, (bf16*)(ws + WS_WO), 0, nullptr, scr, r, lane); continue; } r -= I8;
            if (r < I9) { p0_transpose_item(args.in[22], 4096, 0, 1024, 128, (bf16*)(ws + WS_WUP), 0, args.in[21], scr, r, lane); continue; } r -= I9;
            p0_transpose_item(args.in[23], 1024, 0, 4096, 32, (bf16*)(ws + WS_WDN), 0, nullptr, scr, r, lane);
        }
        for (int m = gw * 4; m < M; m += NGW * 4) rms_rows_to_bf16<4>(args.in[0] + (size_t)m * D, (size_t)D, args.in[2], (bf16*)(ws + WS_XN) + (size_t)m * D, lane);
        for (int m = gw; m < 2048; m += NGW) rms_rows_to_bf16<1>(args.in[1] + (size_t)m * D, (size_t)D, args.in[3], (bf16*)(ws + WS_MEMN) + (size_t)m * D, lane);
        { const int i = bx * 512 + tid;
          if (i < 2048) { const int g = i >> 6, p = i & 63;
            const double lr = (double)args.in[6][i], li = (double)args.in[7][i], dt = exp((double)args.in[8][g]);
            const double mag = exp(lr * dt); double sn, cs; sincos_d(li * dt, sn, cs);
            const double ar = mag * cs, aim = mag * sn, nr = ar - 1.0, ni = aim, den = lr * lr + li * li;
            const double cr = (nr * lr + ni * li) / den, ci = (ni * lr - nr * li) / den;
            double pr = ar, pi = aim;
#pragma unroll 1
            for (int k = 0; k < 7; ++k) { const double t = pr * pr - pi * pi; pi = 2.0 * pr * pi; pr = t; }
            *(f32x4*)(ws + WS_SSMA + (size_t)i * 16) = (f32x4){(float)ar, (float)aim, (float)pr, (float)pi};
            const int nt0 = (p >> 5) * 2, cc = p & 31;
            bf16* BM_ = (bf16*)(ws + WS_SSMB); bf16* CM_ = (bf16*)(ws + WS_SSMC);
#pragma unroll 1
            for (int h = 0; h < 16; ++h) { const double br = (double)args.in[9][(size_t)i * 16 + h], bi = (double)args.in[10][(size_t)i * 16 + h];
                const float bbr = (float)(cr * br - ci * bi), bbi = (float)(cr * bi + ci * br);
                BM_[((size_t)(g * 4 + nt0) * 32 + cc) * 16 + h] = (bf16)(cvtpk(bbr, 0.f) & 0xffffu);
                BM_[((size_t)(g * 4 + nt0 + 1) * 32 + cc) * 16 + h] = (bf16)(cvtpk(bbi, 0.f) & 0xffffu);
                const float c_r = args.in[11][((size_t)g * 16 + h) * 64 + p], c_i = args.in[12][((size_t)g * 16 + h) * 64 + p];
                CM_[((size_t)g * 16 + h) * 128 + 2 * p] = (bf16)(cvtpk(c_r, 0.f) & 0xffffu);
                CM_[((size_t)g * 16 + h) * 128 + 2 * p + 1] = (bf16)(cvtpk(-c_i, 0.f) & 0xffffu); }
          } }
    }
    SEAM(0);

    if (IN(1)) {
        __syncthreads();
        {
            pg8::Gemm g{(const bf16*)(ws + WS_MEMN), (const bf16*)(ws + WS_WMKV), 2048, 512, 1024, 1024, 1024, wave}; pg8::StaticOrder S; S.init(2048, 512, G, bx);
            pg8::EpiMKf E{(bf16*)(ws + WS_MK)}; pg8::gemm_phase(lds, g, S, E); }
        {
            pg8::Gemm g{(const bf16*)(ws + WS_WMKV) + (size_t)512 * 1024, (const bf16*)(ws + WS_MEMN), 512, 2048, 1024, 1024, 1024, wave}; pg8::StaticOrder S; S.init(512, 2048, G, (bx + G - 16) % G);
            pg8::EpiVTf E{(bf16*)(ws + WS_MVT), 1, 0}; pg8::gemm_phase(lds, g, S, E); }
        {
            pg8::Gemm g{(const bf16*)(ws + WS_XN), (const bf16*)(ws + WS_WIN), M, NIN, 1024, 1024, 1024, wave}; pg8::StaticOrder S; S.init(M, NIN, G, bx);
            pg8::EpiMain E{(bf16*)(ws + WS_U), (bf16*)(ws + WS_MQ), (bf16*)(ws + WS_GATES), args.in[5]}; pg8::gemm_phase(lds, g, S, E); }
        p1_group<0>(lds, ws, G, bx, wave); p1_group<1>(lds, ws, G, bx, wave); p1_group<2>(lds, ws, G, bx, wave);
    }
    SEAM(1);

    if (IN(2)) {
        for (int rep = 0; rep < PROBE_REP; ++rep)
        for (int it = gw; it < 12288; it += NGW) {
            const int qb = it & 127, rest = it >> 7, hh = rest & 3, b = (rest >> 2) & 7, g = rest >> 5;
            const int sh = 2 * g, d = 1 << sh, Ld = 8192 >> sh; const int pp0 = qb * 64, r = pp0 / Ld, j0 = pp0 % Ld;
            const size_t hb = ((size_t)(g * 8 + b) * 4 + hh) * 8192;
            const bf16* Qp = (const bf16*)(ws + WS_Q) + (hb + pp0) * 64;
            const bf16* Kt = (const bf16*)(ws + WS_K) + (hb + (size_t)r * Ld) * 64;
            const bf16* Vt = (const bf16*)(ws + WS_VT) + (hb + (size_t)r * Ld) * 64;
            f32x16 O[2][2]; float mr[2], l[2];
            sattn_wave(Qp, Kt, Vt, j0, lane, O, mr, l);
            const int c = lane & 31, hi = lane >> 5;
#pragma unroll
            for (int q = 0; q < 2; ++q) { const float inv = 1.f / l[q];
                const size_t tok = (size_t)b * 8192 + (size_t)(j0 + 32 * q + c) * d + r;
                bf16* og = (bf16*)(ws + WS_OG) + tok * 768 + g * 256 + hh * 64;
#pragma unroll
                for (int t = 0; t < 2; ++t)
#pragma unroll
                    for (int a = 0; a < 4; ++a) { v2u w; w.x = cvtpk(O[q][t][4 * a] * inv, O[q][t][4 * a + 1] * inv); w.y = cvtpk(O[q][t][4 * a + 2] * inv, O[q][t][4 * a + 3] * inv);
                        *(v2u*)(og + 32 * t + 8 * a + 4 * hi) = w; }
                if (hi == 0) ((float*)(ws + WS_LSE))[tok * 12 + g * 4 + hh] = mr[q] * 0.125f + __logf(l[q]); }
        }
        for (int it = gw; it < 8192; it += NGW) {
            const int qb = it & 255, h = (it >> 8) & 3, b = it >> 10;
            bf16* Qp = (bf16*)(ws + WS_MQ) + ((size_t)b * 8192 + qb * 32) * 512 + h * 128;
            const bf16* Kt = (const bf16*)(ws + WS_MK) + (size_t)(b * 4 + h) * 8 * 4096;
            const bf16* Vt = (const bf16*)(ws + WS_MVT) + (size_t)(b * 4 + h) * 8 * 4096;
            f32x16 O[4]; float mr, l;
            attn_wave<128, false>(Qp, 512, Kt, Vt, 0, 7, 0, lane, O, mr, l);
            const int c = lane & 31, hi = lane >> 5; const float inv = 1.f / l;
            bf16* om = Qp + (size_t)c * 512;
#pragma unroll
            for (int t = 0; t < 4; ++t)
#pragma unroll
                for (int a = 0; a < 4; ++a) { v2u w; w.x = cvtpk(O[t][4 * a] * inv, O[t][4 * a + 1] * inv); w.y = cvtpk(O[t][4 * a + 2] * inv, O[t][4 * a + 3] * inv);
                    *(v2u*)(om + 32 * t + 8 * a + 4 * hi) = w; }
        }
        for (int rep = 0; rep < PROBE_REP; ++rep)
        for (int it = gw; it < 8192; it += NGW) { const int sp = it & 31, g = (it >> 5) & 31, b = it >> 10; ssm_wave<false>(ws, args.in[13], b, g, 2 * sp, 1, 1, lds + wave * 16384, lane); }
    }
    SEAM(2);

    if (IN(3)) {
        for (int rep = 0; rep < PROBE_P3; ++rep)
        for (int it = gw; it < 2048; it += NGW) { const int qd = it & 7, g = (it >> 3) & 31, b = it >> 8;
            ssm_wave<true>(ws, args.in[13], b, g, 8 * qd, 4, 4, lds + wave * 16384, lane); }
        for (int m2 = gw; m2 < M / 2; m2 += NGW) { const size_t tok = (size_t)m2 * 2 + (lane >> 5); const int cc = (lane & 31) * 8, hh = cc >> 6;
            const float* ls = (const float*)(ws + WS_LSE) + tok * 12 + hh; const float l0 = ls[0], l1 = ls[4], l2 = ls[8];
            const float mx = fmaxf(l0, fmaxf(l1, l2)); const float e0 = __expf(l0 - mx), e1 = __expf(l1 - mx), e2 = __expf(l2 - mx); const float inv = 1.f / (e0 + e1 + e2);
            const bf16* og = (const bf16*)(ws + WS_OG) + tok * 768 + cc;
            pg8::f32x4 a0, a1, b0, b1, c0, c1; pg8::unpack8(*(const v4u*)og, a0, a1); pg8::unpack8(*(const v4u*)(og + 256), b0, b1); pg8::unpack8(*(const v4u*)(og + 512), c0, c1);
            const float w0 = e0 * inv, w1 = e1 * inv, w2 = e2 * inv;
            const pg8::f32x4 r0 = a0 * w0 + b0 * w1 + c0 * w2, r1 = a1 * w0 + b1 * w1 + c1 * w2;
            *(v4u*)((bf16*)(ws + WS_OMRG) + tok * 256 + cc) = pg8::pack8(r0, r1); }
    }
    SEAM(3);

    if (IN(4)) {
        __syncthreads();
        pg8::Gemm g{(const bf16*)(ws + WS_YG), (const bf16*)(ws + WS_WGLU), M, 512, 512, 512, 512, wave}; pg8::StaticOrder S; S.init(M, 512, G, bx);
        pg8::EpiGlu E{(const bf16*)(ws + WS_YG), (bf16*)(ws + WS_Y2), args.in[15]}; pg8::gemm_phase(lds, g, S, E);
    }
    SEAM(4);

    if (IN(5)) {
        __syncthreads();
        pg8::StaticOrder S; S.init(M, 1024, G, bx);
        { pg8::Gemm g{(const bf16*)(ws + WS_Y2), (const bf16*)(ws + WS_WSSM), M, 1024, 512, 512, 512, wave};
          pg8::EpiBranch<0> E{(const bf16*)(ws + WS_GATES), (bf16*)(ws + WS_MG), 0}; pg8::gemm_phase(lds, g, S, E); }
        { pg8::Gemm g{(const bf16*)(ws + WS_OMRG), (const bf16*)(ws + WS_WATT), M, 1024, 256, 256, 256, wave};
          pg8::EpiBranch<1> E{(const bf16*)(ws + WS_GATES), (bf16*)(ws + WS_MG), 1024}; pg8::gemm_phase(lds, g, S, E); }
        { pg8::Gemm g{(const bf16*)(ws + WS_MQ), (const bf16*)(ws + WS_WMEM), M, 1024, 512, 512, 512, wave};
          pg8::EpiBranch<1> E{(const bf16*)(ws + WS_GATES), (bf16*)(ws + WS_MG), 2048}; pg8::gemm_phase(lds, g, S, E); }
    }
    SEAM(5);

    if (IN(6)) {
        __syncthreads();
        pg8::Gemm g{(const bf16*)(ws + WS_MG), (const bf16*)(ws + WS_WO), M, 1024, 1024, 1024, 1024, wave}; pg8::StaticOrder S; S.init(M, 1024, G, bx);
        pg8::EpiResid<0> E{args.in[0], (bf16*)(ws + WS_HB), (float*)(ws + WS_SSP1)}; pg8::gemm_phase(lds, g, S, E);
    }
    SEAM(6);

    if (IN(7)) {
        __syncthreads();
        pg8::Gemm g{(const bf16*)(ws + WS_HB), (const bf16*)(ws + WS_WUP), M, FF, 1024, 1024, 1024, wave}; pg8::StaticOrder S; S.init(M, FF, G, bx);
        pg8::EpiUp E{(const float*)(ws + WS_SSP1), (bf16*)(ws + WS_ACT)};
        pg8::gemm_phase(lds, g, S, E);
        if (PROBE_G7 > 1) pg8::gemm_phase(lds, g, S, E);
    }
    SEAM(7);

    if (IN(8)) {
        __syncthreads();
        pg8::Gemm g{(const bf16*)(ws + WS_ACT), (const bf16*)(ws + WS_WDN), M, 1024, FF, FF, FF, wave}; pg8::StaticOrder S; S.init(M, 1024, G, bx);
        pg8::EpiResid<1> E{nullptr, (bf16*)(ws + WS_HB), (float*)(ws + WS_SSP2)}; pg8::gemm_phase(lds, g, S, E);
    }
    SEAM(8);

    if (IN(9)) {
        const f32x4* gr = (const f32x4*)args.in[24];
        const int c8a = lane * 8, c8b = (lane + 64) * 8;
        const f32x4 ga0 = gr[c8a / 4], ga1 = gr[c8a / 4 + 1], gb0 = gr[c8b / 4], gb1 = gr[c8b / 4 + 1];
        for (int m = gw * 4; m < M; m += NGW * 4) {
            float pv[4]; v4u ha[4], hb4[4];
#pragma unroll
            for (int r = 0; r < 4; ++r) { pv[r] = (lane < 16) ? ((const float*)(ws + WS_SSP2))[(size_t)(m + r) * 16 + lane] : 0.f;
                const bf16* hr = (const bf16*)(ws + WS_HB) + (size_t)(m + r) * D; ha[r] = *(const v4u*)(hr + c8a); hb4[r] = *(const v4u*)(hr + c8b); }
#pragma unroll
            for (int r = 0; r < 4; ++r) { const float rs = 1.0f / sqrtf(wave_sum(pv[r]) * (1.f / 1024.f) + 1e-6f);
                f32x4* xr = (f32x4*)(args.out + (size_t)(m + r) * D); pg8::f32x4 v0, v1;
                pg8::unpack8(ha[r], v0, v1); xr[c8a / 4] = v0 * rs * ga0; xr[c8a / 4 + 1] = v1 * rs * ga1;
                pg8::unpack8(hb4[r], v0, v1); xr[c8b / 4] = v0 * rs * gb0; xr[c8b / 4 + 1] = v1 * rs * gb1; } }
    }
#undef IN
#undef SEAM
}

#ifndef DBG_PH
#define DBG_PH 0
#endif
struct DumpSeg { size_t off; unsigned n; unsigned pad; };
struct DumpArgs { float* out; const unsigned char* ws; DumpSeg s[6]; };
__global__ void dbg_dump(DumpArgs a) {
    size_t base = 0;
    float mag = 1e12f;
    for (int k = 0; k < 6; ++k, mag *= 0.1f) { const unsigned short* src = (const unsigned short*)(a.ws + a.s[k].off);
        for (size_t i = (size_t)blockIdx.x * blockDim.x + threadIdx.x; i < a.s[k].n; i += (size_t)gridDim.x * blockDim.x) a.out[base + i] = ((src[i] & 0x7f80u) == 0x7f80u) ? mag : 0.f;
        base += a.s[k].n; }
    for (size_t i = base + (size_t)blockIdx.x * blockDim.x + threadIdx.x; i < (size_t)M * D; i += (size_t)gridDim.x * blockDim.x) a.out[i] = 0.f;
}
extern "C" void kernel_launch(void* const* d_in, const int* in_sizes, int n_in, void* d_out, int out_size, void* d_ws, size_t ws_size, hipStream_t stream) {
    static int grid = 0;
    if (grid == 0) {
        if (n_in != 25 || out_size != M * D || ws_size < WS_END) { fprintf(stderr, "kernel_launch: unexpected shapes (n_in %d out %d ws %zu)\n", n_in, out_size, ws_size); grid = -1; return; }
        int dev = 0, cus = 0, per_cu = 0;
        if (hipGetDevice(&dev) != hipSuccess || hipDeviceGetAttribute(&cus, hipDeviceAttributeMultiprocessorCount, dev) != hipSuccess) { grid = -1; return; }
        if (hipOccupancyMaxActiveBlocksPerMultiprocessor(&per_cu, (const void*)fwd_megakernel, NWAVES * 64, 0) != hipSuccess || per_cu < 1) { fprintf(stderr, "kernel_launch: occupancy query says %d\n", per_cu); per_cu = 1; }
        (void)hipGetLastError();
        grid = cus;
    }
    if (grid < 0) return;
    Args a{};
    for (int i = 0; i < 25; ++i) a.in[i] = (const float*)d_in[i];
    a.out = (float*)d_out; a.ws = (unsigned char*)d_ws;
#if MK_N_LAUNCHES == 1
    if (hipMemsetAsync(d_ws, 0, 65536, stream) != hipSuccess) { fprintf(stderr, "kernel_launch: memset of the barrier words failed\n"); return; }
    a.ph_lo = 0; a.ph_hi = N_PHASES;
    void* kargs[] = {&a};
    hipError_t e = hipLaunchCooperativeKernel((const void*)fwd_megakernel, dim3(grid), dim3(NWAVES * 64), kargs, 0, stream);
    if (e != hipSuccess) fprintf(stderr, "kernel_launch: cooperative launch failed: %s (grid %d)\n", hipGetErrorString(e), grid);
#else
    const int np = DBG_PH ? DBG_PH + 1 : N_PHASES;
    for (int p = 0; p < np; ++p) { a.ph_lo = p; a.ph_hi = p + 1; hipLaunchKernelGGL(fwd_megakernel, dim3(grid), dim3(NWAVES * 64), 0, stream, a); }
#if DBG_PH && DBG_PH < 8
    { DumpArgs da{}; da.out = (float*)d_out; da.ws = (const unsigned char*)d_ws;
      DBG_SEGS
      hipLaunchKernelGGL(dbg_dump, dim3(2048), dim3(256), 0, stream, da); }
#endif
#endif
}
```

```cpp
#include <hip/hip_runtime.h>
#include <hip/hip_cooperative_groups.h>
#include <cstdio>
#include <cstdint>
namespace cg = cooperative_groups;

#define DBG_PH 0
#define DBG_SEGS da.s[0] = {WS_GATES, 12u << 20, 0}; da.s[1] = {WS_OG, 12u << 20, 0}; da.s[2] = {WS_MQ, 12u << 20, 0}; da.s[3] = {WS_YG, 8u << 20, 0}; da.s[4] = {WS_OMRG, 8u << 20, 0}; da.s[5] = {WS_MG, 12u << 20, 0};
#ifndef PROBE_G7
#define PROBE_G7 1
#endif
#ifndef PROBE_REP
#define PROBE_REP 1
#define PROBE_P3 1
#endif
#ifndef MK_N_LAUNCHES
#define MK_N_LAUNCHES 1
#endif

__device__ __forceinline__ int lane_id() { int l; asm volatile("v_mbcnt_lo_u32_b32 %0, -1, 0\n\tv_mbcnt_hi_u32_b32 %0, -1, %0" : "=v"(l)); return l; }

namespace pg8 {
#define PG8_LAS __attribute__((address_space(3)))
typedef unsigned short bf16_t;
typedef short bf16x8 __attribute__((ext_vector_type(8)));
typedef float f32x4 __attribute__((ext_vector_type(4)));
typedef unsigned u32x4 __attribute__((ext_vector_type(4)));
constexpr int BM = 256, BK = 64, HALF = 128, HTB = HALF * BK * 2, STAGE_BYTES = 8 * HTB, NXCD = 8, WGM = 8;

__host__ __device__ __forceinline__ int lds_byte(int r, int c) { const int st = (r >> 4) * 2 + (c >> 5), rr = r & 15, cc = c & 31, ob = rr * 64 + cc * 2; return st * 1024 + (ob ^ (((ob >> 9) & 1) << 5)); }
__host__ __device__ __forceinline__ void stage_rc(int b, int& R, int& C) { const int st = b / 1024, sb = b % 1024, swz = sb ^ (((sb >> 9) & 1) << 5); R = (st >> 1) * 16 + swz / 64; C = (st & 1) * 32 + (swz % 64) / 2; }
__host__ __device__ __forceinline__ int perm32(int rho) { const int n = rho >> 4, i = rho & 15; return 8 * (i >> 2) + 4 * n + (i & 3); }

struct Unit { int pm, pn; };
struct Gemm { const bf16_t* A; const bf16_t* Bt; int M, N, K; int lda, ldb; int wid; };
__device__ __forceinline__ const char* a_tile(const Gemm& g, int pm) { return (const char*)g.A + (size_t)pm * 256 * (size_t)g.lda * 2; }
template <int BDIL> __device__ __forceinline__ const char* b_tile(const Gemm& g, int pn) {
    if (BDIL == 0) return (const char*)g.Bt + (size_t)pn * 256 * (size_t)g.ldb * 2;
    constexpr int Ld = BDIL ? 8192 / BDIL : 1; const int b = pn >> 5, pp0 = (pn & 31) * 256, r = pp0 / Ld, j0 = pp0 % Ld;
    return (const char*)g.Bt + ((size_t)b * 8192 + (size_t)j0 * BDIL + r) * 1024 * 2;
}

struct StaticOrder {
    int nM, nN, nwg, G, c;
    __host__ __device__ void init(int M, int N, int G_, int c_) { nM = M / BM; nN = N / BM; nwg = nM * nN; G = G_; c = c_; }
    __host__ __device__ bool next(int i, Unit& u) const {
        const long L = (long)i * G + c; if (L >= nwg) return false;
        int wgid = (int)L; { const int q = nwg / NXCD, r = nwg % NXCD, xcd = wgid % NXCD, off = wgid / NXCD; wgid = (xcd < r ? xcd * (q + 1) : r * (q + 1) + (xcd - r) * q) + off; }
        const int nig = WGM * nN, gid = wgid / nig, fm = gid * WGM, gsz = (nM - fm) < WGM ? (nM - fm) : WGM;
        u.pm = fm + ((wgid % nig) % gsz); u.pn = (wgid % nig) / gsz; return true;
    }
};

typedef float f32x2_ __attribute__((ext_vector_type(2))); typedef __bf16 bf16x2_ __attribute__((ext_vector_type(2)));
__device__ __forceinline__ unsigned cvt_pk_bf16(float lo, float hi) { f32x2_ v = {lo, hi}; bf16x2_ b = __builtin_convertvector(v, bf16x2_); return __builtin_bit_cast(unsigned, b); }
__device__ __forceinline__ float bf_lo(unsigned w) { return __builtin_bit_cast(float, w << 16); }
__device__ __forceinline__ float bf_hi(unsigned w) { return __builtin_bit_cast(float, w & 0xffff0000u); }
__device__ __forceinline__ u32x4 pack8(const f32x4 v0, const f32x4 v1) { u32x4 w; w.x = cvt_pk_bf16(v0[0], v0[1]); w.y = cvt_pk_bf16(v0[2], v0[3]); w.z = cvt_pk_bf16(v1[0], v1[1]); w.w = cvt_pk_bf16(v1[2], v1[3]); return w; }
__device__ __forceinline__ void unpack8(const u32x4 w, f32x4& v0, f32x4& v1) { v0 = (f32x4){bf_lo(w.x), bf_hi(w.x), bf_lo(w.y), bf_hi(w.y)}; v1 = (f32x4){bf_lo(w.z), bf_hi(w.z), bf_lo(w.w), bf_hi(w.w)}; }
__device__ __forceinline__ float sigm(float x) { return __builtin_amdgcn_rcpf(1.f + __builtin_amdgcn_exp2f(-1.4426950408889634f * x)); }

#define EPI_LOOP _Pragma("unroll") for (int ai = 0; ai < 2; ++ai) _Pragma("unroll") for (int m = 0; m < 4; ++m) _Pragma("unroll") for (int bj = 0; bj < 2; ++bj)
#define EPI_ROW (u.pm * 256 + ai * 128 + wr * 64 + m * 16 + fr)
#define EPI_COL (u.pn * 256 + bj * 128 + wc * 32 + 8 * fq)
typedef f32x4 AccT[2][2][4][2];

struct EpiPlain {
    bf16_t* O; size_t ldc;
    __device__ __forceinline__ void operator()(const AccT& acc, const Unit& u, int wr, int wc, int fr, int fq) const {
        EPI_LOOP { const int row = EPI_ROW, col = EPI_COL; *(u32x4*)(O + (size_t)row * ldc + col) = pack8(acc[ai][bj][m][0], acc[ai][bj][m][1]); }
    }
};
struct EpiVTf {
    bf16_t* O; int mem; int g;
    __device__ __forceinline__ void operator()(const AccT& acc, const Unit& u, int wr, int wc, int fr, int fq) const {
        EPI_LOOP { const int row = EPI_ROW, col = EPI_COL;
            int e, kk; size_t tb;
            if (mem) { const int h = row >> 7, b = col >> 8; e = row & 127; kk = col & 255; tb = ((size_t)((b * 4 + h) * 8 + (kk >> 5))) * 4096; }
            else { const int hh = row >> 6, b = col >> 13; e = row & 63; kk = col & 8191; tb = (((size_t)(g * 8 + b) * 4 + hh) * 8192) * 64 + (size_t)(kk >> 5) * 2048; }
            const int t = e >> 5, c = e & 31, k0 = kk & 31, s2 = k0 >> 4, half = (k0 >> 3) & 1;
            bf16_t* d0 = O + tb + (((t * 2 + s2) * 2 + 0) * 32 + c) * 8 + half * 4;
            const f32x4 v0 = acc[ai][bj][m][0], v1 = acc[ai][bj][m][1];
            typedef unsigned u32x2 __attribute__((ext_vector_type(2)));
            u32x2 w0, w1; w0.x = cvt_pk_bf16(v0[0], v0[1]); w0.y = cvt_pk_bf16(v0[2], v0[3]); w1.x = cvt_pk_bf16(v1[0], v1[1]); w1.y = cvt_pk_bf16(v1[2], v1[3]);
            *(u32x2*)d0 = w0; *(u32x2*)(d0 + 256) = w1; }
    }
};
struct EpiMKf {
    bf16_t* O;
    __device__ __forceinline__ void operator()(const AccT& acc, const Unit& u, int wr, int wc, int fr, int fq) const {
        EPI_LOOP { const int row = EPI_ROW, col = EPI_COL; const int b = row >> 8, key = row & 255, h = col >> 7, e = col & 127;
            *(u32x4*)(O + ((size_t)((b * 4 + h) * 8 + (key >> 5))) * 4096 + (((e >> 4) * 2 + ((e >> 3) & 1)) * 32 + (key & 31)) * 8) = pack8(acc[ai][bj][m][0], acc[ai][bj][m][1]); }
    }
};
struct EpiInProj {
    bf16_t *U, *Q, *Kb, *MQ, *GATES; const float* b_gate;
    __device__ __forceinline__ void operator()(const AccT& acc, const Unit& u, int wr, int wc, int fr, int fq) const {
        const int pn = u.pn;
        if (pn < 2) { EPI_LOOP { const int row = EPI_ROW, col = EPI_COL; *(u32x4*)(U + (size_t)row * 512 + col) = pack8(acc[ai][bj][m][0], acc[ai][bj][m][1]); } }
        else if (pn < 8) {
            const int g = (pn < 5) ? pn - 2 : pn - 5; bf16_t* base = (pn < 5) ? Q : Kb; const int sh = 2 * g  , Ld = 8192 >> sh, dm = (1 << sh) - 1;
            const bool isk = (pn >= 5);
            EPI_LOOP { const int row = EPI_ROW, colw = bj * 128 + wc * 32 + 8 * fq; const int hh = colw >> 6, e = colw & 63, b = row >> 13, t = row & 8191;
                const int pp = (t & dm) * Ld + (t >> sh);
                const size_t hbase = (((size_t)(g * 8 + b) * 4 + hh) * 8192) * 64;
                const size_t off = isk ? hbase + (size_t)(pp >> 5) * 2048 + ((((e >> 4) * 2 + ((e >> 3) & 1)) * 32 + (pp & 31)) * 8) : hbase + (size_t)pp * 64 + e;
                *(u32x4*)(base + off) = pack8(acc[ai][bj][m][0], acc[ai][bj][m][1]); }
        }
        else if (pn < 10) { EPI_LOOP { const int row = EPI_ROW, col = EPI_COL - 2048; *(u32x4*)(MQ + (size_t)row * 512 + col) = pack8(acc[ai][bj][m][0], acc[ai][bj][m][1]); } }
        else {
            f32x4 bb0[2], bb1[2];
#pragma unroll
            for (int bj = 0; bj < 2; ++bj) { const int col = EPI_COL - 2560; bb0[bj] = *(const f32x4*)(b_gate + col); bb1[bj] = *(const f32x4*)(b_gate + col + 4); }
            EPI_LOOP { const int row = EPI_ROW, col = EPI_COL - 2560;
                f32x4 v0 = acc[ai][bj][m][0] + bb0[bj], v1 = acc[ai][bj][m][1] + bb1[bj];
#pragma unroll
                for (int i = 0; i < 4; ++i) { v0[i] = sigm(v0[i]); v1[i] = sigm(v1[i]); }
                *(u32x4*)(GATES + (size_t)row * 3072 + col) = pack8(v0, v1); }
        }
    }
};
struct EpiGlu {
    const bf16_t* YG; bf16_t* Y2; const float* b;
    __device__ __forceinline__ void operator()(const AccT& acc, const Unit& u, int wr, int wc, int fr, int fq) const {
        f32x4 bb0[2], bb1[2];
#pragma unroll
        for (int bj = 0; bj < 2; ++bj) { const int col = EPI_COL; bb0[bj] = *(const f32x4*)(b + col); bb1[bj] = *(const f32x4*)(b + col + 4); }
#pragma unroll
        for (int ai = 0; ai < 2; ++ai) {
            u32x4 yv[4][2];
#pragma unroll
            for (int m = 0; m < 4; ++m)
#pragma unroll
                for (int bj = 0; bj < 2; ++bj) { const int row = EPI_ROW, col = EPI_COL; yv[m][bj] = *(const u32x4*)(YG + (size_t)row * 512 + col); }
#pragma unroll
            for (int m = 0; m < 4; ++m)
#pragma unroll
                for (int bj = 0; bj < 2; ++bj) { const int row = EPI_ROW, col = EPI_COL;
                    f32x4 y0, y1; unpack8(yv[m][bj], y0, y1);
                    f32x4 v0 = acc[ai][bj][m][0] + bb0[bj], v1 = acc[ai][bj][m][1] + bb1[bj];
#pragma unroll
                    for (int i = 0; i < 4; ++i) { v0[i] = y0[i] * sigm(v0[i]); v1[i] = y1[i] * sigm(v1[i]); }
                    *(u32x4*)(Y2 + (size_t)row * 512 + col) = pack8(v0, v1); }
        }
    }
};
template <int MODE> struct EpiBranch {
    const bf16_t* GATES; bf16_t* MG; int goff;
    __device__ __forceinline__ void operator()(const AccT& acc, const Unit& u, int wr, int wc, int fr, int fq) const {
#pragma unroll
        for (int ai = 0; ai < 2; ++ai) {
            u32x4 gv[4][2], pv[4][2];
#pragma unroll
            for (int m = 0; m < 4; ++m)
#pragma unroll
                for (int bj = 0; bj < 2; ++bj) { const int row = EPI_ROW, col = EPI_COL; gv[m][bj] = *(const u32x4*)(GATES + (size_t)row * 3072 + goff + col);
                    if (MODE == 1) pv[m][bj] = *(const u32x4*)(MG + (size_t)row * 1024 + col); }
#pragma unroll
            for (int m = 0; m < 4; ++m)
#pragma unroll
                for (int bj = 0; bj < 2; ++bj) { const int row = EPI_ROW, col = EPI_COL; f32x4 g0, g1; unpack8(gv[m][bj], g0, g1);
                    f32x4 v0 = acc[ai][bj][m][0] * g0, v1 = acc[ai][bj][m][1] * g1;
                    if (MODE == 1) { f32x4 p0, p1; unpack8(pv[m][bj], p0, p1); v0 += p0; v1 += p1; }
                    *(u32x4*)(MG + (size_t)row * 1024 + col) = pack8(v0, v1); }
        }
    }
};
template <int MODE> struct EpiResid {
    const float* X; bf16_t* HB; float* SS;
    __device__ __forceinline__ void operator()(const AccT& acc, const Unit& u, int wr, int wc, int fr, int fq) const {
#pragma unroll
        for (int ai = 0; ai < 2; ++ai) {
            f32x4 ra[4][2], rb[4][2]; u32x4 hv[4][2];
#pragma unroll
            for (int m = 0; m < 4; ++m)
#pragma unroll
                for (int bj = 0; bj < 2; ++bj) { const int row = EPI_ROW, col = EPI_COL; const size_t o = (size_t)row * 1024 + col;
                    if (MODE == 0) { ra[m][bj] = *(const f32x4*)(X + o); rb[m][bj] = *(const f32x4*)(X + o + 4); } else hv[m][bj] = *(const u32x4*)(HB + o); }
#pragma unroll
            for (int m = 0; m < 4; ++m) { const int row = EPI_ROW; float ss = 0.f;
#pragma unroll
                for (int bj = 0; bj < 2; ++bj) { const int col = EPI_COL; const size_t o = (size_t)row * 1024 + col;
                    f32x4 r0, r1;
                    if (MODE == 0) { r0 = ra[m][bj]; r1 = rb[m][bj]; } else unpack8(hv[m][bj], r0, r1);
                    const f32x4 v0 = acc[ai][bj][m][0] + r0, v1 = acc[ai][bj][m][1] + r1;
                    *(u32x4*)(HB + o) = pack8(v0, v1);
                    ss += (v0[0] * v0[0] + v0[1] * v0[1]) + (v0[2] * v0[2] + v0[3] * v0[3]) + (v1[0] * v1[0] + v1[1] * v1[1]) + (v1[2] * v1[2] + v1[3] * v1[3]); }
                ss += __shfl_xor(ss, 16); ss += __shfl_xor(ss, 32);
                if (fq == 0) SS[(size_t)row * 16 + u.pn * 4 + wc] = ss; }
        }
    }
};
struct EpiUp {
    const float* SS; bf16_t* ACT;
    __device__ __forceinline__ void operator()(const AccT& acc, const Unit& u, int wr, int wc, int fr, int fq) const {
        float rsv[2][4];
#pragma unroll
        for (int ai = 0; ai < 2; ++ai) { f32x4 q[4][4];
#pragma unroll
            for (int m = 0; m < 4; ++m) { const int row = EPI_ROW; const f32x4* sp = (const f32x4*)(SS + (size_t)row * 16);
#pragma unroll
                for (int k = 0; k < 4; ++k) q[m][k] = sp[k]; }
#pragma unroll
            for (int m = 0; m < 4; ++m) { const float tot = ((q[m][0][0] + q[m][0][1]) + (q[m][0][2] + q[m][0][3])) + ((q[m][1][0] + q[m][1][1]) + (q[m][1][2] + q[m][1][3])) + ((q[m][2][0] + q[m][2][1]) + (q[m][2][2] + q[m][2][3])) + ((q[m][3][0] + q[m][3][1]) + (q[m][3][2] + q[m][3][3]));
                rsv[ai][m] = 1.0f / sqrtf(tot * (1.f / 1024.f) + 1e-6f); } }
#pragma unroll
        for (int ai = 0; ai < 2; ++ai)
#pragma unroll
            for (int m = 0; m < 4; ++m) { const int row = EPI_ROW; const float rs = rsv[ai][m];
#pragma unroll
                for (int bj = 0; bj < 2; ++bj) { const int col = EPI_COL; f32x4 v0 = acc[ai][bj][m][0] * rs, v1 = acc[ai][bj][m][1] * rs;
#pragma unroll
                    for (int i = 0; i < 4; ++i) { const float a = fmaxf(v0[i], 0.f), b = fmaxf(v1[i], 0.f); v0[i] = a * a; v1[i] = b * b; }
                    *(u32x4*)(ACT + (size_t)row * 4096 + col) = pack8(v0, v1); } }
    }
};

template <class Epi, int BDIL = 0>
__device__ __forceinline__ void gemm_phase(PG8_LAS unsigned char* lds, const Gemm g, const StaticOrder& S, const Epi& E) {
    const int wid = g.wid, lane = lane_id(), tid = wid * 64 + lane, wr = wid >> 2, wc = wid & 3, fr = lane & 15, fq = lane >> 4;
    const int K = g.K, nt = K / BK;
    unsigned voffA[2], voffB[2];
#pragma unroll
    for (int i = 0; i < 2; ++i) { int R, C; stage_rc(tid * 16 + i * 8192, R, C); const int Rb = (R & ~31) + perm32(R & 31);
        voffA[i] = (unsigned)(R * g.lda + C) * 2u; voffB[i] = (unsigned)(Rb * g.ldb + C) * 2u; }
    const size_t kstep = (size_t)(BK * 2);
    const size_t hstepA = (size_t)HALF * g.lda * 2, hstepB = (size_t)HALF * g.ldb * 2;
    const unsigned ldsw = (unsigned)wid * 1024u;
    const int aoff = lds_byte(wr * 64 + fr, fq * 8), boff = lds_byte(wc * 32 + fr, fq * 8);
#define PG8_SA(b, h) (((b) * 2 + (h)) * HTB)
#define PG8_SB(b, h) ((4 + (b) * 2 + (h)) * HTB)
#define PG8_STAGE(bufoff, gbase, voff) do { _Pragma("unroll") for (int _i = 0; _i < 2; ++_i) \
        __builtin_amdgcn_global_load_lds((const unsigned*)((const char*)(gbase) + (voff)[_i]), (PG8_LAS unsigned*)(lds + (bufoff) + ldsw + _i * 8192), 16, 0, 0); } while (0)
#define PG8_LDA(dst, b, h) do { _Pragma("unroll") for (int m = 0; m < 4; ++m) _Pragma("unroll") for (int k = 0; k < 2; ++k) dst[m][k] = *(const PG8_LAS bf16x8*)(lds + PG8_SA(b, h) + aoff + m * 2048 + k * 1024); } while (0)
#define PG8_LDB(dst, b, h) do { _Pragma("unroll") for (int n = 0; n < 2; ++n) _Pragma("unroll") for (int k = 0; k < 2; ++k) dst[n][k] = *(const PG8_LAS bf16x8*)(lds + PG8_SB(b, h) + boff + n * 2048 + k * 1024); } while (0)
#define PG8_MMA(ai, bj, At, Bt) do { __builtin_amdgcn_s_setprio(1); _Pragma("unroll") for (int m = 0; m < 4; ++m) _Pragma("unroll") for (int n = 0; n < 2; ++n) _Pragma("unroll") for (int k = 0; k < 2; ++k) \
        acc[ai][bj][m][n] = __builtin_amdgcn_mfma_f32_16x16x32_bf16(Bt[n][k], At[m][k], acc[ai][bj][m][n], 0, 0, 0); __builtin_amdgcn_s_setprio(0); } while (0)
#define PG8_WAIT_V(n) asm volatile("s_waitcnt vmcnt(" #n ")" ::: "memory")
#define PG8_WAIT_L(n) asm volatile("s_waitcnt lgkmcnt(" #n ")" ::: "memory")
#define PG8_BAR __builtin_amdgcn_s_barrier()
#define PG8_SCHED __builtin_amdgcn_sched_barrier(0)
    Unit cur, nxt; int ui = 0;
    if (!S.next(0, cur)) return;
    f32x4 acc[2][2][4][2];
#pragma unroll
    for (int a = 0; a < 2; ++a)
#pragma unroll
        for (int b = 0; b < 2; ++b)
#pragma unroll
            for (int m = 0; m < 4; ++m)
#pragma unroll
                for (int n = 0; n < 2; ++n) acc[a][b][m][n] = (f32x4){0.f, 0.f, 0.f, 0.f};
    bf16x8 At[4][2], B0[2][2], B1[2][2];
    const char* cA = a_tile(g, cur.pm); const char* cB = b_tile<BDIL>(g, cur.pn);
    PG8_STAGE(PG8_SB(0, 0), cB, voffB); PG8_STAGE(PG8_SB(0, 1), cB + hstepB, voffB); PG8_STAGE(PG8_SA(0, 0), cA, voffA); PG8_STAGE(PG8_SA(0, 1), cA + hstepA, voffA);
    if (wr == 1) PG8_BAR;
    PG8_WAIT_V(2); PG8_BAR;
    PG8_STAGE(PG8_SB(1, 0), cB + kstep, voffB); PG8_STAGE(PG8_SA(1, 0), cA + kstep, voffA); PG8_STAGE(PG8_SB(1, 1), cB + hstepB + kstep, voffB);
    PG8_WAIT_V(6); PG8_BAR;
    for (;;) {
        const bool has_next = S.next(ui + 1, nxt);
        const char* nA = has_next ? a_tile(g, nxt.pm) : cA; const char* nB = has_next ? b_tile<BDIL>(g, nxt.pn) : cB;
        for (int t = 0; t < nt; t += 2) {
            const bool last = (t == nt - 2);
            const char* a1 = cA + (size_t)(t + 1) * kstep;
            const char* a2 = last ? nA : cA + (size_t)(t + 2) * kstep; const char* b2 = last ? nB : cB + (size_t)(t + 2) * kstep;
            const char* a3 = a2 + kstep; const char* b3 = b2 + kstep;
            PG8_LDB(B0, 0, 0); PG8_LDB(B1, 0, 1); PG8_SCHED; PG8_LDA(At, 0, 0); PG8_STAGE(PG8_SA(1, 1), a1 + hstepA, voffA);
            PG8_WAIT_V(8); PG8_WAIT_L(0); PG8_BAR; PG8_MMA(0, 0, At, B0); PG8_MMA(0, 1, At, B1); PG8_BAR; PG8_SCHED;
            PG8_LDA(At, 0, 1); PG8_STAGE(PG8_SB(0, 0), b2, voffB); PG8_STAGE(PG8_SB(0, 1), b2 + hstepB, voffB); PG8_STAGE(PG8_SA(0, 0), a2, voffA);
            PG8_WAIT_V(8); PG8_WAIT_L(0); PG8_BAR; PG8_MMA(1, 0, At, B0); PG8_MMA(1, 1, At, B1); PG8_BAR; PG8_SCHED;
            PG8_LDB(B0, 1, 0); PG8_LDB(B1, 1, 1); PG8_SCHED; PG8_LDA(At, 1, 0); PG8_STAGE(PG8_SA(0, 1), a2 + hstepA, voffA);
            PG8_WAIT_V(8); PG8_WAIT_L(0); PG8_BAR; PG8_MMA(0, 0, At, B0); PG8_MMA(0, 1, At, B1); PG8_BAR; PG8_SCHED;
            PG8_LDA(At, 1, 1); PG8_STAGE(PG8_SB(1, 0), b3, voffB); PG8_STAGE(PG8_SB(1, 1), b3 + hstepB, voffB); PG8_STAGE(PG8_SA(1, 0), a3, voffA);
            PG8_WAIT_V(8); PG8_WAIT_L(0); PG8_BAR; PG8_MMA(1, 0, At, B0); PG8_MMA(1, 1, At, B1); PG8_BAR; PG8_SCHED;
        }
        if (wr == 0) PG8_BAR;
        E(acc, cur, wr, wc, fr, fq);
        if (!has_next) break;
#pragma unroll
        for (int a = 0; a < 2; ++a)
#pragma unroll
            for (int b = 0; b < 2; ++b)
#pragma unroll
                for (int m = 0; m < 4; ++m)
#pragma unroll
                    for (int n = 0; n < 2; ++n) acc[a][b][m][n] = (f32x4){0.f, 0.f, 0.f, 0.f};
        cur = nxt; cA = nA; cB = nB; ++ui;
        if (wr == 1) PG8_BAR;
    }
    PG8_WAIT_V(0);
    PG8_BAR;
#undef PG8_SA
#undef PG8_SB
#undef PG8_STAGE
#undef PG8_LDA
#undef PG8_LDB
#undef PG8_MMA
#undef PG8_WAIT_V
#undef PG8_WAIT_L
#undef PG8_BAR
#undef PG8_SCHED
}
}

constexpr int NWAVES = 8;
constexpr int BATCH = 8, SEQ = 8192, D = 1024, M = BATCH * SEQ, FF = 4096;
constexpr int NIN = 5632;
constexpr int N_PHASES = 10;

constexpr size_t MiB = 1u << 20;
constexpr size_t WS_BAR = 0;
constexpr size_t WS_SSMA = 512 * 1024;
constexpr size_t WS_SSMB = 576 * 1024;
constexpr size_t WS_SSMC = 704 * 1024;
constexpr size_t WS_WIN = 2 * MiB;
constexpr size_t WS_WV = 13 * MiB;
constexpr size_t WS_WGLU = 15 * MiB;
constexpr size_t WS_WSSM = 16 * MiB;
constexpr size_t WS_WATT = 17 * MiB;
constexpr size_t WS_WMKV = 18 * MiB;
constexpr size_t WS_WMEM = 20 * MiB;
constexpr size_t WS_WO = 21 * MiB;
constexpr size_t WS_WUP = 23 * MiB;
constexpr size_t WS_WDN = 31 * MiB;
constexpr size_t WS_MEMN = 40 * MiB;
constexpr size_t WS_MK = 44 * MiB;
constexpr size_t WS_MVT = 46 * MiB;
constexpr size_t WS_E = 48 * MiB;
constexpr size_t WS_SSP1 = 56 * MiB, WS_SSP2 = 60 * MiB;
constexpr size_t WS_XN = 64 * MiB;
constexpr size_t WS_OG = 64 * MiB, WS_LSE = 160 * MiB;
constexpr size_t WS_U = 192 * MiB;
constexpr size_t WS_MQ = 256 * MiB;
constexpr size_t WS_HB = 192 * MiB;
constexpr size_t WS_GATES = 320 * MiB;
constexpr size_t WS_Q = 704 * MiB, WS_K = 800 * MiB, WS_VT = 896 * MiB;
constexpr size_t WS_YG = 192 * MiB;
constexpr size_t WS_Y2 = 768 * MiB, WS_OMRG = 832 * MiB, WS_MG = 864 * MiB;
constexpr size_t WS_ACT = 320 * MiB;
constexpr size_t WS_END = 992 * MiB;

constexpr int LDS_BYTES = 147456;

#define LAS __attribute__((address_space(3)))
typedef unsigned short bf16;
typedef unsigned v4u __attribute__((ext_vector_type(4)));
typedef unsigned v2u __attribute__((ext_vector_type(2)));
typedef float f32x4 __attribute__((ext_vector_type(4)));
typedef float f32x2 __attribute__((ext_vector_type(2)));
typedef float f32x16 __attribute__((ext_vector_type(16)));
typedef short bf16x8 __attribute__((ext_vector_type(8)));
typedef short s16x4 __attribute__((ext_vector_type(4)));
typedef __bf16 bf16x2_t __attribute__((ext_vector_type(2)));
__device__ __forceinline__ unsigned cvtpk(float lo, float hi) { f32x2 v = {lo, hi}; bf16x2_t b = __builtin_convertvector(v, bf16x2_t); return __builtin_bit_cast(unsigned, b); }
__device__ __forceinline__ float wave_sum(float v) {
#pragma unroll
    for (int o = 1; o < 64; o <<= 1) v += __shfl_xor(v, o);
    return v;
}
__device__ __forceinline__ float bf2f(bf16 b) { return __builtin_bit_cast(float, (unsigned)b << 16); }

struct Args { const float* in[25]; float* out; unsigned char* ws; int ph_lo, ph_hi; };

__device__ __forceinline__ void p0_transpose_item(const float* W, int ldw, int c0, int K, int nblk, bf16* WT, int row_off, const float* scale, LAS float* scr, int item, int lane) {
    const int kb = item / nblk, nb = item % nblk, k0 = 64 * kb, n0 = 32 * nb;
#pragma unroll 8
    for (int i = 0; i < 32; ++i) { const int kk = 2 * i + (lane >> 5); float v = W[(size_t)(k0 + kk) * ldw + c0 + n0 + (lane & 31)]; if (scale) v *= scale[k0 + kk]; scr[kk * 33 + (lane & 31)] = v; }
    asm volatile("s_waitcnt lgkmcnt(0)" ::: "memory");
    const int c = lane & 7;
#pragma unroll
    for (int j = 0; j < 4; ++j) { const int n = (lane >> 3) + 8 * j; const LAS float* s = scr + (8 * c) * 33 + n;
        v4u o; o.x = cvtpk(s[0 * 33], s[1 * 33]); o.y = cvtpk(s[2 * 33], s[3 * 33]); o.z = cvtpk(s[4 * 33], s[5 * 33]); o.w = cvtpk(s[6 * 33], s[7 * 33]);
        *(v4u*)(WT + (size_t)(row_off + n0 + n) * K + k0 + 8 * c) = o; }
    asm volatile("s_waitcnt lgkmcnt(0)" ::: "memory");
}
template <int NR>
__device__ __forceinline__ void rms_rows_to_bf16(const float* xrow, size_t rs, const float* g, bf16* orow, int lane) {
    const f32x4* gr = (const f32x4*)g + lane;
    f32x4 v[NR][4]; float s[NR];
#pragma unroll
    for (int r = 0; r < NR; ++r) { const f32x4* xr = (const f32x4*)(xrow + r * rs) + lane; s[r] = 0.f;
#pragma unroll
        for (int j = 0; j < 4; ++j) v[r][j] = xr[64 * j]; }
    f32x4 gg[4];
#pragma unroll
    for (int j = 0; j < 4; ++j) gg[j] = gr[64 * j];
#pragma unroll
    for (int r = 0; r < NR; ++r) {
#pragma unroll
        for (int j = 0; j < 4; ++j) s[r] += (v[r][j].x * v[r][j].x + v[r][j].y * v[r][j].y) + (v[r][j].z * v[r][j].z + v[r][j].w * v[r][j].w);
        const float rstd = 1.f / sqrtf(wave_sum(s[r]) * (1.f / 1024.f) + 1e-6f);
        unsigned long long* o8 = (unsigned long long*)(orow + r * rs) + lane;
#pragma unroll
        for (int j = 0; j < 4; ++j)
            o8[64 * j] = (unsigned long long)cvtpk(v[r][j].x * rstd * gg[j].x, v[r][j].y * rstd * gg[j].y) | ((unsigned long long)cvtpk(v[r][j].z * rstd * gg[j].z, v[r][j].w * rstd * gg[j].w) << 32); }
}
__device__ __forceinline__ void sincos_d(double x, double& s, double& c) {
    const double k = rint(x * 0.15915494309189535); const double y = (x - k * 6.283185307179586) - k * 2.4492935982947064e-16;
    const double y2 = y * y; double ts = 1.0, tc = 1.0;
#pragma unroll 1
    for (int n = 27; n >= 3; n -= 2) { ts = 1.0 - ts * y2 / (double)(n * (n - 1)); tc = 1.0 - tc * y2 / (double)((n - 1) * (n - 2)); }
    s = y * ts; c = tc;
}

template <int E, bool MASK>
__device__ __forceinline__ void attn_wave(const bf16* Qp, int ldq, const bf16* Kt, const bf16* Vt,
                                          int kt0, int kt1, int j0, int lane, f32x16 (&O)[E / 32], float& m_out, float& l_out) {
    constexpr int TE = 32 * E;
    const int c = lane & 31, hi = lane >> 5;
    bf16x8 qf[E / 16];
#pragma unroll
    for (int s = 0; s < E / 16; ++s) qf[s] = *(const bf16x8*)(Qp + (size_t)c * ldq + 16 * s + 8 * hi);
    float mrun = -1e30f, l = 0.f;
#pragma unroll
    for (int t = 0; t < E / 32; ++t)
#pragma unroll
        for (int i = 0; i < 16; ++i) O[t][i] = 0.f;
    const float c2 = (E == 64 ? 0.125f : 0.08838834764831845f) * 1.4426950408889634f;
    bf16x8 kf[E / 16];
#pragma unroll
    for (int s = 0; s < E / 16; ++s) kf[s] = *(const bf16x8*)(Kt + (size_t)kt0 * TE + s * 512 + lane * 8);
    for (int kt = kt0; kt <= kt1; ++kt) {
        bf16x8 vfr[E / 32][2];
#pragma unroll
        for (int t = 0; t < E / 32; ++t)
#pragma unroll
            for (int s2 = 0; s2 < 2; ++s2) vfr[t][s2] = *(const bf16x8*)(Vt + (size_t)kt * TE + (t * 2 + s2) * 512 + lane * 8);
        bf16x8 kn[E / 16];
        { const int ktn = (kt < kt1) ? kt + 1 : kt1;
#pragma unroll
          for (int s = 0; s < E / 16; ++s) kn[s] = *(const bf16x8*)(Kt + (size_t)ktn * TE + s * 512 + lane * 8); }
        f32x16 S;
#pragma unroll
        for (int i = 0; i < 16; ++i) S[i] = 0.f;
#pragma unroll
        for (int s = 0; s < E / 16; ++s) S = __builtin_amdgcn_mfma_f32_32x32x16_bf16(kf[s], qf[s], S, 0, 0, 0);
        if (MASK) {
            const bool full = (kt * 32 + 31 <= j0) && (kt * 32 + 128 >= j0 + 31);
            if (!full) { const int qj = j0 + c;
#pragma unroll
                for (int i = 0; i < 16; ++i) { const int kj = kt * 32 + (i & 3) + 8 * (i >> 2) + 4 * hi; const bool valid = (kj <= qj) && (kj + 128 >= qj); S[i] = valid ? S[i] : -1e30f; } }
        }
        float mx = S[0];
#pragma unroll
        for (int i = 1; i < 16; ++i) mx = fmaxf(mx, S[i]);
        mx = fmaxf(mx, __shfl_xor(mx, 32));
        const float mn = fmaxf(mrun, mx); const float alpha = __builtin_amdgcn_exp2f((mrun - mn) * c2); mrun = mn;
        float ps = 0.f;
#pragma unroll
        for (int i = 0; i < 16; ++i) { const float p = __builtin_amdgcn_exp2f((S[i] - mn) * c2); S[i] = p; ps += p; }
        l = l * alpha + ps;
#pragma unroll
        for (int t = 0; t < E / 32; ++t)
#pragma unroll
            for (int i = 0; i < 16; ++i) O[t][i] *= alpha;
        bf16x8 pk[2];
#pragma unroll
        for (int s2 = 0; s2 < 2; ++s2) { v4u w; w.x = cvtpk(S[8 * s2 + 0], S[8 * s2 + 1]); w.y = cvtpk(S[8 * s2 + 2], S[8 * s2 + 3]); w.z = cvtpk(S[8 * s2 + 4], S[8 * s2 + 5]); w.w = cvtpk(S[8 * s2 + 6], S[8 * s2 + 7]); pk[s2] = __builtin_bit_cast(bf16x8, w); }
#pragma unroll
        for (int t = 0; t < E / 32; ++t)
#pragma unroll
            for (int s2 = 0; s2 < 2; ++s2) O[t] = __builtin_amdgcn_mfma_f32_32x32x16_bf16(vfr[t][s2], pk[s2], O[t], 0, 0, 0);
#pragma unroll
        for (int s = 0; s < E / 16; ++s) kf[s] = kn[s];
    }
    l += __shfl_xor(l, 32);
    m_out = mrun; l_out = l;
}

__device__ __forceinline__ void sattn_wave(const bf16* Qp, const bf16* Kt, const bf16* Vt, int j0, int lane, f32x16 (&O)[2][2], float (&m_out)[2], float (&l_out)[2]) {
    const int c = lane & 31, hi = lane >> 5;
    bf16x8 qf[2][4];
#pragma unroll
    for (int q = 0; q < 2; ++q)
#pragma unroll
        for (int s = 0; s < 4; ++s) qf[q][s] = *(const bf16x8*)(Qp + (size_t)(32 * q + c) * 64 + 16 * s + 8 * hi);
    float mrun[2] = {-1e30f, -1e30f}, l[2] = {0.f, 0.f};
#pragma unroll
    for (int q = 0; q < 2; ++q)
#pragma unroll
        for (int t = 0; t < 2; ++t)
#pragma unroll
            for (int i = 0; i < 16; ++i) O[q][t][i] = 0.f;
    const float c2 = 0.125f * 1.4426950408889634f;
    const int kb = j0 >> 5, kt_end = kb + 1, kt_beg = (kb >= 4) ? kb - 4 : 0;
    bf16x8 kf[4], vfr[2][2];
#pragma unroll
    for (int s = 0; s < 4; ++s) kf[s] = *(const bf16x8*)(Kt + (size_t)kt_beg * 2048 + s * 512 + lane * 8);
#pragma unroll
    for (int t = 0; t < 2; ++t)
#pragma unroll
        for (int s2 = 0; s2 < 2; ++s2) vfr[t][s2] = *(const bf16x8*)(Vt + (size_t)kt_beg * 2048 + (t * 2 + s2) * 512 + lane * 8);
    for (int kt = kt_beg; kt <= kt_end; ++kt) {
        const int ktn = (kt < kt_end) ? kt + 1 : kt_end;
        bf16x8 kn[4], vn[2][2];
#pragma unroll
        for (int s = 0; s < 4; ++s) kn[s] = *(const bf16x8*)(Kt + (size_t)ktn * 2048 + s * 512 + lane * 8);
#pragma unroll
        for (int t = 0; t < 2; ++t)
#pragma unroll
            for (int s2 = 0; s2 < 2; ++s2) vn[t][s2] = *(const bf16x8*)(Vt + (size_t)ktn * 2048 + (t * 2 + s2) * 512 + lane * 8);
#pragma unroll
        for (int q = 0; q < 2; ++q) {
            const int kq = kb + q;
            if (kt <= kq && kt + 4 >= kq) {
                f32x16 S;
#pragma unroll
                for (int i = 0; i < 16; ++i) S[i] = 0.f;
#pragma unroll
                for (int s = 0; s < 4; ++s) S = __builtin_amdgcn_mfma_f32_32x32x16_bf16(kf[s], qf[q][s], S, 0, 0, 0);
                const int jq = j0 + 32 * q;
                const bool full = (kt * 32 + 31 <= jq) && (kt * 32 + 128 >= jq + 31);
                if (!full) { const int qj = jq + c;
#pragma unroll
                    for (int i = 0; i < 16; ++i) { const int kj = kt * 32 + (i & 3) + 8 * (i >> 2) + 4 * hi; const bool valid = (kj <= qj) && (kj + 128 >= qj); S[i] = valid ? S[i] : -1e30f; } }
                float mx = S[0];
#pragma unroll
                for (int i = 1; i < 16; ++i) mx = fmaxf(mx, S[i]);
                mx = fmaxf(mx, __shfl_xor(mx, 32));
                const float mn = fmaxf(mrun[q], mx); const float alpha = __builtin_amdgcn_exp2f((mrun[q] - mn) * c2); mrun[q] = mn;
                float ps = 0.f;
#pragma unroll
                for (int i = 0; i < 16; ++i) { const float p = __builtin_amdgcn_exp2f((S[i] - mn) * c2); S[i] = p; ps += p; }
                l[q] = l[q] * alpha + ps;
#pragma unroll
                for (int t = 0; t < 2; ++t)
#pragma unroll
                    for (int i = 0; i < 16; ++i) O[q][t][i] *= alpha;
                bf16x8 pk[2];
#pragma unroll
                for (int s2 = 0; s2 < 2; ++s2) { v4u w; w.x = cvtpk(S[8 * s2 + 0], S[8 * s2 + 1]); w.y = cvtpk(S[8 * s2 + 2], S[8 * s2 + 3]); w.z = cvtpk(S[8 * s2 + 4], S[8 * s2 + 5]); w.w = cvtpk(S[8 * s2 + 6], S[8 * s2 + 7]); pk[s2] = __builtin_bit_cast(bf16x8, w); }
#pragma unroll
                for (int t = 0; t < 2; ++t)
#pragma unroll
                    for (int s2 = 0; s2 < 2; ++s2) O[q][t] = __builtin_amdgcn_mfma_f32_32x32x16_bf16(vfr[t][s2], pk[s2], O[q][t], 0, 0, 0);
            }
        }
#pragma unroll
        for (int s = 0; s < 4; ++s) kf[s] = kn[s];
#pragma unroll
        for (int t = 0; t < 2; ++t)
#pragma unroll
            for (int s2 = 0; s2 < 2; ++s2) vfr[t][s2] = vn[t][s2];
    }
#pragma unroll
    for (int q = 0; q < 2; ++q) { l[q] += __shfl_xor(l[q], 32); m_out[q] = mrun[q]; l_out[q] = l[q]; }
}

constexpr int SSM_LROW = 272;
template <bool PASSB>
__device__ __forceinline__ void ssm_wave(const unsigned char* ws, const float* dd, int b, int g, int segbase, int hstride, int nsp, LAS unsigned char* sb, int lane, float (&st)[4]) {
    const int c = lane & 31, hi = lane >> 5;
    const f32x4 pa0 = *(const f32x4*)(ws + WS_SSMA + (size_t)(g * 64 + c) * 16), pa1 = *(const f32x4*)(ws + WS_SSMA + (size_t)(g * 64 + c + 32) * 16);
    bf16x8 bfr[4];
#pragma unroll
    for (int n = 0; n < 4; ++n) bfr[n] = *(const bf16x8*)(ws + WS_SSMB + ((size_t)((g * 4 + n) * 32 + c) * 16 + 8 * hi) * 2);
    const bf16* U = (const bf16*)(ws + WS_U);
    float s0r = PASSB ? st[0] : 0.f, s0i = PASSB ? st[1] : 0.f, s1r = PASSB ? st[2] : 0.f, s1i = PASSB ? st[3] : 0.f;
    bf16x8 cfr[4];
    if (PASSB) {
#pragma unroll
        for (int ks = 0; ks < 4; ++ks) cfr[ks] = *(const bf16x8*)(ws + WS_SSMC + ((size_t)(g * 16 + (lane & 15)) * 128 + 32 * ks + 8 * (lane >> 4)) * 2);
    }
    const int segsel = (c >> 2) & 1, toff = (c & 3) + 4 * (c >> 3);
    const float dsk = dd[g * 16 + (lane & 15)];
    for (int kp = 0; kp < nsp; ++kp) {
        const int seg0 = segbase + kp;
        const size_t tokA = (size_t)b * 8192 + (size_t)(seg0 + hstride * segsel) * 128 + toff;
        bf16x8 ufn = *(const bf16x8*)(U + tokA * 512 + g * 16 + 8 * hi);
        for (int blk = 0; blk < 8; ++blk) {
            const bf16x8 uf = ufn; { const int bn = (blk < 7) ? blk + 1 : 7; ufn = *(const bf16x8*)(U + (tokA + bn * 16) * 512 + g * 16 + 8 * hi); }
            bf16 uu[2][4];
            if (PASSB) {
#pragma unroll
                for (int ss = 0; ss < 2; ++ss)
#pragma unroll
                    for (int rg = 0; rg < 4; ++rg) uu[ss][rg] = U[((size_t)b * 8192 + (size_t)(seg0 + hstride * ss) * 128 + blk * 16 + (lane >> 4) * 4 + rg) * 512 + g * 16 + (lane & 15)];
            }
            f32x16 z;
#pragma unroll
            for (int i = 0; i < 16; ++i) z[i] = 0.f;
            const f32x16 BU0 = __builtin_amdgcn_mfma_f32_32x32x16_bf16(uf, bfr[0], z, 0, 0, 0), BU1 = __builtin_amdgcn_mfma_f32_32x32x16_bf16(uf, bfr[1], z, 0, 0, 0);
            const f32x16 BU2 = __builtin_amdgcn_mfma_f32_32x32x16_bf16(uf, bfr[2], z, 0, 0, 0), BU3 = __builtin_amdgcn_mfma_f32_32x32x16_bf16(uf, bfr[3], z, 0, 0, 0);
#pragma unroll
            for (int i = 0; i < 16; ++i) {
                const float n0r = pa0.x * s0r - pa0.y * s0i + BU0[i], n0i = pa0.x * s0i + pa0.y * s0r + BU1[i]; s0r = n0r; s0i = n0i;
                const float n1r = pa1.x * s1r - pa1.y * s1i + BU2[i], n1i = pa1.x * s1i + pa1.y * s1r + BU3[i]; s1r = n1r; s1i = n1i;
                if (PASSB) { LAS unsigned char* rowp = sb + (hi * 16 + i) * SSM_LROW + 4 * c;
                    *(LAS unsigned*)rowp = cvtpk(s0r, s0i); *(LAS unsigned*)(rowp + 128) = cvtpk(s1r, s1i); }
            }
            if (PASSB) {
                asm volatile("s_waitcnt lgkmcnt(0)" ::: "memory");
#pragma unroll
                for (int ss = 0; ss < 2; ++ss) {
                    pg8::f32x4 Y = {0.f, 0.f, 0.f, 0.f};
#pragma unroll
                    for (int ks = 0; ks < 4; ++ks) { const bf16x8 af = *(const LAS bf16x8*)(sb + (ss * 16 + (lane & 15)) * SSM_LROW + (32 * ks + 8 * (lane >> 4)) * 2);
                        Y = __builtin_amdgcn_mfma_f32_16x16x32_bf16(af, cfr[ks], Y, 0, 0, 0); }
#pragma unroll
                    for (int rg = 0; rg < 4; ++rg) { const size_t tok = (size_t)b * 8192 + (size_t)(seg0 + hstride * ss) * 128 + blk * 16 + (lane >> 4) * 4 + rg; const size_t o = tok * 512 + g * 16 + (lane & 15);
                        const float y = Y[rg] + dsk * bf2f(uu[ss][rg]);
                        const float zz = 0.7978845608028654f * (y + 0.044715f * y * y * y);
                        const float gl = y * __builtin_amdgcn_rcpf(1.f + __builtin_amdgcn_exp2f(-2.885390081777927f * zz));
                        ((bf16*)(ws + WS_YG))[o] = (bf16)(cvtpk(gl, 0.f) & 0xffffu); }
                }
                asm volatile("s_waitcnt lgkmcnt(0)" ::: "memory");
            }
        }
    }
    st[0] = s0r; st[1] = s0i; st[2] = s1r; st[3] = s1i;
}

#define RLX_AGENT __ATOMIC_RELAXED, __HIP_MEMORY_SCOPE_AGENT
#define XB_TMO      128
#define XB_XCNT(j)  (256  + 64 * (j))
#define XB_XSUB(j)  (1280 + 64 * (j))
#define XB_XGEN(j)  (2304 + 64 * (j))
#define XB_TOP      3328
#define XB_TOPGEN   3392
#define XCD_BAR_WORDS 3456
#define XB_SPIN_CAP (1u << 18)

__device__ __forceinline__ unsigned xb_ld(unsigned* p)              { return __hip_atomic_load(p, __ATOMIC_RELAXED, __HIP_MEMORY_SCOPE_AGENT); }
__device__ __forceinline__ unsigned xb_add(unsigned* p, unsigned v) { return __hip_atomic_fetch_add(p, v, __ATOMIC_RELAXED, __HIP_MEMORY_SCOPE_AGENT); }
__device__ __forceinline__ unsigned xb_xcc_id() { return (unsigned)__builtin_amdgcn_s_getreg((3 << 11) | 20) & 0xFu; }
#define XB_SPIN(cond, bar) do { unsigned _sp = 0; while (cond) { __builtin_amdgcn_s_sleep(1); \
    if ((++_sp & 255u) == 0u) { if (xb_ld(&(bar)[XB_TMO])) break; if (_sp > XB_SPIN_CAP) { atomicAdd(&(bar)[XB_TMO], 1u); break; } } } } while (0)

struct XcdBarrier {
    unsigned* bar; unsigned x;
    volatile LAS unsigned* st;
};

__device__ __forceinline__ XcdBarrier xcd_barrier_post(unsigned* bar, volatile LAS unsigned* st, bool tid0) {
    XcdBarrier b; b.bar = bar; b.x = xb_xcc_id(); b.st = st;
    if (tid0) (void)xb_add(&bar[XB_XCNT(b.x)], 1u);
    return b;
}
__device__ __forceinline__ void xcd_barrier_complete(unsigned* bar, unsigned x, unsigned& nloc, unsigned& nx) {
    const unsigned G = gridDim.x * gridDim.y * gridDim.z;
    unsigned sum, cnt, mine, sp = 0u;
    for (;;) {
        sum = 0u; cnt = 0u; mine = 0u;
#pragma unroll
        for (unsigned j = 0; j < 16; ++j) { const unsigned c = xb_ld(&bar[XB_XCNT(j)]); sum += c; cnt += (c > 0u) ? 1u : 0u; mine = (j == x) ? c : mine; }
        if (sum == G) break;
        __builtin_amdgcn_s_sleep(1);
        if ((++sp & 255u) == 0u) { if (xb_ld(&bar[XB_TMO])) break; if (sp > XB_SPIN_CAP) { atomicAdd(&bar[XB_TMO], 1u); break; } }
    }
    nloc = mine > 0u ? mine : 1u; nx = cnt > 0u ? cnt : 1u;
}

__device__ __forceinline__ void xcd_barrier(const XcdBarrier& b, bool tid0) {
    asm volatile("s_waitcnt vmcnt(0)" ::: "memory");
    __syncthreads();
    if (tid0) {
        unsigned* bar = b.bar;
        __builtin_amdgcn_s_waitcnt(0);
        unsigned nloc = b.st[0], nx = b.st[1];
        if (nloc == 0u) { xcd_barrier_complete(bar, b.x, nloc, nx); b.st[0] = nloc; b.st[1] = nx; }
        const unsigned old = xb_add(&bar[XB_XSUB(b.x)], 1u);
        const unsigned gen = old / nloc;
        if (old + 1u == (gen + 1u) * nloc) {
            __builtin_amdgcn_fence(__ATOMIC_RELEASE, "agent");
            asm volatile("s_waitcnt vmcnt(0)" ::: "memory");
            const unsigned og = xb_add(&bar[XB_TOP], 1u);
            const unsigned tg = og / nx;
            if (og + 1u == (tg + 1u) * nx) xb_add(&bar[XB_TOPGEN], 1u);
            else XB_SPIN(xb_ld(&bar[XB_TOPGEN]) == tg, bar);
            __builtin_amdgcn_fence(__ATOMIC_ACQUIRE, "agent");
            xb_add(&bar[XB_XGEN(b.x)], 1u);
            asm volatile("s_waitcnt vmcnt(0)" ::: "memory");
        } else {
            XB_SPIN(xb_ld(&bar[XB_XGEN(b.x)]) == gen, bar);
            __builtin_amdgcn_fence(__ATOMIC_ACQUIRE, "agent");
            asm volatile("s_waitcnt vmcnt(0)" ::: "memory");
        }
    }
    __syncthreads();
}

template <int GI> __device__ __forceinline__ void p1_vt(LAS unsigned char* lds, unsigned char* ws, int G, int bx, int wave) {
    constexpr int d = 1 << (2 * GI);
    pg8::Gemm g{(const bf16*)(ws + WS_WV) + (size_t)GI * 256 * 1024, (const bf16*)(ws + WS_XN), 256, M, 1024, 1024, d * 1024, wave}; pg8::StaticOrder S; S.init(256, M, G, bx);
    pg8::EpiVTf E{(bf16*)(ws + WS_VT), 0, GI}; pg8::gemm_phase<pg8::EpiVTf, d>(lds, g, S, E);
}

__global__ void __launch_bounds__(NWAVES * 64, 2) fwd_megakernel(Args args) {
    __shared__ __attribute__((aligned(16))) unsigned char lds_raw[LDS_BYTES];
    LAS unsigned char* lds = (LAS unsigned char*)lds_raw;
    const int wave = __builtin_amdgcn_readfirstlane((int)threadIdx.x >> 6);
    const int G = gridDim.x; const int bx = blockIdx.x; const int vcu = (G % 8 == 0) ? (bx % 8) * (G / 8) + bx / 8 : bx;
    const int gw = vcu * NWAVES + wave, NGW = G * NWAVES;
    unsigned char* ws = args.ws;
    const int lo = args.ph_lo, hi_ph = args.ph_hi;
    volatile LAS unsigned* MISC = (volatile LAS unsigned*)(lds + 131072 + 320);
    { const int t0 = wave * 64 + lane_id(); if (t0 < 32) MISC[t0] = 0u; }
    __syncthreads();
    XcdBarrier bar; bar.bar = (unsigned*)ws; bar.x = 0; bar.st = nullptr;
    if (hi_ph - lo > 1) bar = xcd_barrier_post((unsigned*)ws, MISC + 8, wave == 0 && lane_id() == 0);
    if (lo == 0x7fffffff) cg::this_grid().sync();
#define IN(k) (lo <= (k) && (k) < hi_ph)
#define SEAM(k) do { if (IN(k) && IN((k) + 1)) { xcd_barrier(bar, wave == 0 && lane_id() == 0); } } while (0)

    if (IN(0)) {
        const int lane = lane_id(), tid = wave * 64 + lane;
        LAS float* scr = (LAS float*)(lds + wave * 16384);
        const float* w_in = args.in[4];
        constexpr int I0 = 16 * 64, I1 = 16 * 24, I2 = 16 * 112, I3 = 8 * 16, I4 = 8 * 32, I5 = 4 * 32, I6 = 16 * 32, I7 = 8 * 32, I8 = 16 * 32, I9 = 16 * 128, I10 = 64 * 32;
        constexpr int NITEMS = I0 + I1 + I2 + I3 + I4 + I5 + I6 + I7 + I8 + I9 + I10;
        for (int it = gw; it < NITEMS; it += NGW) {
            int r = it;
            if (r < I0) { p0_transpose_item(w_in, 6400, 0, 1024, 64, (bf16*)(ws + WS_WIN), 0, nullptr, scr, r, lane); continue; } r -= I0;
            if (r < I1) { p0_transpose_item(w_in, 6400, 2048, 1024, 24, (bf16*)(ws + WS_WV), 0, nullptr, scr, r, lane); continue; } r -= I1;
            if (r < I2) { p0_transpose_item(w_in, 6400, 2816, 1024, 112, (bf16*)(ws + WS_WIN), 2048, nullptr, scr, r, lane); continue; } r -= I2;
            if (r < I3) { p0_transpose_item(args.in[14], 512, 0, 512, 16, (bf16*)(ws + WS_WGLU), 0, nullptr, scr, r, lane); continue; } r -= I3;
            if (r < I4) { p0_transpose_item(args.in[16], 1024, 0, 512, 32, (bf16*)(ws + WS_WSSM), 0, nullptr, scr, r, lane); continue; } r -= I4;
            if (r < I5) { p0_transpose_item(args.in[17], 1024, 0, 256, 32, (bf16*)(ws + WS_WATT), 0, nullptr, scr, r, lane); continue; } r -= I5;
            if (r < I6) { p0_transpose_item(args.in[18], 1024, 0, 1024, 32, (bf16*)(ws + WS_WMKV), 0, nullptr, scr, r, lane); continue; } r -= I6;
            if (r < I7) { p0_transpose_item(args.in[19], 1024, 0, 512, 32, (bf16*)(ws + WS_WMEM), 0, nullptr, scr, r, lane); continue; } r -= I7;
            if (r < I8) { p0_transpose_item(args.in[20], 1024, 0, 1024, 32, (bf16*)(ws + WS_WO), 0, nullptr, scr, r, lane); continue; } r -= I8;
            if (r < I9) { p0_transpose_item(args.in[22], 4096, 0, 1024, 128, (bf16*)(ws + WS_WUP), 0, args.in[21], scr, r, lane); continue; } r -= I9;
            p0_transpose_item(args.in[23], 1024, 0, 4096, 32, (bf16*)(ws + WS_WDN), 0, nullptr, scr, r, lane);
        }
        for (int m = gw * 4; m < M; m += NGW * 4) rms_rows_to_bf16<4>(args.in[0] + (size_t)m * D, (size_t)D, args.in[2], (bf16*)(ws + WS_XN) + (size_t)m * D, lane);
        for (int m = gw; m < 2048; m += NGW) rms_rows_to_bf16<1>(args.in[1] + (size_t)m * D, (size_t)D, args.in[3], (bf16*)(ws + WS_MEMN) + (size_t)m * D, lane);
        { const int i = bx * 512 + tid;
          if (i < 2048) { const int g = i >> 6, p = i & 63;
            const double lr = (double)args.in[6][i], li = (double)args.in[7][i], dt = exp((double)args.in[8][g]);
            const double mag = exp(lr * dt); double sn, cs; sincos_d(li * dt, sn, cs);
            const double ar = mag * cs, aim = mag * sn, nr = ar - 1.0, ni = aim, den = lr * lr + li * li;
            const double cr = (nr * lr + ni * li) / den, ci = (ni * lr - nr * li) / den;
            double pr = ar, pi = aim;
#pragma unroll 1
            for (int k = 0; k < 7; ++k) { const double t = pr * pr - pi * pi; pi = 2.0 * pr * pi; pr = t; }
            *(f32x4*)(ws + WS_SSMA + (size_t)i * 16) = (f32x4){(float)ar, (float)aim, (float)pr, (float)pi};
            const int nt0 = (p >> 5) * 2, cc = p & 31;
            bf16* BM_ = (bf16*)(ws + WS_SSMB); bf16* CM_ = (bf16*)(ws + WS_SSMC);
#pragma unroll 1
            for (int h = 0; h < 16; ++h) { const double br = (double)args.in[9][(size_t)i * 16 + h], bi = (double)args.in[10][(size_t)i * 16 + h];
                const float bbr = (float)(cr * br - ci * bi), bbi = (float)(cr * bi + ci * br);
                BM_[((size_t)(g * 4 + nt0) * 32 + cc) * 16 + h] = (bf16)(cvtpk(bbr, 0.f) & 0xffffu);
                BM_[((size_t)(g * 4 + nt0 + 1) * 32 + cc) * 16 + h] = (bf16)(cvtpk(bbi, 0.f) & 0xffffu);
                const float c_r = args.in[11][((size_t)g * 16 + h) * 64 + p], c_i = args.in[12][((size_t)g * 16 + h) * 64 + p];
                CM_[((size_t)g * 16 + h) * 128 + 2 * p] = (bf16)(cvtpk(c_r, 0.f) & 0xffffu);
                CM_[((size_t)g * 16 + h) * 128 + 2 * p + 1] = (bf16)(cvtpk(-c_i, 0.f) & 0xffffu); }
          } }
    }
    SEAM(0);

    if (IN(1)) {
        __syncthreads();
        {
            pg8::Gemm g{(const bf16*)(ws + WS_MEMN), (const bf16*)(ws + WS_WMKV), 2048, 512, 1024, 1024, 1024, wave}; pg8::StaticOrder S; S.init(2048, 512, G, bx);
            pg8::EpiMKf E{(bf16*)(ws + WS_MK)}; pg8::gemm_phase(lds, g, S, E); }
        {
            pg8::Gemm g{(const bf16*)(ws + WS_WMKV) + (size_t)512 * 1024, (const bf16*)(ws + WS_MEMN), 512, 2048, 1024, 1024, 1024, wave}; pg8::StaticOrder S; S.init(512, 2048, G, (bx + G - 16) % G);
            pg8::EpiVTf E{(bf16*)(ws + WS_MVT), 1, 0}; pg8::gemm_phase(lds, g, S, E); }
        {
            pg8::Gemm g{(const bf16*)(ws + WS_XN), (const bf16*)(ws + WS_WIN), M, NIN, 1024, 1024, 1024, wave}; pg8::StaticOrder S; S.init(M, NIN, G, bx);
            pg8::EpiInProj E{(bf16*)(ws + WS_U), (bf16*)(ws + WS_Q), (bf16*)(ws + WS_K), (bf16*)(ws + WS_MQ), (bf16*)(ws + WS_GATES), args.in[5]}; pg8::gemm_phase(lds, g, S, E); }
        p1_vt<0>(lds, ws, G, bx, wave); p1_vt<1>(lds, ws, G, bx, wave); p1_vt<2>(lds, ws, G, bx, wave);
    }
    SEAM(1);

    if (IN(2)) {
        const int lane = lane_id();
        for (int rep = 0; rep < PROBE_REP; ++rep)
        for (int it = gw; it < 12288; it += NGW) {
            const int qb = it & 127, rest = it >> 7, hh = rest & 3, b = (rest >> 2) & 7, g = rest >> 5;
            const int sh = 2 * g, d = 1 << sh, Ld = 8192 >> sh; const int pp0 = qb * 64, r = pp0 / Ld, j0 = pp0 % Ld;
            const size_t hb = ((size_t)(g * 8 + b) * 4 + hh) * 8192;
            const bf16* Qp = (const bf16*)(ws + WS_Q) + (hb + pp0) * 64;
            const bf16* Kt = (const bf16*)(ws + WS_K) + (hb + (size_t)r * Ld) * 64;
            const bf16* Vt = (const bf16*)(ws + WS_VT) + (hb + (size_t)r * Ld) * 64;
            f32x16 O[2][2]; float mr[2], l[2];
            sattn_wave(Qp, Kt, Vt, j0, lane, O, mr, l);
            const int c = lane & 31, hi = lane >> 5;
#pragma unroll
            for (int q = 0; q < 2; ++q) { const float inv = 1.f / l[q];
                const size_t tok = (size_t)b * 8192 + (size_t)(j0 + 32 * q + c) * d + r;
                bf16* og = (bf16*)(ws + WS_OG) + tok * 768 + g * 256 + hh * 64;
#pragma unroll
                for (int t = 0; t < 2; ++t)
#pragma unroll
                    for (int a = 0; a < 4; ++a) { v2u w; w.x = cvtpk(O[q][t][4 * a] * inv, O[q][t][4 * a + 1] * inv); w.y = cvtpk(O[q][t][4 * a + 2] * inv, O[q][t][4 * a + 3] * inv);
                        *(v2u*)(og + 32 * t + 8 * a + 4 * hi) = w; }
                if (hi == 0) ((float*)(ws + WS_LSE))[tok * 12 + g * 4 + hh] = mr[q] * 0.125f + __logf(l[q]); }
        }
        for (int it = gw; it < 8192; it += NGW) {
            const int qb = it & 255, h = (it >> 8) & 3, b = it >> 10;
            bf16* Qp = (bf16*)(ws + WS_MQ) + ((size_t)b * 8192 + qb * 32) * 512 + h * 128;
            const bf16* Kt = (const bf16*)(ws + WS_MK) + (size_t)(b * 4 + h) * 8 * 4096;
            const bf16* Vt = (const bf16*)(ws + WS_MVT) + (size_t)(b * 4 + h) * 8 * 4096;
            f32x16 O[4]; float mr, l;
            attn_wave<128, false>(Qp, 512, Kt, Vt, 0, 7, 0, lane, O, mr, l);
            const int c = lane & 31, hi = lane >> 5; const float inv = 1.f / l;
            bf16* om = Qp + (size_t)c * 512;
#pragma unroll
            for (int t = 0; t < 4; ++t)
#pragma unroll
                for (int a = 0; a < 4; ++a) { v2u w; w.x = cvtpk(O[t][4 * a] * inv, O[t][4 * a + 1] * inv); w.y = cvtpk(O[t][4 * a + 2] * inv, O[t][4 * a + 3] * inv);
                    *(v2u*)(om + 32 * t + 8 * a + 4 * hi) = w; }
        }
        {
            const int qd = wave, g = vcu & 31, b = vcu >> 5, c = lane & 31, hi = lane >> 5, idx = 2 * qd + hi;
            float st[4];
            ssm_wave<false>(ws, args.in[13], b, g, 8 * qd, 4, 4, lds + wave * 16384, lane, st);
            LAS f32x2* ex = (LAS f32x2*)(lds + 131072 + 1024);
            ex[idx * 64 + c] = (f32x2){st[0], st[1]}; ex[idx * 64 + c + 32] = (f32x2){st[2], st[3]};
            __syncthreads();
            const f32x4 pa0 = *(const f32x4*)(ws + WS_SSMA + (size_t)(g * 64 + c) * 16), pa1 = *(const f32x4*)(ws + WS_SSMA + (size_t)(g * 64 + c + 32) * 16);
            float a0r = pa0.z, a0i = pa0.w, a1r = pa1.z, a1i = pa1.w;
#pragma unroll
            for (int k = 0; k < 2; ++k) { const float t0 = a0r * a0r - a0i * a0i; a0i = 2.f * a0r * a0i; a0r = t0; const float t1 = a1r * a1r - a1i * a1i; a1i = 2.f * a1r * a1i; a1r = t1; }
            float s0r = 0.f, s0i = 0.f, s1r = 0.f, s1i = 0.f;
            for (int k = 0; k < idx; ++k) { const f32x2 e0 = ex[k * 64 + c], e1 = ex[k * 64 + c + 32];
                const float n0r = a0r * s0r - a0i * s0i + e0.x, n0i = a0r * s0i + a0i * s0r + e0.y; s0r = n0r; s0i = n0i;
                const float n1r = a1r * s1r - a1i * s1i + e1.x, n1i = a1r * s1i + a1i * s1r + e1.y; s1r = n1r; s1i = n1i; }
            st[0] = s0r; st[1] = s0i; st[2] = s1r; st[3] = s1i;
            ssm_wave<true>(ws, args.in[13], b, g, 8 * qd, 4, 4, lds + wave * 16384, lane, st);
        }
    }
    SEAM(2);


    if (IN(4)) {
        const int lane = lane_id();
        for (int m2 = gw; m2 < M / 2; m2 += NGW) { const size_t tok = (size_t)m2 * 2 + (lane >> 5); const int cc = (lane & 31) * 8, hh = cc >> 6;
            const float* ls = (const float*)(ws + WS_LSE) + tok * 12 + hh; const float l0 = ls[0], l1 = ls[4], l2 = ls[8];
            const float mx = fmaxf(l0, fmaxf(l1, l2)); const float e0 = __expf(l0 - mx), e1 = __expf(l1 - mx), e2 = __expf(l2 - mx); const float inv = 1.f / (e0 + e1 + e2);
            const bf16* og = (const bf16*)(ws + WS_OG) + tok * 768 + cc;
            pg8::f32x4 a0, a1, b0, b1, c0, c1; pg8::unpack8(*(const v4u*)og, a0, a1); pg8::unpack8(*(const v4u*)(og + 256), b0, b1); pg8::unpack8(*(const v4u*)(og + 512), c0, c1);
            const float w0 = e0 * inv, w1 = e1 * inv, w2 = e2 * inv;
            const pg8::f32x4 r0 = a0 * w0 + b0 * w1 + c0 * w2, r1 = a1 * w0 + b1 * w1 + c1 * w2;
            *(v4u*)((bf16*)(ws + WS_OMRG) + tok * 256 + cc) = pg8::pack8(r0, r1); }
        __syncthreads();
        pg8::Gemm g{(const bf16*)(ws + WS_YG), (const bf16*)(ws + WS_WGLU), M, 512, 512, 512, 512, wave}; pg8::StaticOrder S; S.init(M, 512, G, bx);
        pg8::EpiGlu E{(const bf16*)(ws + WS_YG), (bf16*)(ws + WS_Y2), args.in[15]}; pg8::gemm_phase(lds, g, S, E);
    }
    SEAM(4);

    if (IN(5)) {
        __syncthreads();
        pg8::StaticOrder S; S.init(M, 1024, G, bx);
        { pg8::Gemm g{(const bf16*)(ws + WS_Y2), (const bf16*)(ws + WS_WSSM), M, 1024, 512, 512, 512, wave};
          pg8::EpiBranch<0> E{(const bf16*)(ws + WS_GATES), (bf16*)(ws + WS_MG), 0}; pg8::gemm_phase(lds, g, S, E); }
        { pg8::Gemm g{(const bf16*)(ws + WS_OMRG), (const bf16*)(ws + WS_WATT), M, 1024, 256, 256, 256, wave};
          pg8::EpiBranch<1> E{(const bf16*)(ws + WS_GATES), (bf16*)(ws + WS_MG), 1024}; pg8::gemm_phase(lds, g, S, E); }
        { pg8::Gemm g{(const bf16*)(ws + WS_MQ), (const bf16*)(ws + WS_WMEM), M, 1024, 512, 512, 512, wave};
          pg8::EpiBranch<1> E{(const bf16*)(ws + WS_GATES), (bf16*)(ws + WS_MG), 2048}; pg8::gemm_phase(lds, g, S, E); }
    }
    SEAM(5);

    if (IN(6)) {
        __syncthreads();
        pg8::Gemm g{(const bf16*)(ws + WS_MG), (const bf16*)(ws + WS_WO), M, 1024, 1024, 1024, 1024, wave}; pg8::StaticOrder S; S.init(M, 1024, G, bx);
        pg8::EpiResid<0> E{args.in[0], (bf16*)(ws + WS_HB), (float*)(ws + WS_SSP1)}; pg8::gemm_phase(lds, g, S, E);
    }
    SEAM(6);

    if (IN(7)) {
        __syncthreads();
        pg8::Gemm g{(const bf16*)(ws + WS_HB), (const bf16*)(ws + WS_WUP), M, FF, 1024, 1024, 1024, wave}; pg8::StaticOrder S; S.init(M, FF, G, bx);
        pg8::EpiUp E{(const float*)(ws + WS_SSP1), (bf16*)(ws + WS_ACT)};
        pg8::gemm_phase(lds, g, S, E);
        if (PROBE_G7 > 1) pg8::gemm_phase(lds, g, S, E);
    }
    SEAM(7);

    if (IN(8)) {
        __syncthreads();
        pg8::Gemm g{(const bf16*)(ws + WS_ACT), (const bf16*)(ws + WS_WDN), M, 1024, FF, FF, FF, wave}; pg8::StaticOrder S; S.init(M, 1024, G, bx);
        pg8::EpiResid<1> E{nullptr, (bf16*)(ws + WS_HB), (float*)(ws + WS_SSP2)}; pg8::gemm_phase(lds, g, S, E);
    }
    SEAM(8);

    if (IN(9)) {
        const int lane = lane_id();
        const f32x4* gr = (const f32x4*)args.in[24];
        const int c8a = lane * 8, c8b = (lane + 64) * 8;
        const f32x4 ga0 = gr[c8a / 4], ga1 = gr[c8a / 4 + 1], gb0 = gr[c8b / 4], gb1 = gr[c8b / 4 + 1];
        for (int m = gw * 4; m < M; m += NGW * 4) {
            float pv[4]; v4u ha[4], hb4[4];
#pragma unroll
            for (int r = 0; r < 4; ++r) { pv[r] = (lane < 16) ? ((const float*)(ws + WS_SSP2))[(size_t)(m + r) * 16 + lane] : 0.f;
                const bf16* hr = (const bf16*)(ws + WS_HB) + (size_t)(m + r) * D; ha[r] = *(const v4u*)(hr + c8a); hb4[r] = *(const v4u*)(hr + c8b); }
#pragma unroll
            for (int r = 0; r < 4; ++r) { const float rs = 1.0f / sqrtf(wave_sum(pv[r]) * (1.f / 1024.f) + 1e-6f);
                f32x4* xr = (f32x4*)(args.out + (size_t)(m + r) * D); pg8::f32x4 v0, v1;
                pg8::unpack8(ha[r], v0, v1); xr[c8a / 4] = v0 * rs * ga0; xr[c8a / 4 + 1] = v1 * rs * ga1;
                pg8::unpack8(hb4[r], v0, v1); xr[c8b / 4] = v0 * rs * gb0; xr[c8b / 4 + 1] = v1 * rs * gb1; } }
    }
#undef IN
#undef SEAM
}

#ifndef DBG_PH
#define DBG_PH 0
#endif
struct DumpSeg { size_t off; unsigned n; unsigned pad; };
struct DumpArgs { float* out; const unsigned char* ws; DumpSeg s[6]; };
__global__ void dbg_dump(DumpArgs a) {
    size_t base = 0;
    float mag = 1e12f;
    for (int k = 0; k < 6; ++k, mag *= 0.1f) { const unsigned short* src = (const unsigned short*)(a.ws + a.s[k].off);
        for (size_t i = (size_t)blockIdx.x * blockDim.x + threadIdx.x; i < a.s[k].n; i += (size_t)gridDim.x * blockDim.x) a.out[base + i] = ((src[i] & 0x7f80u) == 0x7f80u) ? mag : 0.f;
        base += a.s[k].n; }
    for (size_t i = base + (size_t)blockIdx.x * blockDim.x + threadIdx.x; i < (size_t)M * D; i += (size_t)gridDim.x * blockDim.x) a.out[i] = 0.f;
}
extern "C" void kernel_launch(void* const* d_in, const int* in_sizes, int n_in, void* d_out, int out_size, void* d_ws, size_t ws_size, hipStream_t stream) {
    static int grid = 0;
    if (grid == 0) {
        if (n_in != 25 || out_size != M * D || ws_size < WS_END) { fprintf(stderr, "kernel_launch: unexpected shapes (n_in %d out %d ws %zu)\n", n_in, out_size, ws_size); grid = -1; return; }
        int dev = 0, cus = 0, per_cu = 0;
        if (hipGetDevice(&dev) != hipSuccess || hipDeviceGetAttribute(&cus, hipDeviceAttributeMultiprocessorCount, dev) != hipSuccess) { grid = -1; return; }
        if (hipOccupancyMaxActiveBlocksPerMultiprocessor(&per_cu, (const void*)fwd_megakernel, NWAVES * 64, 0) != hipSuccess || per_cu < 1) { fprintf(stderr, "kernel_launch: occupancy query says %d\n", per_cu); per_cu = 1; }
        (void)hipGetLastError();
        grid = cus;
    }
    if (grid < 0) return;
    Args a{};
    for (int i = 0; i < 25; ++i) a.in[i] = (const float*)d_in[i];
    a.out = (float*)d_out; a.ws = (unsigned char*)d_ws;
#if MK_N_LAUNCHES == 1
    if (hipMemsetAsync(d_ws, 0, 65536, stream) != hipSuccess) { fprintf(stderr, "kernel_launch: memset of the barrier words failed\n"); return; }
    a.ph_lo = 0; a.ph_hi = N_PHASES;
    void* kargs[] = {&a};
    hipError_t e = hipLaunchCooperativeKernel((const void*)fwd_megakernel, dim3(grid), dim3(NWAVES * 64), kargs, 0, stream);
    if (e != hipSuccess) fprintf(stderr, "kernel_launch: cooperative launch failed: %s (grid %d)\n", hipGetErrorString(e), grid);
#else
    const int np = DBG_PH ? DBG_PH + 1 : N_PHASES;
    for (int p = 0; p < np; ++p) { a.ph_lo = p; a.ph_hi = p + 1; hipLaunchKernelGGL(fwd_megakernel, dim3(grid), dim3(NWAVES * 64), 0, stream, a); }
#if DBG_PH && DBG_PH < 8
    { DumpArgs da{}; da.out = (float*)d_out; da.ws = (const unsigned char*)d_ws;
      DBG_SEGS
      hipLaunchKernelGGL(dbg_dump, dim3(2048), dim3(256), 0, stream, da); }
#endif
#endif
}
```

```cpp
#include <hip/hip_runtime.h>
#include <hip/hip_cooperative_groups.h>
#include <cstdio>
#include <cstdint>
namespace cg = cooperative_groups;

#define DBG_PH 0
#define DBG_SEGS da.s[0] = {WS_GATES, 12u << 20, 0}; da.s[1] = {WS_OG, 12u << 20, 0}; da.s[2] = {WS_MQ, 12u << 20, 0}; da.s[3] = {WS_YG, 8u << 20, 0}; da.s[4] = {WS_OMRG, 8u << 20, 0}; da.s[5] = {WS_MG, 12u << 20, 0};
#ifndef PROBE_G7
#define PROBE_G7 1
#endif
#ifndef PROBE_REP
#define PROBE_REP 1
#define PROBE_P3 1
#endif
#ifndef MK_N_LAUNCHES
#define MK_N_LAUNCHES 1
#endif

namespace pg8 {
#define PG8_LAS __attribute__((address_space(3)))
typedef unsigned short bf16_t;
typedef short bf16x8 __attribute__((ext_vector_type(8)));
typedef float f32x4 __attribute__((ext_vector_type(4)));
typedef unsigned u32x4 __attribute__((ext_vector_type(4)));
constexpr int BM = 256, BK = 64, HALF = 128, HTB = HALF * BK * 2, STAGE_BYTES = 8 * HTB, NXCD = 8, WGM = 8;

__host__ __device__ __forceinline__ int lds_byte(int r, int c) { const int st = (r >> 4) * 2 + (c >> 5), rr = r & 15, cc = c & 31, ob = rr * 64 + cc * 2; return st * 1024 + (ob ^ (((ob >> 9) & 1) << 5)); }
__host__ __device__ __forceinline__ void stage_rc(int b, int& R, int& C) { const int st = b / 1024, sb = b % 1024, swz = sb ^ (((sb >> 9) & 1) << 5); R = (st >> 1) * 16 + swz / 64; C = (st & 1) * 32 + (swz % 64) / 2; }
__host__ __device__ __forceinline__ int perm32(int rho) { const int n = rho >> 4, i = rho & 15; return 8 * (i >> 2) + 4 * n + (i & 3); }

struct Unit { int pm, pn; };
struct Gemm { const bf16_t* A; const bf16_t* Bt; int M, N, K; int lda, ldb; int bdil; };
__device__ __forceinline__ const char* a_tile(const Gemm& g, int pm) { return (const char*)g.A + (size_t)pm * 256 * (size_t)g.lda * 2; }
__device__ __forceinline__ const char* b_tile(const Gemm& g, int pn) {
    if (g.bdil == 0) return (const char*)g.Bt + (size_t)pn * 256 * (size_t)g.ldb * 2;
    const int d = g.bdil, Ld = 8192 / d, b = pn >> 5, pp0 = (pn & 31) * 256, r = pp0 / Ld, j0 = pp0 % Ld;
    return (const char*)g.Bt + ((size_t)b * 8192 + (size_t)j0 * d + r) * 1024 * 2;
}

struct StaticOrder {
    int nM, nN, nwg, G, c;
    __host__ __device__ void init(int M, int N, int G_, int c_) { nM = M / BM; nN = N / BM; nwg = nM * nN; G = G_; c = c_; }
    __host__ __device__ bool next(int i, Unit& u) const {
        const long L = (long)i * G + c; if (L >= nwg) return false;
        int wgid = (int)L; { const int q = nwg / NXCD, r = nwg % NXCD, xcd = wgid % NXCD, off = wgid / NXCD; wgid = (xcd < r ? xcd * (q + 1) : r * (q + 1) + (xcd - r) * q) + off; }
        const int nig = WGM * nN, gid = wgid / nig, fm = gid * WGM, gsz = (nM - fm) < WGM ? (nM - fm) : WGM;
        u.pm = fm + ((wgid % nig) % gsz); u.pn = (wgid % nig) / gsz; return true;
    }
};

typedef float f32x2_ __attribute__((ext_vector_type(2))); typedef __bf16 bf16x2_ __attribute__((ext_vector_type(2)));
__device__ __forceinline__ unsigned cvt_pk_bf16(float lo, float hi) { f32x2_ v = {lo, hi}; bf16x2_ b = __builtin_convertvector(v, bf16x2_); return __builtin_bit_cast(unsigned, b); }
__device__ __forceinline__ float bf_lo(unsigned w) { return __builtin_bit_cast(float, w << 16); }
__device__ __forceinline__ float bf_hi(unsigned w) { return __builtin_bit_cast(float, w & 0xffff0000u); }
__device__ __forceinline__ u32x4 pack8(const f32x4 v0, const f32x4 v1) { u32x4 w; w.x = cvt_pk_bf16(v0[0], v0[1]); w.y = cvt_pk_bf16(v0[2], v0[3]); w.z = cvt_pk_bf16(v1[0], v1[1]); w.w = cvt_pk_bf16(v1[2], v1[3]); return w; }
__device__ __forceinline__ void unpack8(const u32x4 w, f32x4& v0, f32x4& v1) { v0 = (f32x4){bf_lo(w.x), bf_hi(w.x), bf_lo(w.y), bf_hi(w.y)}; v1 = (f32x4){bf_lo(w.z), bf_hi(w.z), bf_lo(w.w), bf_hi(w.w)}; }
typedef unsigned u32x2 __attribute__((ext_vector_type(2)));
__device__ __forceinline__ unsigned q8x4(const f32x4 v) {
    unsigned r = 0u;
    r = __builtin_amdgcn_cvt_pk_u8_f32(__builtin_rintf(v[0] * 255.f), 0, r); r = __builtin_amdgcn_cvt_pk_u8_f32(__builtin_rintf(v[1] * 255.f), 1, r);
    r = __builtin_amdgcn_cvt_pk_u8_f32(__builtin_rintf(v[2] * 255.f), 2, r); r = __builtin_amdgcn_cvt_pk_u8_f32(__builtin_rintf(v[3] * 255.f), 3, r); return r; }
__device__ __forceinline__ f32x4 dq8x4(unsigned w) { const float k = 1.f / 255.f;
    return (f32x4){(float)(w & 0xffu) * k, (float)((w >> 8) & 0xffu) * k, (float)((w >> 16) & 0xffu) * k, (float)(w >> 24) * k}; }
__device__ __forceinline__ float sigm(float x) { return __builtin_amdgcn_rcpf(1.f + __builtin_amdgcn_exp2f(-1.4426950408889634f * x)); }

#define EPI_LOOP _Pragma("unroll") for (int ai = 0; ai < 2; ++ai) _Pragma("unroll") for (int m = 0; m < 4; ++m) _Pragma("unroll") for (int bj = 0; bj < 2; ++bj)
#define EPI_ROW (u.pm * 256 + ai * 128 + wr * 64 + m * 16 + fr)
#define EPI_COL (u.pn * 256 + bj * 128 + wc * 32 + 8 * fq)
typedef f32x4 AccT[2][2][4][2];

struct EpiPlain {
    bf16_t* O; size_t ldc;
    __device__ __forceinline__ void operator()(const AccT& acc, const Unit& u, int wr, int wc, int fr, int fq) const {
        EPI_LOOP { const int row = EPI_ROW, col = EPI_COL; *(u32x4*)(O + (size_t)row * ldc + col) = pack8(acc[ai][bj][m][0], acc[ai][bj][m][1]); }
    }
};
struct EpiVTf {
    bf16_t* O; int mem; int g;
    __device__ __forceinline__ void operator()(const AccT& acc, const Unit& u, int wr, int wc, int fr, int fq) const {
        EPI_LOOP { const int row = EPI_ROW, col = EPI_COL;
            int e, kk; size_t tb;
            if (mem) { const int h = row >> 7, b = col >> 8; e = row & 127; kk = col & 255; tb = ((size_t)((b * 4 + h) * 8 + (kk >> 5))) * 4096; }
            else { const int hh = row >> 6, b = col >> 13; e = row & 63; kk = col & 8191; tb = (((size_t)(g * 8 + b) * 4 + hh) * 8192) * 64 + (size_t)(kk >> 5) * 2048; }
            const int t = e >> 5, c = e & 31, k0 = kk & 31, s2 = k0 >> 4, half = (k0 >> 3) & 1;
            bf16_t* d0 = O + tb + (((t * 2 + s2) * 2 + 0) * 32 + c) * 8 + half * 4;
            const f32x4 v0 = acc[ai][bj][m][0], v1 = acc[ai][bj][m][1];
            typedef unsigned u32x2 __attribute__((ext_vector_type(2)));
            u32x2 w0, w1; w0.x = cvt_pk_bf16(v0[0], v0[1]); w0.y = cvt_pk_bf16(v0[2], v0[3]); w1.x = cvt_pk_bf16(v1[0], v1[1]); w1.y = cvt_pk_bf16(v1[2], v1[3]);
            *(u32x2*)d0 = w0; *(u32x2*)(d0 + 256) = w1; }
    }
};
struct EpiMKf {
    bf16_t* O;
    __device__ __forceinline__ void operator()(const AccT& acc, const Unit& u, int wr, int wc, int fr, int fq) const {
        EPI_LOOP { const int row = EPI_ROW, col = EPI_COL; const int b = row >> 8, key = row & 255, h = col >> 7, e = col & 127;
            *(u32x4*)(O + ((size_t)((b * 4 + h) * 8 + (key >> 5))) * 4096 + (((e >> 4) * 2 + ((e >> 3) & 1)) * 32 + (key & 31)) * 8) = pack8(acc[ai][bj][m][0], acc[ai][bj][m][1]); }
    }
};
struct EpiInProj {
    bf16_t *U, *Q, *Kb, *MQ, *GATES; const float* b_gate;
    __device__ __forceinline__ void operator()(const AccT& acc, const Unit& u, int wr, int wc, int fr, int fq) const {
        const int pn = u.pn;
        if (pn < 2) { EPI_LOOP { const int row = EPI_ROW, col = EPI_COL; *(u32x4*)(U + (size_t)row * 512 + col) = pack8(acc[ai][bj][m][0], acc[ai][bj][m][1]); } }
        else if (pn < 8) {
            const int g = (pn < 5) ? pn - 2 : pn - 5; bf16_t* base = (pn < 5) ? Q : Kb; const int sh = 2 * g  , Ld = 8192 >> sh, dm = (1 << sh) - 1;
            const bool isk = (pn >= 5);
            EPI_LOOP { const int row = EPI_ROW, colw = bj * 128 + wc * 32 + 8 * fq; const int hh = colw >> 6, e = colw & 63, b = row >> 13, t = row & 8191;
                const int pp = (t & dm) * Ld + (t >> sh);
                const size_t hbase = (((size_t)(g * 8 + b) * 4 + hh) * 8192) * 64;
                const size_t off = isk ? hbase + (size_t)(pp >> 5) * 2048 + ((((e >> 4) * 2 + ((e >> 3) & 1)) * 32 + (pp & 31)) * 8) : hbase + (size_t)pp * 64 + e;
                *(u32x4*)(base + off) = pack8(acc[ai][bj][m][0], acc[ai][bj][m][1]); }
        }
        else if (pn < 10) { EPI_LOOP { const int row = EPI_ROW, col = EPI_COL - 2048; *(u32x4*)(MQ + (size_t)row * 512 + col) = pack8(acc[ai][bj][m][0], acc[ai][bj][m][1]); } }
        else {
            f32x4 bb0[2], bb1[2];
#pragma unroll
            for (int bj = 0; bj < 2; ++bj) { const int col = EPI_COL - 2560; bb0[bj] = *(const f32x4*)(b_gate + col); bb1[bj] = *(const f32x4*)(b_gate + col + 4); }
            EPI_LOOP { const int row = EPI_ROW, col = EPI_COL - 2560;
                f32x4 v0 = acc[ai][bj][m][0] + bb0[bj], v1 = acc[ai][bj][m][1] + bb1[bj];
#pragma unroll
                for (int i = 0; i < 4; ++i) { v0[i] = sigm(v0[i]); v1[i] = sigm(v1[i]); }
                u32x2 w; w.x = q8x4(v0); w.y = q8x4(v1);
                *(u32x2*)((unsigned char*)GATES + (size_t)row * 3072 + col) = w; }
        }
    }
};
struct EpiGlu {
    const bf16_t* YG; bf16_t* Y2; const float* b;
    __device__ __forceinline__ void operator()(const AccT& acc, const Unit& u, int wr, int wc, int fr, int fq) const {
        f32x4 bb0[2], bb1[2];
#pragma unroll
        for (int bj = 0; bj < 2; ++bj) { const int col = EPI_COL; bb0[bj] = *(const f32x4*)(b + col); bb1[bj] = *(const f32x4*)(b + col + 4); }
#pragma unroll
        for (int ai = 0; ai < 2; ++ai) {
            u32x4 yv[4][2];
#pragma unroll
            for (int m = 0; m < 4; ++m)
#pragma unroll
                for (int bj = 0; bj < 2; ++bj) { const int row = EPI_ROW, col = EPI_COL; yv[m][bj] = *(const u32x4*)(YG + (size_t)row * 512 + col); }
#pragma unroll
            for (int m = 0; m < 4; ++m)
#pragma unroll
                for (int bj = 0; bj < 2; ++bj) { const int row = EPI_ROW, col = EPI_COL;
                    f32x4 y0, y1; unpack8(yv[m][bj], y0, y1);
                    f32x4 v0 = acc[ai][bj][m][0] + bb0[bj], v1 = acc[ai][bj][m][1] + bb1[bj];
#pragma unroll
                    for (int i = 0; i < 4; ++i) { v0[i] = y0[i] * sigm(v0[i]); v1[i] = y1[i] * sigm(v1[i]); }
                    *(u32x4*)(Y2 + (size_t)row * 512 + col) = pack8(v0, v1); }
        }
    }
};
template <int MODE> struct EpiBranch {
    const bf16_t* GATES; bf16_t* MG; int goff;
    __device__ __forceinline__ void operator()(const AccT& acc, const Unit& u, int wr, int wc, int fr, int fq) const {
#pragma unroll
        for (int ai = 0; ai < 2; ++ai) {
            u32x2 gv[4][2]; u32x4 pv[4][2];
#pragma unroll
            for (int m = 0; m < 4; ++m)
#pragma unroll
                for (int bj = 0; bj < 2; ++bj) { const int row = EPI_ROW, col = EPI_COL; gv[m][bj] = *(const u32x2*)((const unsigned char*)GATES + (size_t)row * 3072 + goff + col);
                    if (MODE == 1) pv[m][bj] = *(const u32x4*)(MG + (size_t)row * 1024 + col); }
#pragma unroll
            for (int m = 0; m < 4; ++m)
#pragma unroll
                for (int bj = 0; bj < 2; ++bj) { const int row = EPI_ROW, col = EPI_COL; const f32x4 g0 = dq8x4(gv[m][bj].x), g1 = dq8x4(gv[m][bj].y);
                    f32x4 v0 = acc[ai][bj][m][0] * g0, v1 = acc[ai][bj][m][1] * g1;
                    if (MODE == 1) { f32x4 p0, p1; unpack8(pv[m][bj], p0, p1); v0 += p0; v1 += p1; }
                    *(u32x4*)(MG + (size_t)row * 1024 + col) = pack8(v0, v1); }
        }
    }
};
template <int MODE> struct EpiResid {
    const float* X; bf16_t* HB; float* SS;
    __device__ __forceinline__ void operator()(const AccT& acc, const Unit& u, int wr, int wc, int fr, int fq) const {
#pragma unroll
        for (int ai = 0; ai < 2; ++ai) {
            f32x4 ra[4][2], rb[4][2]; u32x4 hv[4][2];
#pragma unroll
            for (int m = 0; m < 4; ++m)
#pragma unroll
                for (int bj = 0; bj < 2; ++bj) { const int row = EPI_ROW, col = EPI_COL; const size_t o = (size_t)row * 1024 + col;
                    if (MODE == 0) { ra[m][bj] = *(const f32x4*)(X + o); rb[m][bj] = *(const f32x4*)(X + o + 4); } else hv[m][bj] = *(const u32x4*)(HB + o); }
#pragma unroll
            for (int m = 0; m < 4; ++m) { const int row = EPI_ROW; float ss = 0.f;
#pragma unroll
                for (int bj = 0; bj < 2; ++bj) { const int col = EPI_COL; const size_t o = (size_t)row * 1024 + col;
                    f32x4 r0, r1;
                    if (MODE == 0) { r0 = ra[m][bj]; r1 = rb[m][bj]; } else unpack8(hv[m][bj], r0, r1);
                    const f32x4 v0 = acc[ai][bj][m][0] + r0, v1 = acc[ai][bj][m][1] + r1;
                    *(u32x4*)(HB + o) = pack8(v0, v1);
                    ss += (v0[0] * v0[0] + v0[1] * v0[1]) + (v0[2] * v0[2] + v0[3] * v0[3]) + (v1[0] * v1[0] + v1[1] * v1[1]) + (v1[2] * v1[2] + v1[3] * v1[3]); }
                ss += __shfl_xor(ss, 16); ss += __shfl_xor(ss, 32);
                if (fq == 0) SS[(size_t)row * 16 + u.pn * 4 + wc] = ss; }
        }
    }
};
struct EpiUp {
    const float* SS; bf16_t* ACT;
    __device__ __forceinline__ void operator()(const AccT& acc, const Unit& u, int wr, int wc, int fr, int fq) const {
        float rsv[2][4];
#pragma unroll
        for (int ai = 0; ai < 2; ++ai) { f32x4 q[4][4];
#pragma unroll
            for (int m = 0; m < 4; ++m) { const int row = EPI_ROW; const f32x4* sp = (const f32x4*)(SS + (size_t)row * 16);
#pragma unroll
                for (int k = 0; k < 4; ++k) q[m][k] = sp[k]; }
#pragma unroll
            for (int m = 0; m < 4; ++m) { const float tot = ((q[m][0][0] + q[m][0][1]) + (q[m][0][2] + q[m][0][3])) + ((q[m][1][0] + q[m][1][1]) + (q[m][1][2] + q[m][1][3])) + ((q[m][2][0] + q[m][2][1]) + (q[m][2][2] + q[m][2][3])) + ((q[m][3][0] + q[m][3][1]) + (q[m][3][2] + q[m][3][3]));
                rsv[ai][m] = 1.0f / sqrtf(tot * (1.f / 1024.f) + 1e-6f); } }
#pragma unroll
        for (int ai = 0; ai < 2; ++ai)
#pragma unroll
            for (int m = 0; m < 4; ++m) { const int row = EPI_ROW; const float rs = rsv[ai][m];
#pragma unroll
                for (int bj = 0; bj < 2; ++bj) { const int col = EPI_COL; f32x4 v0 = acc[ai][bj][m][0] * rs, v1 = acc[ai][bj][m][1] * rs;
#pragma unroll
                    for (int i = 0; i < 4; ++i) { const float a = fmaxf(v0[i], 0.f), b = fmaxf(v1[i], 0.f); v0[i] = a * a; v1[i] = b * b; }
                    *(u32x4*)(ACT + (size_t)row * 4096 + col) = pack8(v0, v1); } }
    }
};

template <class Epi>
__device__ __forceinline__ void gemm_phase(PG8_LAS unsigned char* lds, const Gemm g, const StaticOrder& S, const Epi& E) {
    const int tid = threadIdx.x, wid = __builtin_amdgcn_readfirstlane(tid >> 6), lane = tid & 63, wr = wid >> 2, wc = wid & 3, fr = lane & 15, fq = lane >> 4;
    const int K = g.K, nt = K / BK;
    unsigned voffA[2], voffB[2];
#pragma unroll
    for (int i = 0; i < 2; ++i) { int R, C; stage_rc(tid * 16 + i * 8192, R, C); const int Rb = (R & ~31) + perm32(R & 31);
        voffA[i] = (unsigned)(R * g.lda + C) * 2u; voffB[i] = (unsigned)(Rb * g.ldb + C) * 2u; }
    const size_t kstep = (size_t)(BK * 2);
    const size_t hstepA = (size_t)HALF * g.lda * 2, hstepB = (size_t)HALF * g.ldb * 2;
    const unsigned ldsw = (unsigned)wid * 1024u;
    const int aoff = lds_byte(wr * 64 + fr, fq * 8), boff = lds_byte(wc * 32 + fr, fq * 8);
#define PG8_SA(b, h) (((b) * 2 + (h)) * HTB)
#define PG8_SB(b, h) ((4 + (b) * 2 + (h)) * HTB)
#define PG8_STAGE(bufoff, gbase, voff) do { _Pragma("unroll") for (int _i = 0; _i < 2; ++_i) \
        __builtin_amdgcn_global_load_lds((const unsigned*)((const char*)(gbase) + (voff)[_i]), (PG8_LAS unsigned*)(lds + (bufoff) + ldsw + _i * 8192), 16, 0, 0); } while (0)
#define PG8_LDA(dst, b, h) do { _Pragma("unroll") for (int m = 0; m < 4; ++m) _Pragma("unroll") for (int k = 0; k < 2; ++k) dst[m][k] = *(const PG8_LAS bf16x8*)(lds + PG8_SA(b, h) + aoff + m * 2048 + k * 1024); } while (0)
#define PG8_LDB(dst, b, h) do { _Pragma("unroll") for (int n = 0; n < 2; ++n) _Pragma("unroll") for (int k = 0; k < 2; ++k) dst[n][k] = *(const PG8_LAS bf16x8*)(lds + PG8_SB(b, h) + boff + n * 2048 + k * 1024); } while (0)
#define PG8_MMA(ai, bj, At, Bt) do { __builtin_amdgcn_s_setprio(1); _Pragma("unroll") for (int m = 0; m < 4; ++m) _Pragma("unroll") for (int n = 0; n < 2; ++n) _Pragma("unroll") for (int k = 0; k < 2; ++k) \
        acc[ai][bj][m][n] = __builtin_amdgcn_mfma_f32_16x16x32_bf16(Bt[n][k], At[m][k], acc[ai][bj][m][n], 0, 0, 0); __builtin_amdgcn_s_setprio(0); } while (0)
#define PG8_WAIT_V(n) asm volatile("s_waitcnt vmcnt(" #n ")" ::: "memory")
#define PG8_WAIT_L(n) asm volatile("s_waitcnt lgkmcnt(" #n ")" ::: "memory")
#define PG8_BAR __builtin_amdgcn_s_barrier()
#define PG8_SCHED __builtin_amdgcn_sched_barrier(0)
    Unit cur, nxt; int ui = 0;
    if (!S.next(0, cur)) return;
    f32x4 acc[2][2][4][2];
#pragma unroll
    for (int a = 0; a < 2; ++a)
#pragma unroll
        for (int b = 0; b < 2; ++b)
#pragma unroll
            for (int m = 0; m < 4; ++m)
#pragma unroll
                for (int n = 0; n < 2; ++n) acc[a][b][m][n] = (f32x4){0.f, 0.f, 0.f, 0.f};
    bf16x8 At[4][2], B0[2][2], B1[2][2];
    const char* cA = a_tile(g, cur.pm); const char* cB = b_tile(g, cur.pn);
    PG8_STAGE(PG8_SB(0, 0), cB, voffB); PG8_STAGE(PG8_SB(0, 1), cB + hstepB, voffB); PG8_STAGE(PG8_SA(0, 0), cA, voffA); PG8_STAGE(PG8_SA(0, 1), cA + hstepA, voffA);
    if (wr == 1) PG8_BAR;
    PG8_WAIT_V(2); PG8_BAR;
    PG8_STAGE(PG8_SB(1, 0), cB + kstep, voffB); PG8_STAGE(PG8_SA(1, 0), cA + kstep, voffA); PG8_STAGE(PG8_SB(1, 1), cB + hstepB + kstep, voffB);
    PG8_WAIT_V(6); PG8_BAR;
    for (;;) {
        const bool has_next = S.next(ui + 1, nxt);
        const char* nA = has_next ? a_tile(g, nxt.pm) : cA; const char* nB = has_next ? b_tile(g, nxt.pn) : cB;
        for (int t = 0; t < nt; t += 2) {
            const bool last = (t == nt - 2);
            const char* a1 = cA + (size_t)(t + 1) * kstep;
            const char* a2 = last ? nA : cA + (size_t)(t + 2) * kstep; const char* b2 = last ? nB : cB + (size_t)(t + 2) * kstep;
            const char* a3 = a2 + kstep; const char* b3 = b2 + kstep;
            PG8_LDB(B0, 0, 0); PG8_LDB(B1, 0, 1); PG8_SCHED; PG8_LDA(At, 0, 0); PG8_STAGE(PG8_SA(1, 1), a1 + hstepA, voffA);
            PG8_WAIT_V(8); PG8_WAIT_L(0); PG8_BAR; PG8_MMA(0, 0, At, B0); PG8_MMA(0, 1, At, B1); PG8_BAR; PG8_SCHED;
            PG8_LDA(At, 0, 1); PG8_STAGE(PG8_SB(0, 0), b2, voffB); PG8_STAGE(PG8_SB(0, 1), b2 + hstepB, voffB); PG8_STAGE(PG8_SA(0, 0), a2, voffA);
            PG8_WAIT_V(8); PG8_WAIT_L(0); PG8_BAR; PG8_MMA(1, 0, At, B0); PG8_MMA(1, 1, At, B1); PG8_BAR; PG8_SCHED;
            PG8_LDB(B0, 1, 0); PG8_LDB(B1, 1, 1); PG8_SCHED; PG8_LDA(At, 1, 0); PG8_STAGE(PG8_SA(0, 1), a2 + hstepA, voffA);
            PG8_WAIT_V(8); PG8_WAIT_L(0); PG8_BAR; PG8_MMA(0, 0, At, B0); PG8_MMA(0, 1, At, B1); PG8_BAR; PG8_SCHED;
            PG8_LDA(At, 1, 1); PG8_STAGE(PG8_SB(1, 0), b3, voffB); PG8_STAGE(PG8_SB(1, 1), b3 + hstepB, voffB); PG8_STAGE(PG8_SA(1, 0), a3, voffA);
            PG8_WAIT_V(8); PG8_WAIT_L(0); PG8_BAR; PG8_MMA(1, 0, At, B0); PG8_MMA(1, 1, At, B1); PG8_BAR; PG8_SCHED;
        }
        if (wr == 0) PG8_BAR;
        E(acc, cur, wr, wc, fr, fq);
        if (!has_next) break;
#pragma unroll
        for (int a = 0; a < 2; ++a)
#pragma unroll
            for (int b = 0; b < 2; ++b)
#pragma unroll
                for (int m = 0; m < 4; ++m)
#pragma unroll
                    for (int n = 0; n < 2; ++n) acc[a][b][m][n] = (f32x4){0.f, 0.f, 0.f, 0.f};
        cur = nxt; cA = nA; cB = nB; ++ui;
        if (wr == 1) PG8_BAR;
    }
    PG8_WAIT_V(0);
    PG8_BAR;
#undef PG8_SA
#undef PG8_SB
#undef PG8_STAGE
#undef PG8_LDA
#undef PG8_LDB
#undef PG8_MMA
#undef PG8_WAIT_V
#undef PG8_WAIT_L
#undef PG8_BAR
#undef PG8_SCHED
}
}

constexpr int NWAVES = 8;
constexpr int BATCH = 8, SEQ = 8192, D = 1024, M = BATCH * SEQ, FF = 4096;
constexpr int NIN = 5632;
constexpr int N_PHASES = 10;

constexpr size_t MiB = 1u << 20;
constexpr size_t WS_BAR = 0;
constexpr size_t WS_SSMA = 512 * 1024;
constexpr size_t WS_SSMB = 576 * 1024;
constexpr size_t WS_SSMC = 704 * 1024;
constexpr size_t WS_WIN = 2 * MiB;
constexpr size_t WS_WV = 13 * MiB;
constexpr size_t WS_WGLU = 15 * MiB;
constexpr size_t WS_WSSM = 16 * MiB;
constexpr size_t WS_WATT = 17 * MiB;
constexpr size_t WS_WMKV = 18 * MiB;
constexpr size_t WS_WMEM = 20 * MiB;
constexpr size_t WS_WO = 21 * MiB;
constexpr size_t WS_WUP = 23 * MiB;
constexpr size_t WS_WDN = 31 * MiB;
constexpr size_t WS_MEMN = 40 * MiB;
constexpr size_t WS_MK = 44 * MiB;
constexpr size_t WS_MVT = 46 * MiB;
constexpr size_t WS_E = 48 * MiB;
constexpr size_t WS_SSP1 = 56 * MiB, WS_SSP2 = 60 * MiB;
constexpr size_t WS_XN = 64 * MiB;
constexpr size_t WS_OG = 64 * MiB, WS_LSE = 160 * MiB;
constexpr size_t WS_U = 192 * MiB;
constexpr size_t WS_MQ = 256 * MiB;
constexpr size_t WS_HB = 192 * MiB;
constexpr size_t WS_GATES = 320 * MiB;
constexpr size_t WS_Q = 704 * MiB, WS_K = 800 * MiB, WS_VT = 896 * MiB;
constexpr size_t WS_YG = 704 * MiB, WS_Y2 = 768 * MiB, WS_OMRG = 832 * MiB, WS_MG = 864 * MiB;
constexpr size_t WS_ACT = 320 * MiB;
constexpr size_t WS_END = 992 * MiB;

constexpr int LDS_BYTES = 147456;

#define LAS __attribute__((address_space(3)))
typedef unsigned short bf16;
typedef unsigned v4u __attribute__((ext_vector_type(4)));
typedef unsigned v2u __attribute__((ext_vector_type(2)));
typedef float f32x4 __attribute__((ext_vector_type(4)));
typedef float f32x2 __attribute__((ext_vector_type(2)));
typedef float f32x16 __attribute__((ext_vector_type(16)));
typedef short bf16x8 __attribute__((ext_vector_type(8)));
typedef short s16x4 __attribute__((ext_vector_type(4)));
typedef __bf16 bf16x2_t __attribute__((ext_vector_type(2)));
__device__ __forceinline__ unsigned cvtpk(float lo, float hi) { f32x2 v = {lo, hi}; bf16x2_t b = __builtin_convertvector(v, bf16x2_t); return __builtin_bit_cast(unsigned, b); }
__device__ __forceinline__ float wave_sum(float v) {
#pragma unroll
    for (int o = 1; o < 64; o <<= 1) v += __shfl_xor(v, o);
    return v;
}
__device__ __forceinline__ float bf2f(bf16 b) { return __builtin_bit_cast(float, (unsigned)b << 16); }

struct Args { const float* in[25]; float* out; unsigned char* ws; int ph_lo, ph_hi; };

__device__ __forceinline__ void p0_transpose_item(const float* W, int ldw, int c0, int K, int nblk, bf16* WT, int row_off, const float* scale, LAS float* scr, int item, int lane) {
    const int kb = item / nblk, nb = item % nblk, k0 = 64 * kb, n0 = 32 * nb;
#pragma unroll 8
    for (int i = 0; i < 32; ++i) { const int kk = 2 * i + (lane >> 5); float v = W[(size_t)(k0 + kk) * ldw + c0 + n0 + (lane & 31)]; if (scale) v *= scale[k0 + kk]; scr[kk * 33 + (lane & 31)] = v; }
    asm volatile("s_waitcnt lgkmcnt(0)" ::: "memory");
    const int c = lane & 7;
#pragma unroll
    for (int j = 0; j < 4; ++j) { const int n = (lane >> 3) + 8 * j; const LAS float* s = scr + (8 * c) * 33 + n;
        v4u o; o.x = cvtpk(s[0 * 33], s[1 * 33]); o.y = cvtpk(s[2 * 33], s[3 * 33]); o.z = cvtpk(s[4 * 33], s[5 * 33]); o.w = cvtpk(s[6 * 33], s[7 * 33]);
        *(v4u*)(WT + (size_t)(row_off + n0 + n) * K + k0 + 8 * c) = o; }
    asm volatile("s_waitcnt lgkmcnt(0)" ::: "memory");
}
template <int NR>
__device__ __forceinline__ void rms_rows_to_bf16(const float* xrow, size_t rs, const float* g, bf16* orow, int lane) {
    const f32x4* gr = (const f32x4*)g + lane;
    f32x4 v[NR][4]; float s[NR];
#pragma unroll
    for (int r = 0; r < NR; ++r) { const f32x4* xr = (const f32x4*)(xrow + r * rs) + lane; s[r] = 0.f;
#pragma unroll
        for (int j = 0; j < 4; ++j) v[r][j] = xr[64 * j]; }
    f32x4 gg[4];
#pragma unroll
    for (int j = 0; j < 4; ++j) gg[j] = gr[64 * j];
#pragma unroll
    for (int r = 0; r < NR; ++r) {
#pragma unroll
        for (int j = 0; j < 4; ++j) s[r] += (v[r][j].x * v[r][j].x + v[r][j].y * v[r][j].y) + (v[r][j].z * v[r][j].z + v[r][j].w * v[r][j].w);
        const float rstd = 1.f / sqrtf(wave_sum(s[r]) * (1.f / 1024.f) + 1e-6f);
        unsigned long long* o8 = (unsigned long long*)(orow + r * rs) + lane;
#pragma unroll
        for (int j = 0; j < 4; ++j)
            o8[64 * j] = (unsigned long long)cvtpk(v[r][j].x * rstd * gg[j].x, v[r][j].y * rstd * gg[j].y) | ((unsigned long long)cvtpk(v[r][j].z * rstd * gg[j].z, v[r][j].w * rstd * gg[j].w) << 32); }
}
__device__ __forceinline__ void sincos_d(double x, double& s, double& c) {
    const double k = rint(x * 0.15915494309189535); const double y = (x - k * 6.283185307179586) - k * 2.4492935982947064e-16;
    const double y2 = y * y; double ts = 1.0, tc = 1.0;
#pragma unroll 1
    for (int n = 27; n >= 3; n -= 2) { ts = 1.0 - ts * y2 / (double)(n * (n - 1)); tc = 1.0 - tc * y2 / (double)((n - 1) * (n - 2)); }
    s = y * ts; c = tc;
}

template <int E, bool MASK>
__device__ __forceinline__ void attn_wave(const bf16* Qp, int ldq, const bf16* Kt, const bf16* Vt,
                                          int kt0, int kt1, int j0, int lane, f32x16 (&O)[E / 32], float& m_out, float& l_out) {
    constexpr int TE = 32 * E;
    const int c = lane & 31, hi = lane >> 5;
    bf16x8 qf[E / 16];
#pragma unroll
    for (int s = 0; s < E / 16; ++s) qf[s] = *(const bf16x8*)(Qp + (size_t)c * ldq + 16 * s + 8 * hi);
    float mrun = -1e30f, l = 0.f;
#pragma unroll
    for (int t = 0; t < E / 32; ++t)
#pragma unroll
        for (int i = 0; i < 16; ++i) O[t][i] = 0.f;
    const float c2 = (E == 64 ? 0.125f : 0.08838834764831845f) * 1.4426950408889634f;
    bf16x8 kf[E / 16];
#pragma unroll
    for (int s = 0; s < E / 16; ++s) kf[s] = *(const bf16x8*)(Kt + (size_t)kt0 * TE + s * 512 + lane * 8);
    for (int kt = kt0; kt <= kt1; ++kt) {
        bf16x8 vfr[E / 32][2];
#pragma unroll
        for (int t = 0; t < E / 32; ++t)
#pragma unroll
            for (int s2 = 0; s2 < 2; ++s2) vfr[t][s2] = *(const bf16x8*)(Vt + (size_t)kt * TE + (t * 2 + s2) * 512 + lane * 8);
        bf16x8 kn[E / 16];
        { const int ktn = (kt < kt1) ? kt + 1 : kt1;
#pragma unroll
          for (int s = 0; s < E / 16; ++s) kn[s] = *(const bf16x8*)(Kt + (size_t)ktn * TE + s * 512 + lane * 8); }
        f32x16 S;
#pragma unroll
        for (int i = 0; i < 16; ++i) S[i] = 0.f;
#pragma unroll
        for (int s = 0; s < E / 16; ++s) S = __builtin_amdgcn_mfma_f32_32x32x16_bf16(kf[s], qf[s], S, 0, 0, 0);
        if (MASK) {
            const bool full = (kt * 32 + 31 <= j0) && (kt * 32 + 128 >= j0 + 31);
            if (!full) { const int qj = j0 + c;
#pragma unroll
                for (int i = 0; i < 16; ++i) { const int kj = kt * 32 + (i & 3) + 8 * (i >> 2) + 4 * hi; const bool valid = (kj <= qj) && (kj + 128 >= qj); S[i] = valid ? S[i] : -1e30f; } }
        }
        float mx = S[0];
#pragma unroll
        for (int i = 1; i < 16; ++i) mx = fmaxf(mx, S[i]);
        mx = fmaxf(mx, __shfl_xor(mx, 32));
        const float mn = fmaxf(mrun, mx); const float alpha = __builtin_amdgcn_exp2f((mrun - mn) * c2); mrun = mn;
        float ps = 0.f;
#pragma unroll
        for (int i = 0; i < 16; ++i) { const float p = __builtin_amdgcn_exp2f((S[i] - mn) * c2); S[i] = p; ps += p; }
        l = l * alpha + ps;
#pragma unroll
        for (int t = 0; t < E / 32; ++t)
#pragma unroll
            for (int i = 0; i < 16; ++i) O[t][i] *= alpha;
        bf16x8 pk[2];
#pragma unroll
        for (int s2 = 0; s2 < 2; ++s2) { v4u w; w.x = cvtpk(S[8 * s2 + 0], S[8 * s2 + 1]); w.y = cvtpk(S[8 * s2 + 2], S[8 * s2 + 3]); w.z = cvtpk(S[8 * s2 + 4], S[8 * s2 + 5]); w.w = cvtpk(S[8 * s2 + 6], S[8 * s2 + 7]); pk[s2] = __builtin_bit_cast(bf16x8, w); }
#pragma unroll
        for (int t = 0; t < E / 32; ++t)
#pragma unroll
            for (int s2 = 0; s2 < 2; ++s2) O[t] = __builtin_amdgcn_mfma_f32_32x32x16_bf16(vfr[t][s2], pk[s2], O[t], 0, 0, 0);
#pragma unroll
        for (int s = 0; s < E / 16; ++s) kf[s] = kn[s];
    }
    l += __shfl_xor(l, 32);
    m_out = mrun; l_out = l;
}

__device__ __forceinline__ void sattn_wave(const bf16* Qp, const bf16* Kt, const bf16* Vt, int j0, int lane, f32x16 (&O)[2][2], float (&m_out)[2], float (&l_out)[2]) {
    const int c = lane & 31, hi = lane >> 5;
    bf16x8 qf[2][4];
#pragma unroll
    for (int q = 0; q < 2; ++q)
#pragma unroll
        for (int s = 0; s < 4; ++s) qf[q][s] = *(const bf16x8*)(Qp + (size_t)(32 * q + c) * 64 + 16 * s + 8 * hi);
    float mrun[2] = {-1e30f, -1e30f}, l[2] = {0.f, 0.f};
#pragma unroll
    for (int q = 0; q < 2; ++q)
#pragma unroll
        for (int t = 0; t < 2; ++t)
#pragma unroll
            for (int i = 0; i < 16; ++i) O[q][t][i] = 0.f;
    const float c2 = 0.125f * 1.4426950408889634f;
    const int kb = j0 >> 5, kt_end = kb + 1, kt_beg = (kb >= 4) ? kb - 4 : 0;
    bf16x8 kf[4], vfr[2][2];
#pragma unroll
    for (int s = 0; s < 4; ++s) kf[s] = *(const bf16x8*)(Kt + (size_t)kt_beg * 2048 + s * 512 + lane * 8);
#pragma unroll
    for (int t = 0; t < 2; ++t)
#pragma unroll
        for (int s2 = 0; s2 < 2; ++s2) vfr[t][s2] = *(const bf16x8*)(Vt + (size_t)kt_beg * 2048 + (t * 2 + s2) * 512 + lane * 8);
    for (int kt = kt_beg; kt <= kt_end; ++kt) {
        const int ktn = (kt < kt_end) ? kt + 1 : kt_end;
        bf16x8 kn[4], vn[2][2];
#pragma unroll
        for (int s = 0; s < 4; ++s) kn[s] = *(const bf16x8*)(Kt + (size_t)ktn * 2048 + s * 512 + lane * 8);
#pragma unroll
        for (int t = 0; t < 2; ++t)
#pragma unroll
            for (int s2 = 0; s2 < 2; ++s2) vn[t][s2] = *(const bf16x8*)(Vt + (size_t)ktn * 2048 + (t * 2 + s2) * 512 + lane * 8);
#pragma unroll
        for (int q = 0; q < 2; ++q) {
            const int kq = kb + q;
            if (kt <= kq && kt + 4 >= kq) {
                f32x16 S;
#pragma unroll
                for (int i = 0; i < 16; ++i) S[i] = 0.f;
#pragma unroll
                for (int s = 0; s < 4; ++s) S = __builtin_amdgcn_mfma_f32_32x32x16_bf16(kf[s], qf[q][s], S, 0, 0, 0);
                const int jq = j0 + 32 * q;
                const bool full = (kt * 32 + 31 <= jq) && (kt * 32 + 128 >= jq + 31);
                if (!full) { const int qj = jq + c;
#pragma unroll
                    for (int i = 0; i < 16; ++i) { const int kj = kt * 32 + (i & 3) + 8 * (i >> 2) + 4 * hi; const bool valid = (kj <= qj) && (kj + 128 >= qj); S[i] = valid ? S[i] : -1e30f; } }
                float mx = S[0];
#pragma unroll
                for (int i = 1; i < 16; ++i) mx = fmaxf(mx, S[i]);
                mx = fmaxf(mx, __shfl_xor(mx, 32));
                const float mn = fmaxf(mrun[q], mx); const float alpha = __builtin_amdgcn_exp2f((mrun[q] - mn) * c2); mrun[q] = mn;
                float ps = 0.f;
#pragma unroll
                for (int i = 0; i < 16; ++i) { const float p = __builtin_amdgcn_exp2f((S[i] - mn) * c2); S[i] = p; ps += p; }
                l[q] = l[q] * alpha + ps;
#pragma unroll
                for (int t = 0; t < 2; ++t)
#pragma unroll
                    for (int i = 0; i < 16; ++i) O[q][t][i] *= alpha;
                bf16x8 pk[2];
#pragma unroll
                for (int s2 = 0; s2 < 2; ++s2) { v4u w; w.x = cvtpk(S[8 * s2 + 0], S[8 * s2 + 1]); w.y = cvtpk(S[8 * s2 + 2], S[8 * s2 + 3]); w.z = cvtpk(S[8 * s2 + 4], S[8 * s2 + 5]); w.w = cvtpk(S[8 * s2 + 6], S[8 * s2 + 7]); pk[s2] = __builtin_bit_cast(bf16x8, w); }
#pragma unroll
                for (int t = 0; t < 2; ++t)
#pragma unroll
                    for (int s2 = 0; s2 < 2; ++s2) O[q][t] = __builtin_amdgcn_mfma_f32_32x32x16_bf16(vfr[t][s2], pk[s2], O[q][t], 0, 0, 0);
            }
        }
#pragma unroll
        for (int s = 0; s < 4; ++s) kf[s] = kn[s];
#pragma unroll
        for (int t = 0; t < 2; ++t)
#pragma unroll
            for (int s2 = 0; s2 < 2; ++s2) vfr[t][s2] = vn[t][s2];
    }
#pragma unroll
    for (int q = 0; q < 2; ++q) { l[q] += __shfl_xor(l[q], 32); m_out[q] = mrun[q]; l_out[q] = l[q]; }
}

constexpr int SSM_LROW = 272;
template <bool PASSB>
__device__ __forceinline__ void ssm_wave(const unsigned char* ws, const float* dd, int b, int g, int segbase, int hstride, int nsp, LAS unsigned char* sb, int lane) {
    const int c = lane & 31, hi = lane >> 5;
    const f32x4 pa0 = *(const f32x4*)(ws + WS_SSMA + (size_t)(g * 64 + c) * 16), pa1 = *(const f32x4*)(ws + WS_SSMA + (size_t)(g * 64 + c + 32) * 16);
    bf16x8 bfr[4];
#pragma unroll
    for (int n = 0; n < 4; ++n) bfr[n] = *(const bf16x8*)(ws + WS_SSMB + ((size_t)((g * 4 + n) * 32 + c) * 16 + 8 * hi) * 2);
    const bf16* U = (const bf16*)(ws + WS_U);
    float s0r = 0.f, s0i = 0.f, s1r = 0.f, s1i = 0.f;
    f32x2* Eb = (f32x2*)(ws + WS_E) + (size_t)(b * 32 + g) * 64 * 64;
    if (PASSB) {
        const int seg = segbase + hstride * hi;
#pragma unroll 8
        for (int sq = 0; sq < seg; ++sq) { const f32x2 e0 = Eb[sq * 64 + c], e1 = Eb[sq * 64 + c + 32];
            const float n0r = pa0.z * s0r - pa0.w * s0i + e0.x, n0i = pa0.z * s0i + pa0.w * s0r + e0.y; s0r = n0r; s0i = n0i;
            const float n1r = pa1.z * s1r - pa1.w * s1i + e1.x, n1i = pa1.z * s1i + pa1.w * s1r + e1.y; s1r = n1r; s1i = n1i; }
    }
    bf16x8 cfr[4];
    if (PASSB) {
#pragma unroll
        for (int ks = 0; ks < 4; ++ks) cfr[ks] = *(const bf16x8*)(ws + WS_SSMC + ((size_t)(g * 16 + (lane & 15)) * 128 + 32 * ks + 8 * (lane >> 4)) * 2);
    }
    const int segsel = (c >> 2) & 1, toff = (c & 3) + 4 * (c >> 3);
    const float dsk = dd[g * 16 + (lane & 15)];
    for (int kp = 0; kp < nsp; ++kp) {
        if (!PASSB) { s0r = 0.f; s0i = 0.f; s1r = 0.f; s1i = 0.f; }
        const int seg0 = segbase + kp;
        const size_t tokA = (size_t)b * 8192 + (size_t)(seg0 + hstride * segsel) * 128 + toff;
        bf16x8 ufn = *(const bf16x8*)(U + tokA * 512 + g * 16 + 8 * hi);
        for (int blk = 0; blk < 8; ++blk) {
            const bf16x8 uf = ufn; { const int bn = (blk < 7) ? blk + 1 : 7; ufn = *(const bf16x8*)(U + (tokA + bn * 16) * 512 + g * 16 + 8 * hi); }
            bf16 uu[2][4];
            if (PASSB) {
#pragma unroll
                for (int ss = 0; ss < 2; ++ss)
#pragma unroll
                    for (int rg = 0; rg < 4; ++rg) uu[ss][rg] = U[((size_t)b * 8192 + (size_t)(seg0 + hstride * ss) * 128 + blk * 16 + (lane >> 4) * 4 + rg) * 512 + g * 16 + (lane & 15)];
            }
            f32x16 z;
#pragma unroll
            for (int i = 0; i < 16; ++i) z[i] = 0.f;
            const f32x16 BU0 = __builtin_amdgcn_mfma_f32_32x32x16_bf16(uf, bfr[0], z, 0, 0, 0), BU1 = __builtin_amdgcn_mfma_f32_32x32x16_bf16(uf, bfr[1], z, 0, 0, 0);
            const f32x16 BU2 = __builtin_amdgcn_mfma_f32_32x32x16_bf16(uf, bfr[2], z, 0, 0, 0), BU3 = __builtin_amdgcn_mfma_f32_32x32x16_bf16(uf, bfr[3], z, 0, 0, 0);
#pragma unroll
            for (int i = 0; i < 16; ++i) {
                const float n0r = pa0.x * s0r - pa0.y * s0i + BU0[i], n0i = pa0.x * s0i + pa0.y * s0r + BU1[i]; s0r = n0r; s0i = n0i;
                const float n1r = pa1.x * s1r - pa1.y * s1i + BU2[i], n1i = pa1.x * s1i + pa1.y * s1r + BU3[i]; s1r = n1r; s1i = n1i;
                if (PASSB) { LAS unsigned char* rowp = sb + (hi * 16 + i) * SSM_LROW + 4 * c;
                    *(LAS unsigned*)rowp = cvtpk(s0r, s0i); *(LAS unsigned*)(rowp + 128) = cvtpk(s1r, s1i); }
            }
            if (PASSB) {
                asm volatile("s_waitcnt lgkmcnt(0)" ::: "memory");
#pragma unroll
                for (int ss = 0; ss < 2; ++ss) {
                    pg8::f32x4 Y = {0.f, 0.f, 0.f, 0.f};
#pragma unroll
                    for (int ks = 0; ks < 4; ++ks) { const bf16x8 af = *(const LAS bf16x8*)(sb + (ss * 16 + (lane & 15)) * SSM_LROW + (32 * ks + 8 * (lane >> 4)) * 2);
                        Y = __builtin_amdgcn_mfma_f32_16x16x32_bf16(af, cfr[ks], Y, 0, 0, 0); }
#pragma unroll
                    for (int rg = 0; rg < 4; ++rg) { const size_t tok = (size_t)b * 8192 + (size_t)(seg0 + hstride * ss) * 128 + blk * 16 + (lane >> 4) * 4 + rg; const size_t o = tok * 512 + g * 16 + (lane & 15);
                        const float y = Y[rg] + dsk * bf2f(uu[ss][rg]);
                        const float zz = 0.7978845608028654f * (y + 0.044715f * y * y * y);
                        const float gl = y * __builtin_amdgcn_rcpf(1.f + __builtin_amdgcn_exp2f(-2.885390081777927f * zz));
                        ((bf16*)(ws + WS_YG))[o] = (bf16)(cvtpk(gl, 0.f) & 0xffffu); }
                }
                asm volatile("s_waitcnt lgkmcnt(0)" ::: "memory");
            }
        }
        if (!PASSB) { const int seg = seg0 + hstride * hi; Eb[seg * 64 + c] = (f32x2){s0r, s0i}; Eb[seg * 64 + c + 32] = (f32x2){s1r, s1i}; }
    }
}

#define RLX_AGENT __ATOMIC_RELAXED, __HIP_MEMORY_SCOPE_AGENT
#define XB_TMO      128
#define XB_XCNT(j)  (256  + 64 * (j))
#define XB_XSUB(j)  (1280 + 64 * (j))
#define XB_XGEN(j)  (2304 + 64 * (j))
#define XB_TOP      3328
#define XB_TOPGEN   3392
#define XCD_BAR_WORDS 3456
#define XB_SPIN_CAP (1u << 18)

__device__ __forceinline__ unsigned xb_ld(unsigned* p)              { return __hip_atomic_load(p, __ATOMIC_RELAXED, __HIP_MEMORY_SCOPE_AGENT); }
__device__ __forceinline__ unsigned xb_add(unsigned* p, unsigned v) { return __hip_atomic_fetch_add(p, v, __ATOMIC_RELAXED, __HIP_MEMORY_SCOPE_AGENT); }
__device__ __forceinline__ unsigned xb_xcc_id() { return (unsigned)__builtin_amdgcn_s_getreg((3 << 11) | 20) & 0xFu; }
#define XB_SPIN(cond, bar) do { unsigned _sp = 0; while (cond) { __builtin_amdgcn_s_sleep(1); \
    if ((++_sp & 255u) == 0u) { if (xb_ld(&(bar)[XB_TMO])) break; if (_sp > XB_SPIN_CAP) { atomicAdd(&(bar)[XB_TMO], 1u); break; } } } } while (0)

struct XcdBarrier {
    unsigned* bar; unsigned x;
    volatile LAS unsigned* st;
};

__device__ __forceinline__ XcdBarrier xcd_barrier_post(unsigned* bar, volatile LAS unsigned* st) {
    XcdBarrier b; b.bar = bar; b.x = xb_xcc_id(); b.st = st;
    if (threadIdx.x == 0) (void)xb_add(&bar[XB_XCNT(b.x)], 1u);
    return b;
}
__device__ __forceinline__ void xcd_barrier_complete(unsigned* bar, unsigned x, unsigned& nloc, unsigned& nx) {
    const unsigned G = gridDim.x * gridDim.y * gridDim.z;
    unsigned sum, cnt, mine, sp = 0u;
    for (;;) {
        sum = 0u; cnt = 0u; mine = 0u;
#pragma unroll
        for (unsigned j = 0; j < 16; ++j) { const unsigned c = xb_ld(&bar[XB_XCNT(j)]); sum += c; cnt += (c > 0u) ? 1u : 0u; mine = (j == x) ? c : mine; }
        if (sum == G) break;
        __builtin_amdgcn_s_sleep(1);
        if ((++sp & 255u) == 0u) { if (xb_ld(&bar[XB_TMO])) break; if (sp > XB_SPIN_CAP) { atomicAdd(&bar[XB_TMO], 1u); break; } }
    }
    nloc = mine > 0u ? mine : 1u; nx = cnt > 0u ? cnt : 1u;
}

__device__ __forceinline__ void xcd_barrier(const XcdBarrier& b) {
    asm volatile("s_waitcnt vmcnt(0)" ::: "memory");
    __syncthreads();
    if (threadIdx.x == 0) {
        unsigned* bar = b.bar;
        __builtin_amdgcn_s_waitcnt(0);
        unsigned nloc = b.st[0], nx = b.st[1];
        if (nloc == 0u) { xcd_barrier_complete(bar, b.x, nloc, nx); b.st[0] = nloc; b.st[1] = nx; }
        const unsigned old = xb_add(&bar[XB_XSUB(b.x)], 1u);
        const unsigned gen = old / nloc;
        if (old + 1u == (gen + 1u) * nloc) {
            __builtin_amdgcn_fence(__ATOMIC_RELEASE, "agent");
            asm volatile("s_waitcnt vmcnt(0)" ::: "memory");
            const unsigned og = xb_add(&bar[XB_TOP], 1u);
            const unsigned tg = og / nx;
            if (og + 1u == (tg + 1u) * nx) xb_add(&bar[XB_TOPGEN], 1u);
            else XB_SPIN(xb_ld(&bar[XB_TOPGEN]) == tg, bar);
            __builtin_amdgcn_fence(__ATOMIC_ACQUIRE, "agent");
            xb_add(&bar[XB_XGEN(b.x)], 1u);
            asm volatile("s_waitcnt vmcnt(0)" ::: "memory");
        } else {
            XB_SPIN(xb_ld(&bar[XB_XGEN(b.x)]) == gen, bar);
            __builtin_amdgcn_fence(__ATOMIC_ACQUIRE, "agent");
            asm volatile("s_waitcnt vmcnt(0)" ::: "memory");
        }
    }
    __syncthreads();
}

__global__ void __launch_bounds__(NWAVES * 64, 2) fwd_megakernel(Args args) {
    __shared__ __attribute__((aligned(16))) unsigned char lds_raw[LDS_BYTES];
    LAS unsigned char* lds = (LAS unsigned char*)lds_raw;
    const int tid = threadIdx.x, lane = tid & 63, wave = __builtin_amdgcn_readfirstlane(tid >> 6);
    const int G = gridDim.x; const int bx = blockIdx.x; const int vcu = (G % 8 == 0) ? (bx % 8) * (G / 8) + bx / 8 : bx;
    const int gw = vcu * NWAVES + wave, NGW = G * NWAVES;
    unsigned char* ws = args.ws;
    const int lo = args.ph_lo, hi_ph = args.ph_hi;
    volatile LAS unsigned* MISC = (volatile LAS unsigned*)(lds + 131072 + 320);
    if (tid < 32) MISC[tid] = 0u;
    __syncthreads();
    XcdBarrier bar; bar.bar = (unsigned*)ws; bar.x = 0; bar.st = nullptr;
    if (hi_ph - lo > 1) bar = xcd_barrier_post((unsigned*)ws, MISC + 8);
    if (lo == 0x7fffffff) cg::this_grid().sync();
#define IN(k) (lo <= (k) && (k) < hi_ph)
#define SEAM(k) do { if (IN(k) && IN((k) + 1)) { xcd_barrier(bar); } } while (0)

    if (IN(0)) {
        LAS float* scr = (LAS float*)(lds + wave * 16384);
        const float* w_in = args.in[4];
        constexpr int I0 = 16 * 64, I1 = 16 * 24, I2 = 16 * 112, I3 = 8 * 16, I4 = 8 * 32, I5 = 4 * 32, I6 = 16 * 32, I7 = 8 * 32, I8 = 16 * 32, I9 = 16 * 128, I10 = 64 * 32;
        constexpr int NITEMS = I0 + I1 + I2 + I3 + I4 + I5 + I6 + I7 + I8 + I9 + I10;
        for (int it = gw; it < NITEMS; it += NGW) {
            int r = it;
            if (r < I0) { p0_transpose_item(w_in, 6400, 0, 1024, 64, (bf16*)(ws + WS_WIN), 0, nullptr, scr, r, lane); continue; } r -= I0;
            if (r < I1) { p0_transpose_item(w_in, 6400, 2048, 1024, 24, (bf16*)(ws + WS_WV), 0, nullptr, scr, r, lane); continue; } r -= I1;
            if (r < I2) { p0_transpose_item(w_in, 6400, 2816, 1024, 112, (bf16*)(ws + WS_WIN), 2048, nullptr, scr, r, lane); continue; } r -= I2;
            if (r < I3) { p0_transpose_item(args.in[14], 512, 0, 512, 16, (bf16*)(ws + WS_WGLU), 0, nullptr, scr, r, lane); continue; } r -= I3;
            if (r < I4) { p0_transpose_item(args.in[16], 1024, 0, 512, 32, (bf16*)(ws + WS_WSSM), 0, nullptr, scr, r, lane); continue; } r -= I4;
            if (r < I5) { p0_transpose_item(args.in[17], 1024, 0, 256, 32, (bf16*)(ws + WS_WATT), 0, nullptr, scr, r, lane); continue; } r -= I5;
            if (r < I6) { p0_transpose_item(args.in[18], 1024, 0, 1024, 32, (bf16*)(ws + WS_WMKV), 0, nullptr, scr, r, lane); continue; } r -= I6;
            if (r < I7) { p0_transpose_item(args.in[19], 1024, 0, 512, 32, (bf16*)(ws + WS_WMEM), 0, nullptr, scr, r, lane); continue; } r -= I7;
            if (r < I8) { p0_transpose_item(args.in[20], 1024, 0, 1024, 32, (bf16*)(ws + WS_WO), 0, nullptr, scr, r, lane); continue; } r -= I8;
            if (r < I9) { p0_transpose_item(args.in[22], 4096, 0, 1024, 128, (bf16*)(ws + WS_WUP), 0, args.in[21], scr, r, lane); continue; } r -= I9;
            p0_transpose_item(args.in[23], 1024, 0, 4096, 32, (bf16*)(ws + WS_WDN), 0, nullptr, scr, r, lane);
        }
        for (int m = gw * 4; m < M; m += NGW * 4) rms_rows_to_bf16<4>(args.in[0] + (size_t)m * D, (size_t)D, args.in[2], (bf16*)(ws + WS_XN) + (size_t)m * D, lane);
        for (int m = gw; m < 2048; m += NGW) rms_rows_to_bf16<1>(args.in[1] + (size_t)m * D, (size_t)D, args.in[3], (bf16*)(ws + WS_MEMN) + (size_t)m * D, lane);
        { const int i = bx * 512 + tid;
          if (i < 2048) { const int g = i >> 6, p = i & 63;
            const double lr = (double)args.in[6][i], li = (double)args.in[7][i], dt = exp((double)args.in[8][g]);
            const double mag = exp(lr * dt); double sn, cs; sincos_d(li * dt, sn, cs);
            const double ar = mag * cs, aim = mag * sn, nr = ar - 1.0, ni = aim, den = lr * lr + li * li;
            const double cr = (nr * lr + ni * li) / den, ci = (ni * lr - nr * li) / den;
            double pr = ar, pi = aim;
#pragma unroll 1
            for (int k = 0; k < 7; ++k) { const double t = pr * pr - pi * pi; pi = 2.0 * pr * pi; pr = t; }
            *(f32x4*)(ws + WS_SSMA + (size_t)i * 16) = (f32x4){(float)ar, (float)aim, (float)pr, (float)pi};
            const int nt0 = (p >> 5) * 2, cc = p & 31;
            bf16* BM_ = (bf16*)(ws + WS_SSMB); bf16* CM_ = (bf16*)(ws + WS_SSMC);
#pragma unroll 1
            for (int h = 0; h < 16; ++h) { const double br = (double)args.in[9][(size_t)i * 16 + h], bi = (double)args.in[10][(size_t)i * 16 + h];
                const float bbr = (float)(cr * br - ci * bi), bbi = (float)(cr * bi + ci * br);
                BM_[((size_t)(g * 4 + nt0) * 32 + cc) * 16 + h] = (bf16)(cvtpk(bbr, 0.f) & 0xffffu);
                BM_[((size_t)(g * 4 + nt0 + 1) * 32 + cc) * 16 + h] = (bf16)(cvtpk(bbi, 0.f) & 0xffffu);
                const float c_r = args.in[11][((size_t)g * 16 + h) * 64 + p], c_i = args.in[12][((size_t)g * 16 + h) * 64 + p];
                CM_[((size_t)g * 16 + h) * 128 + 2 * p] = (bf16)(cvtpk(c_r, 0.f) & 0xffffu);
                CM_[((size_t)g * 16 + h) * 128 + 2 * p + 1] = (bf16)(cvtpk(-c_i, 0.f) & 0xffffu); }
          } }
    }
    SEAM(0);

    if (IN(1)) {
        __syncthreads();
        {
            pg8::Gemm g{(const bf16*)(ws + WS_MEMN), (const bf16*)(ws + WS_WMKV), 2048, 512, 1024, 1024, 1024, 0}; pg8::StaticOrder S; S.init(2048, 512, G, bx);
            pg8::EpiMKf E{(bf16*)(ws + WS_MK)}; pg8::gemm_phase(lds, g, S, E); }
        {
            pg8::Gemm g{(const bf16*)(ws + WS_WMKV) + (size_t)512 * 1024, (const bf16*)(ws + WS_MEMN), 512, 2048, 1024, 1024, 1024, 0}; pg8::StaticOrder S; S.init(512, 2048, G, (bx + G - 16) % G);
            pg8::EpiVTf E{(bf16*)(ws + WS_MVT), 1, 0}; pg8::gemm_phase(lds, g, S, E); }
        {
            pg8::Gemm g{(const bf16*)(ws + WS_XN), (const bf16*)(ws + WS_WIN), M, NIN, 1024, 1024, 1024, 0}; pg8::StaticOrder S; S.init(M, NIN, G, bx);
            pg8::EpiInProj E{(bf16*)(ws + WS_U), (bf16*)(ws + WS_Q), (bf16*)(ws + WS_K), (bf16*)(ws + WS_MQ), (bf16*)(ws + WS_GATES), args.in[5]}; pg8::gemm_phase(lds, g, S, E); }
#pragma unroll 1
        for (int gi = 0; gi < 3; ++gi) {
            const int d = 1 << (2 * gi);
            pg8::Gemm g{(const bf16*)(ws + WS_WV) + (size_t)gi * 256 * 1024, (const bf16*)(ws + WS_XN), 256, M, 1024, 1024, d * 1024, d}; pg8::StaticOrder S; S.init(256, M, G, bx);
            pg8::EpiVTf E{(bf16*)(ws + WS_VT), 0, gi}; pg8::gemm_phase(lds, g, S, E); }
    }
    SEAM(1);

    if (IN(2)) {
        for (int rep = 0; rep < PROBE_REP; ++rep)
        for (int it = gw; it < 12288; it += NGW) {
            const int qb = it & 127, rest = it >> 7, hh = rest & 3, b = (rest >> 2) & 7, g = rest >> 5;
            const int sh = 2 * g, d = 1 << sh, Ld = 8192 >> sh; const int pp0 = qb * 64, r = pp0 / Ld, j0 = pp0 % Ld;
            const size_t hb = ((size_t)(g * 8 + b) * 4 + hh) * 8192;
            const bf16* Qp = (const bf16*)(ws + WS_Q) + (hb + pp0) * 64;
            const bf16* Kt = (const bf16*)(ws + WS_K) + (hb + (size_t)r * Ld) * 64;
            const bf16* Vt = (const bf16*)(ws + WS_VT) + (hb + (size_t)r * Ld) * 64;
            f32x16 O[2][2]; float mr[2], l[2];
            sattn_wave(Qp, Kt, Vt, j0, lane, O, mr, l);
            const int c = lane & 31, hi = lane >> 5;
#pragma unroll
            for (int q = 0; q < 2; ++q) { const float inv = 1.f / l[q];
                const size_t tok = (size_t)b * 8192 + (size_t)(j0 + 32 * q + c) * d + r;
                bf16* og = (bf16*)(ws + WS_OG) + tok * 768 + g * 256 + hh * 64;
#pragma unroll
                for (int t = 0; t < 2; ++t)
#pragma unroll
                    for (int a = 0; a < 4; ++a) { v2u w; w.x = cvtpk(O[q][t][4 * a] * inv, O[q][t][4 * a + 1] * inv); w.y = cvtpk(O[q][t][4 * a + 2] * inv, O[q][t][4 * a + 3] * inv);
                        *(v2u*)(og + 32 * t + 8 * a + 4 * hi) = w; }
                if (hi == 0) ((float*)(ws + WS_LSE))[tok * 12 + g * 4 + hh] = mr[q] * 0.125f + __logf(l[q]); }
        }
        for (int it = gw; it < 8192; it += NGW) {
            const int qb = it & 255, h = (it >> 8) & 3, b = it >> 10;
            bf16* Qp = (bf16*)(ws + WS_MQ) + ((size_t)b * 8192 + qb * 32) * 512 + h * 128;
            const bf16* Kt = (const bf16*)(ws + WS_MK) + (size_t)(b * 4 + h) * 8 * 4096;
            const bf16* Vt = (const bf16*)(ws + WS_MVT) + (size_t)(b * 4 + h) * 8 * 4096;
            f32x16 O[4]; float mr, l;
            attn_wave<128, false>(Qp, 512, Kt, Vt, 0, 7, 0, lane, O, mr, l);
            const int c = lane & 31, hi = lane >> 5; const float inv = 1.f / l;
            bf16* om = Qp + (size_t)c * 512;
#pragma unroll
            for (int t = 0; t < 4; ++t)
#pragma unroll
                for (int a = 0; a < 4; ++a) { v2u w; w.x = cvtpk(O[t][4 * a] * inv, O[t][4 * a + 1] * inv); w.y = cvtpk(O[t][4 * a + 2] * inv, O[t][4 * a + 3] * inv);
                    *(v2u*)(om + 32 * t + 8 * a + 4 * hi) = w; }
        }
        for (int rep = 0; rep < PROBE_REP; ++rep)
        for (int it = gw; it < 8192; it += NGW) { const int sp = it & 31, g = (it >> 5) & 31, b = it >> 10; ssm_wave<false>(ws, args.in[13], b, g, 2 * sp, 1, 1, lds + wave * 16384, lane); }
    }
    SEAM(2);

    if (IN(3)) {
        for (int rep = 0; rep < PROBE_P3; ++rep)
        for (int it = gw; it < 2048; it += NGW) { const int qd = it & 7, g = (it >> 3) & 31, b = it >> 8;
            ssm_wave<true>(ws, args.in[13], b, g, 8 * qd, 4, 4, lds + wave * 16384, lane); }
        for (int m2 = gw; m2 < M / 2; m2 += NGW) { const size_t tok = (size_t)m2 * 2 + (lane >> 5); const int cc = (lane & 31) * 8, hh = cc >> 6;
            const float* ls = (const float*)(ws + WS_LSE) + tok * 12 + hh; const float l0 = ls[0], l1 = ls[4], l2 = ls[8];
            const float mx = fmaxf(l0, fmaxf(l1, l2)); const float e0 = __expf(l0 - mx), e1 = __expf(l1 - mx), e2 = __expf(l2 - mx); const float inv = 1.f / (e0 + e1 + e2);
            const bf16* og = (const bf16*)(ws + WS_OG) + tok * 768 + cc;
            pg8::f32x4 a0, a1, b0, b1, c0, c1; pg8::unpack8(*(const v4u*)og, a0, a1); pg8::unpack8(*(const v4u*)(og + 256), b0, b1); pg8::unpack8(*(const v4u*)(og + 512), c0, c1);
            const float w0 = e0 * inv, w1 = e1 * inv, w2 = e2 * inv;
            const pg8::f32x4 r0 = a0 * w0 + b0 * w1 + c0 * w2, r1 = a1 * w0 + b1 * w1 + c1 * w2;
            *(v4u*)((bf16*)(ws + WS_OMRG) + tok * 256 + cc) = pg8::pack8(r0, r1); }
    }
    SEAM(3);

    if (IN(4)) {
        __syncthreads();
        pg8::Gemm g{(const bf16*)(ws + WS_YG), (const bf16*)(ws + WS_WGLU), M, 512, 512, 512, 512, 0}; pg8::StaticOrder S; S.init(M, 512, G, bx);
        pg8::EpiGlu E{(const bf16*)(ws + WS_YG), (bf16*)(ws + WS_Y2), args.in[15]}; pg8::gemm_phase(lds, g, S, E);
    }
    SEAM(4);

    if (IN(5)) {
        __syncthreads();
        pg8::StaticOrder S; S.init(M, 1024, G, bx);
        { pg8::Gemm g{(const bf16*)(ws + WS_Y2), (const bf16*)(ws + WS_WSSM), M, 1024, 512, 512, 512, 0};
          pg8::EpiBranch<0> E{(const bf16*)(ws + WS_GATES), (bf16*)(ws + WS_MG), 0}; pg8::gemm_phase(lds, g, S, E); }
        { pg8::Gemm g{(const bf16*)(ws + WS_OMRG), (const bf16*)(ws + WS_WATT), M, 1024, 256, 256, 256, 0};
          pg8::EpiBranch<1> E{(const bf16*)(ws + WS_GATES), (bf16*)(ws + WS_MG), 1024}; pg8::gemm_phase(lds, g, S, E); }
        { pg8::Gemm g{(const bf16*)(ws + WS_MQ), (const bf16*)(ws + WS_WMEM), M, 1024, 512, 512, 512, 0};
          pg8::EpiBranch<1> E{(const bf16*)(ws + WS_GATES), (bf16*)(ws + WS_MG), 2048}; pg8::gemm_phase(lds, g, S, E); }
    }
    SEAM(5);

    if (IN(6)) {
        __syncthreads();
        pg8::Gemm g{(const bf16*)(ws + WS_MG), (const bf16*)(ws + WS_WO), M, 1024, 1024, 1024, 1024, 0}; pg8::StaticOrder S; S.init(M, 1024, G, bx);
        pg8::EpiResid<0> E{args.in[0], (bf16*)(ws + WS_HB), (float*)(ws + WS_SSP1)}; pg8::gemm_phase(lds, g, S, E);
    }
    SEAM(6);

    if (IN(7)) {
        __syncthreads();
        pg8::Gemm g{(const bf16*)(ws + WS_HB), (const bf16*)(ws + WS_WUP), M, FF, 1024, 1024, 1024, 0}; pg8::StaticOrder S; S.init(M, FF, G, bx);
        pg8::EpiUp E{(const float*)(ws + WS_SSP1), (bf16*)(ws + WS_ACT)};
        pg8::gemm_phase(lds, g, S, E);
        if (PROBE_G7 > 1) pg8::gemm_phase(lds, g, S, E);
    }
    SEAM(7);

    if (IN(8)) {
        __syncthreads();
        pg8::Gemm g{(const bf16*)(ws + WS_ACT), (const bf16*)(ws + WS_WDN), M, 1024, FF, FF, FF, 0}; pg8::StaticOrder S; S.init(M, 1024, G, bx);
        pg8::EpiResid<1> E{nullptr, (bf16*)(ws + WS_HB), (float*)(ws + WS_SSP2)}; pg8::gemm_phase(lds, g, S, E);
    }
    SEAM(8);

    if (IN(9)) {
        const f32x4* gr = (const f32x4*)args.in[24];
        const int c8a = lane * 8, c8b = (lane + 64) * 8;
        const f32x4 ga0 = gr[c8a / 4], ga1 = gr[c8a / 4 + 1], gb0 = gr[c8b / 4], gb1 = gr[c8b / 4 + 1];
        for (int m = gw * 4; m < M; m += NGW * 4) {
            float pv[4]; v4u ha[4], hb4[4];
#pragma unroll
            for (int r = 0; r < 4; ++r) { pv[r] = (lane < 16) ? ((const float*)(ws + WS_SSP2))[(size_t)(m + r) * 16 + lane] : 0.f;
                const bf16* hr = (const bf16*)(ws + WS_HB) + (size_t)(m + r) * D; ha[r] = *(const v4u*)(hr + c8a); hb4[r] = *(const v4u*)(hr + c8b); }
#pragma unroll
            for (int r = 0; r < 4; ++r) { const float rs = 1.0f / sqrtf(wave_sum(pv[r]) * (1.f / 1024.f) + 1e-6f);
                f32x4* xr = (f32x4*)(args.out + (size_t)(m + r) * D); pg8::f32x4 v0, v1;
                pg8::unpack8(ha[r], v0, v1); xr[c8a / 4] = v0 * rs * ga0; xr[c8a / 4 + 1] = v1 * rs * ga1;
                pg8::unpack8(hb4[r], v0, v1); xr[c8b / 4] = v0 * rs * gb0; xr[c8b / 4 + 1] = v1 * rs * gb1; } }
    }
#undef IN
#undef SEAM
}

#ifndef DBG_PH
#define DBG_PH 0
#endif
struct DumpSeg { size_t off; unsigned n; unsigned pad; };
struct DumpArgs { float* out; const unsigned char* ws; DumpSeg s[6]; };
__global__ void dbg_dump(DumpArgs a) {
    size_t base = 0;
    float mag = 1e12f;
    for (int k = 0; k < 6; ++k, mag *= 0.1f) { const unsigned short* src = (const unsigned short*)(a.ws + a.s[k].off);
        for (size_t i = (size_t)blockIdx.x * blockDim.x + threadIdx.x; i < a.s[k].n; i += (size_t)gridDim.x * blockDim.x) a.out[base + i] = ((src[i] & 0x7f80u) == 0x7f80u) ? mag : 0.f;
        base += a.s[k].n; }
    for (size_t i = base + (size_t)blockIdx.x * blockDim.x + threadIdx.x; i < (size_t)M * D; i += (size_t)gridDim.x * blockDim.x) a.out[i] = 0.f;
}
extern "C" void kernel_launch(void* const* d_in, const int* in_sizes, int n_in, void* d_out, int out_size, void* d_ws, size_t ws_size, hipStream_t stream) {
    static int grid = 0;
    if (grid == 0) {
        if (n_in != 25 || out_size != M * D || ws_size < WS_END) { fprintf(stderr, "kernel_launch: unexpected shapes (n_in %d out %d ws %zu)\n", n_in, out_size, ws_size); grid = -1; return; }
        int dev = 0, cus = 0, per_cu = 0;
        if (hipGetDevice(&dev) != hipSuccess || hipDeviceGetAttribute(&cus, hipDeviceAttributeMultiprocessorCount, dev) != hipSuccess) { grid = -1; return; }
        if (hipOccupancyMaxActiveBlocksPerMultiprocessor(&per_cu, (const void*)fwd_megakernel, NWAVES * 64, 0) != hipSuccess || per_cu < 1) { fprintf(stderr, "kernel_launch: occupancy query says %d\n", per_cu); per_cu = 1; }
        (void)hipGetLastError();
        grid = cus;
    }
    if (grid < 0) return;
    Args a{};
    for (int i = 0; i < 25; ++i) a.in[i] = (const float*)d_in[i];
    a.out = (float*)d_out; a.ws = (unsigned char*)d_ws;
#if MK_N_LAUNCHES == 1
    if (hipMemsetAsync(d_ws, 0, 65536, stream) != hipSuccess) { fprintf(stderr, "kernel_launch: memset of the barrier words failed\n"); return; }
    a.ph_lo = 0; a.ph_hi = N_PHASES;
    void* kargs[] = {&a};
    hipError_t e = hipLaunchCooperativeKernel((const void*)fwd_megakernel, dim3(grid), dim3(NWAVES * 64), kargs, 0, stream);
    if (e != hipSuccess) fprintf(stderr, "kernel_launch: cooperative launch failed: %s (grid %d)\n", hipGetErrorString(e), grid);
#else
    const int np = DBG_PH ? DBG_PH + 1 : N_PHASES;
    for (int p = 0; p < np; ++p) { a.ph_lo = p; a.ph_hi = p + 1; hipLaunchKernelGGL(fwd_megakernel, dim3(grid), dim3(NWAVES * 64), 0, stream, a); }
#if DBG_PH && DBG_PH < 8
    { DumpArgs da{}; da.out = (float*)d_out; da.ws = (const unsigned char*)d_ws;
      DBG_SEGS
      hipLaunchKernelGGL(dbg_dump, dim3(2048), dim3(256), 0, stream, da); }
#endif
#endif
}
```

```cpp
#include <hip/hip_runtime.h>
#include <hip/hip_cooperative_groups.h>
#include <cstdio>
#include <cstdint>
namespace cg = cooperative_groups;

#define DBG_PH 0
#define DBG_SEGS da.s[0] = {WS_GATES, 12u << 20, 0}; da.s[1] = {WS_OG, 12u << 20, 0}; da.s[2] = {WS_MQ, 12u << 20, 0}; da.s[3] = {WS_YG, 8u << 20, 0}; da.s[4] = {WS_OMRG, 8u << 20, 0}; da.s[5] = {WS_MG, 12u << 20, 0};
#ifndef PROBE_G7
#define PROBE_G7 1
#endif
#ifndef PROBE_REP
#define PROBE_REP 1
#define PROBE_P3 1
#endif
#ifndef MK_N_LAUNCHES
#define MK_N_LAUNCHES 1
#endif

namespace pg8 {
#define PG8_LAS __attribute__((address_space(3)))
typedef unsigned short bf16_t;
typedef short bf16x8 __attribute__((ext_vector_type(8)));
typedef float f32x4 __attribute__((ext_vector_type(4)));
typedef unsigned u32x4 __attribute__((ext_vector_type(4)));
constexpr int BM = 256, BK = 64, HALF = 128, HTB = HALF * BK * 2, STAGE_BYTES = 8 * HTB, NXCD = 8, WGM = 8;

__host__ __device__ __forceinline__ int lds_byte(int r, int c) { const int st = (r >> 4) * 2 + (c >> 5), rr = r & 15, cc = c & 31, ob = rr * 64 + cc * 2; return st * 1024 + (ob ^ (((ob >> 9) & 1) << 5)); }
__host__ __device__ __forceinline__ void stage_rc(int b, int& R, int& C) { const int st = b / 1024, sb = b % 1024, swz = sb ^ (((sb >> 9) & 1) << 5); R = (st >> 1) * 16 + swz / 64; C = (st & 1) * 32 + (swz % 64) / 2; }
__host__ __device__ __forceinline__ int perm32(int rho) { const int n = rho >> 4, i = rho & 15; return 8 * (i >> 2) + 4 * n + (i & 3); }

struct Unit { int pm, pn; };
struct Gemm { const bf16_t* A; const bf16_t* Bt; int M, N, K; int lda, ldb; int bdil; };
__device__ __forceinline__ const char* a_tile(const Gemm& g, int pm) { return (const char*)g.A + (size_t)pm * 256 * (size_t)g.lda * 2; }
__device__ __forceinline__ const char* b_tile(const Gemm& g, int pn) {
    if (g.bdil == 0) return (const char*)g.Bt + (size_t)pn * 256 * (size_t)g.ldb * 2;
    const int d = g.bdil, Ld = 8192 / d, b = pn >> 5, pp0 = (pn & 31) * 256, r = pp0 / Ld, j0 = pp0 % Ld;
    return (const char*)g.Bt + ((size_t)b * 8192 + (size_t)j0 * d + r) * 1024 * 2;
}

struct StaticOrder {
    int nM, nN, nwg, G, c;
    __host__ __device__ void init(int M, int N, int G_, int c_) { nM = M / BM; nN = N / BM; nwg = nM * nN; G = G_; c = c_; }
    __host__ __device__ bool next(int i, Unit& u) const {
        const long L = (long)i * G + c; if (L >= nwg) return false;
        int wgid = (int)L; { const int q = nwg / NXCD, r = nwg % NXCD, xcd = wgid % NXCD, off = wgid / NXCD; wgid = (xcd < r ? xcd * (q + 1) : r * (q + 1) + (xcd - r) * q) + off; }
        const int nig = WGM * nN, gid = wgid / nig, fm = gid * WGM, gsz = (nM - fm) < WGM ? (nM - fm) : WGM;
        u.pm = fm + ((wgid % nig) % gsz); u.pn = (wgid % nig) / gsz; return true;
    }
};

typedef float f32x2_ __attribute__((ext_vector_type(2))); typedef __bf16 bf16x2_ __attribute__((ext_vector_type(2)));
__device__ __forceinline__ unsigned cvt_pk_bf16(float lo, float hi) { f32x2_ v = {lo, hi}; bf16x2_ b = __builtin_convertvector(v, bf16x2_); return __builtin_bit_cast(unsigned, b); }
__device__ __forceinline__ float bf_lo(unsigned w) { return __builtin_bit_cast(float, w << 16); }
__device__ __forceinline__ float bf_hi(unsigned w) { return __builtin_bit_cast(float, w & 0xffff0000u); }
__device__ __forceinline__ u32x4 pack8(const f32x4 v0, const f32x4 v1) { u32x4 w; w.x = cvt_pk_bf16(v0[0], v0[1]); w.y = cvt_pk_bf16(v0[2], v0[3]); w.z = cvt_pk_bf16(v1[0], v1[1]); w.w = cvt_pk_bf16(v1[2], v1[3]); return w; }
__device__ __forceinline__ void unpack8(const u32x4 w, f32x4& v0, f32x4& v1) { v0 = (f32x4){bf_lo(w.x), bf_hi(w.x), bf_lo(w.y), bf_hi(w.y)}; v1 = (f32x4){bf_lo(w.z), bf_hi(w.z), bf_lo(w.w), bf_hi(w.w)}; }
typedef unsigned u32x2 __attribute__((ext_vector_type(2)));
__device__ __forceinline__ unsigned q8x4(const f32x4 v) {
    unsigned r = 0u;
    r = __builtin_amdgcn_cvt_pk_u8_f32(__builtin_rintf(v[0] * 255.f), 0, r); r = __builtin_amdgcn_cvt_pk_u8_f32(__builtin_rintf(v[1] * 255.f), 1, r);
    r = __builtin_amdgcn_cvt_pk_u8_f32(__builtin_rintf(v[2] * 255.f), 2, r); r = __builtin_amdgcn_cvt_pk_u8_f32(__builtin_rintf(v[3] * 255.f), 3, r); return r; }
__device__ __forceinline__ f32x4 dq8x4(unsigned w) { const float k = 1.f / 255.f;
    return (f32x4){(float)(w & 0xffu) * k, (float)((w >> 8) & 0xffu) * k, (float)((w >> 16) & 0xffu) * k, (float)(w >> 24) * k}; }
__device__ __forceinline__ float sigm(float x) { return __builtin_amdgcn_rcpf(1.f + __builtin_amdgcn_exp2f(-1.4426950408889634f * x)); }

#define EPI_LOOP _Pragma("unroll") for (int ai = 0; ai < 2; ++ai) _Pragma("unroll") for (int m = 0; m < 4; ++m) _Pragma("unroll") for (int bj = 0; bj < 2; ++bj)
#define EPI_ROW (u.pm * 256 + ai * 128 + wr * 64 + m * 16 + fr)
#define EPI_COL (u.pn * 256 + bj * 128 + wc * 32 + 8 * fq)
typedef f32x4 AccT[2][2][4][2];

struct EpiPlain {
    bf16_t* O; size_t ldc;
    __device__ __forceinline__ void operator()(const AccT& acc, const Unit& u, int wr, int wc, int fr, int fq) const {
        EPI_LOOP { const int row = EPI_ROW, col = EPI_COL; *(u32x4*)(O + (size_t)row * ldc + col) = pack8(acc[ai][bj][m][0], acc[ai][bj][m][1]); }
    }
};
struct EpiVTf {
    bf16_t* O; int mem; int g;
    __device__ __forceinline__ void operator()(const AccT& acc, const Unit& u, int wr, int wc, int fr, int fq) const {
        EPI_LOOP { const int row = EPI_ROW, col = EPI_COL;
            int e, kk; size_t tb;
            if (mem) { const int h = row >> 7, b = col >> 8; e = row & 127; kk = col & 255; tb = ((size_t)((b * 4 + h) * 8 + (kk >> 5))) * 4096; }
            else { const int hh = row >> 6, b = col >> 13; e = row & 63; kk = col & 8191; tb = (((size_t)(g * 8 + b) * 4 + hh) * 8192) * 64 + (size_t)(kk >> 5) * 2048; }
            const int t = e >> 5, c = e & 31, k0 = kk & 31, s2 = k0 >> 4, half = (k0 >> 3) & 1;
            bf16_t* d0 = O + tb + (((t * 2 + s2) * 2 + 0) * 32 + c) * 8 + half * 4;
            const f32x4 v0 = acc[ai][bj][m][0], v1 = acc[ai][bj][m][1];
            typedef unsigned u32x2 __attribute__((ext_vector_type(2)));
            u32x2 w0, w1; w0.x = cvt_pk_bf16(v0[0], v0[1]); w0.y = cvt_pk_bf16(v0[2], v0[3]); w1.x = cvt_pk_bf16(v1[0], v1[1]); w1.y = cvt_pk_bf16(v1[2], v1[3]);
            *(u32x2*)d0 = w0; *(u32x2*)(d0 + 256) = w1; }
    }
};
struct EpiMKf {
    bf16_t* O;
    __device__ __forceinline__ void operator()(const AccT& acc, const Unit& u, int wr, int wc, int fr, int fq) const {
        EPI_LOOP { const int row = EPI_ROW, col = EPI_COL; const int b = row >> 8, key = row & 255, h = col >> 7, e = col & 127;
            *(u32x4*)(O + ((size_t)((b * 4 + h) * 8 + (key >> 5))) * 4096 + (((e >> 4) * 2 + ((e >> 3) & 1)) * 32 + (key & 31)) * 8) = pack8(acc[ai][bj][m][0], acc[ai][bj][m][1]); }
    }
};
struct EpiInProj {
    bf16_t *U, *Q, *Kb, *MQ, *GATES; const float* b_gate;
    __device__ __forceinline__ void operator()(const AccT& acc, const Unit& u, int wr, int wc, int fr, int fq) const {
        const int pn = u.pn;
        if (pn < 2) { EPI_LOOP { const int row = EPI_ROW, col = EPI_COL; *(u32x4*)(U + (size_t)row * 512 + col) = pack8(acc[ai][bj][m][0], acc[ai][bj][m][1]); } }
        else if (pn < 8) {
            const int g = (pn < 5) ? pn - 2 : pn - 5; bf16_t* base = (pn < 5) ? Q : Kb; const int sh = 2 * g  , Ld = 8192 >> sh, dm = (1 << sh) - 1;
            const bool isk = (pn >= 5);
            EPI_LOOP { const int row = EPI_ROW, colw = bj * 128 + wc * 32 + 8 * fq; const int hh = colw >> 6, e = colw & 63, b = row >> 13, t = row & 8191;
                const int pp = (t & dm) * Ld + (t >> sh);
                const size_t hbase = (((size_t)(g * 8 + b) * 4 + hh) * 8192) * 64;
                const size_t off = isk ? hbase + (size_t)(pp >> 5) * 2048 + ((((e >> 4) * 2 + ((e >> 3) & 1)) * 32 + (pp & 31)) * 8) : hbase + (size_t)pp * 64 + e;
                *(u32x4*)(base + off) = pack8(acc[ai][bj][m][0], acc[ai][bj][m][1]); }
        }
        else if (pn < 10) { EPI_LOOP { const int row = EPI_ROW, col = EPI_COL - 2048; *(u32x4*)(MQ + (size_t)row * 512 + col) = pack8(acc[ai][bj][m][0], acc[ai][bj][m][1]); } }
        else {
            f32x4 bb0[2], bb1[2];
#pragma unroll
            for (int bj = 0; bj < 2; ++bj) { const int col = EPI_COL - 2560; bb0[bj] = *(const f32x4*)(b_gate + col); bb1[bj] = *(const f32x4*)(b_gate + col + 4); }
            EPI_LOOP { const int row = EPI_ROW, col = EPI_COL - 2560;
                f32x4 v0 = acc[ai][bj][m][0] + bb0[bj], v1 = acc[ai][bj][m][1] + bb1[bj];
#pragma unroll
                for (int i = 0; i < 4; ++i) { v0[i] = sigm(v0[i]); v1[i] = sigm(v1[i]); }
                u32x2 w; w.x = q8x4(v0); w.y = q8x4(v1);
                *(u32x2*)((unsigned char*)GATES + (size_t)row * 3072 + col) = w; }
        }
    }
};
struct EpiGlu {
    const bf16_t* YG; bf16_t* Y2; const float* b;
    __device__ __forceinline__ void operator()(const AccT& acc, const Unit& u, int wr, int wc, int fr, int fq) const {
        f32x4 bb0[2], bb1[2];
#pragma unroll
        for (int bj = 0; bj < 2; ++bj) { const int col = EPI_COL; bb0[bj] = *(const f32x4*)(b + col); bb1[bj] = *(const f32x4*)(b + col + 4); }
#pragma unroll
        for (int ai = 0; ai < 2; ++ai) {
            u32x4 yv[4][2];
#pragma unroll
            for (int m = 0; m < 4; ++m)
#pragma unroll
                for (int bj = 0; bj < 2; ++bj) { const int row = EPI_ROW, col = EPI_COL; yv[m][bj] = *(const u32x4*)(YG + (size_t)row * 512 + col); }
#pragma unroll
            for (int m = 0; m < 4; ++m)
#pragma unroll
                for (int bj = 0; bj < 2; ++bj) { const int row = EPI_ROW, col = EPI_COL;
                    f32x4 y0, y1; unpack8(yv[m][bj], y0, y1);
                    f32x4 v0 = acc[ai][bj][m][0] + bb0[bj], v1 = acc[ai][bj][m][1] + bb1[bj];
#pragma unroll
                    for (int i = 0; i < 4; ++i) { v0[i] = y0[i] * sigm(v0[i]); v1[i] = y1[i] * sigm(v1[i]); }
                    *(u32x4*)(Y2 + (size_t)row * 512 + col) = pack8(v0, v1); }
        }
    }
};
template <int MODE> struct EpiBranch {
    const bf16_t* GATES; bf16_t* MG; int goff;
    __device__ __forceinline__ void operator()(const AccT& acc, const Unit& u, int wr, int wc, int fr, int fq) const {
#pragma unroll
        for (int ai = 0; ai < 2; ++ai) {
            u32x2 gv[4][2]; u32x4 pv[4][2];
#pragma unroll
            for (int m = 0; m < 4; ++m)
#pragma unroll
                for (int bj = 0; bj < 2; ++bj) { const int row = EPI_ROW, col = EPI_COL; gv[m][bj] = *(const u32x2*)((const unsigned char*)GATES + (size_t)row * 3072 + goff + col);
                    if (MODE == 1) pv[m][bj] = *(const u32x4*)(MG + (size_t)row * 1024 + col); }
#pragma unroll
            for (int m = 0; m < 4; ++m)
#pragma unroll
                for (int bj = 0; bj < 2; ++bj) { const int row = EPI_ROW, col = EPI_COL; const f32x4 g0 = dq8x4(gv[m][bj].x), g1 = dq8x4(gv[m][bj].y);
                    f32x4 v0 = acc[ai][bj][m][0] * g0, v1 = acc[ai][bj][m][1] * g1;
                    if (MODE == 1) { f32x4 p0, p1; unpack8(pv[m][bj], p0, p1); v0 += p0; v1 += p1; }
                    *(u32x4*)(MG + (size_t)row * 1024 + col) = pack8(v0, v1); }
        }
    }
};
template <int MODE> struct EpiResid {
    const bf16_t* XN; const float* XS; const float* G1; bf16_t* HB; float* SS;
    __device__ __forceinline__ void operator()(const AccT& acc, const Unit& u, int wr, int wc, int fr, int fq) const {
        f32x4 ig0[2], ig1[2];
        if (MODE == 0) {
#pragma unroll
            for (int bj = 0; bj < 2; ++bj) { const int col = EPI_COL; const f32x4 a = *(const f32x4*)(G1 + col), b = *(const f32x4*)(G1 + col + 4);
#pragma unroll
                for (int i = 0; i < 4; ++i) { ig0[bj][i] = 1.0f / a[i]; ig1[bj][i] = 1.0f / b[i]; } }
        }
#pragma unroll
        for (int ai = 0; ai < 2; ++ai) {
            u32x4 hv[4][2]; float xs[4];
#pragma unroll
            for (int m = 0; m < 4; ++m) { const int row = EPI_ROW; if (MODE == 0) xs[m] = XS[row];
#pragma unroll
                for (int bj = 0; bj < 2; ++bj) { const int col = EPI_COL; const size_t o = (size_t)row * 1024 + col;
                    hv[m][bj] = *(const u32x4*)((MODE == 0 ? XN : HB) + o); } }
#pragma unroll
            for (int m = 0; m < 4; ++m) { const int row = EPI_ROW; float ss = 0.f;
#pragma unroll
                for (int bj = 0; bj < 2; ++bj) { const int col = EPI_COL; const size_t o = (size_t)row * 1024 + col;
                    f32x4 r0, r1; unpack8(hv[m][bj], r0, r1);
                    if (MODE == 0) { r0 = r0 * xs[m] * ig0[bj]; r1 = r1 * xs[m] * ig1[bj]; }
                    const f32x4 v0 = acc[ai][bj][m][0] + r0, v1 = acc[ai][bj][m][1] + r1;
                    *(u32x4*)(HB + o) = pack8(v0, v1);
                    ss += (v0[0] * v0[0] + v0[1] * v0[1]) + (v0[2] * v0[2] + v0[3] * v0[3]) + (v1[0] * v1[0] + v1[1] * v1[1]) + (v1[2] * v1[2] + v1[3] * v1[3]); }
                ss += __shfl_xor(ss, 16); ss += __shfl_xor(ss, 32);
                if (fq == 0) SS[(size_t)row * 16 + u.pn * 4 + wc] = ss; }
        }
    }
};
struct EpiUp {
    const float* SS; bf16_t* ACT;
    __device__ __forceinline__ void operator()(const AccT& acc, const Unit& u, int wr, int wc, int fr, int fq) const {
        float rsv[2][4];
#pragma unroll
        for (int ai = 0; ai < 2; ++ai) { f32x4 q[4][4];
#pragma unroll
            for (int m = 0; m < 4; ++m) { const int row = EPI_ROW; const f32x4* sp = (const f32x4*)(SS + (size_t)row * 16);
#pragma unroll
                for (int k = 0; k < 4; ++k) q[m][k] = sp[k]; }
#pragma unroll
            for (int m = 0; m < 4; ++m) { const float tot = ((q[m][0][0] + q[m][0][1]) + (q[m][0][2] + q[m][0][3])) + ((q[m][1][0] + q[m][1][1]) + (q[m][1][2] + q[m][1][3])) + ((q[m][2][0] + q[m][2][1]) + (q[m][2][2] + q[m][2][3])) + ((q[m][3][0] + q[m][3][1]) + (q[m][3][2] + q[m][3][3]));
                rsv[ai][m] = 1.0f / sqrtf(tot * (1.f / 1024.f) + 1e-6f); } }
#pragma unroll
        for (int ai = 0; ai < 2; ++ai)
#pragma unroll
            for (int m = 0; m < 4; ++m) { const int row = EPI_ROW; const float rs = rsv[ai][m];
#pragma unroll
                for (int bj = 0; bj < 2; ++bj) { const int col = EPI_COL; f32x4 v0 = acc[ai][bj][m][0] * rs, v1 = acc[ai][bj][m][1] * rs;
#pragma unroll
                    for (int i = 0; i < 4; ++i) { const float a = fmaxf(v0[i], 0.f), b = fmaxf(v1[i], 0.f); v0[i] = a * a; v1[i] = b * b; }
                    *(u32x4*)(ACT + (size_t)row * 4096 + col) = pack8(v0, v1); } }
    }
};

template <class Epi>
__device__ __forceinline__ void gemm_phase(PG8_LAS unsigned char* lds, const Gemm g, const StaticOrder& S, const Epi& E) {
    const int tid = threadIdx.x, wid = __builtin_amdgcn_readfirstlane(tid >> 6), lane = tid & 63, wr = wid >> 2, wc = wid & 3, fr = lane & 15, fq = lane >> 4;
    const int K = g.K, nt = K / BK;
    unsigned voffA[2], voffB[2];
#pragma unroll
    for (int i = 0; i < 2; ++i) { int R, C; stage_rc(tid * 16 + i * 8192, R, C); const int Rb = (R & ~31) + perm32(R & 31);
        voffA[i] = (unsigned)(R * g.lda + C) * 2u; voffB[i] = (unsigned)(Rb * g.ldb + C) * 2u; }
    const size_t kstep = (size_t)(BK * 2);
    const size_t hstepA = (size_t)HALF * g.lda * 2, hstepB = (size_t)HALF * g.ldb * 2;
    const unsigned ldsw = (unsigned)wid * 1024u;
    const int aoff = lds_byte(wr * 64 + fr, fq * 8), boff = lds_byte(wc * 32 + fr, fq * 8);
#define PG8_SA(b, h) (((b) * 2 + (h)) * HTB)
#define PG8_SB(b, h) ((4 + (b) * 2 + (h)) * HTB)
#define PG8_STAGE(bufoff, gbase, voff) do { _Pragma("unroll") for (int _i = 0; _i < 2; ++_i) \
        __builtin_amdgcn_global_load_lds((const unsigned*)((const char*)(gbase) + (voff)[_i]), (PG8_LAS unsigned*)(lds + (bufoff) + ldsw + _i * 8192), 16, 0, 0); } while (0)
#define PG8_LDA(dst, b, h) do { _Pragma("unroll") for (int m = 0; m < 4; ++m) _Pragma("unroll") for (int k = 0; k < 2; ++k) dst[m][k] = *(const PG8_LAS bf16x8*)(lds + PG8_SA(b, h) + aoff + m * 2048 + k * 1024); } while (0)
#define PG8_LDB(dst, b, h) do { _Pragma("unroll") for (int n = 0; n < 2; ++n) _Pragma("unroll") for (int k = 0; k < 2; ++k) dst[n][k] = *(const PG8_LAS bf16x8*)(lds + PG8_SB(b, h) + boff + n * 2048 + k * 1024); } while (0)
#define PG8_MMA(ai, bj, At, Bt) do { __builtin_amdgcn_s_setprio(1); _Pragma("unroll") for (int m = 0; m < 4; ++m) _Pragma("unroll") for (int n = 0; n < 2; ++n) _Pragma("unroll") for (int k = 0; k < 2; ++k) \
        acc[ai][bj][m][n] = __builtin_amdgcn_mfma_f32_16x16x32_bf16(Bt[n][k], At[m][k], acc[ai][bj][m][n], 0, 0, 0); __builtin_amdgcn_s_setprio(0); } while (0)
#define PG8_WAIT_V(n) asm volatile("s_waitcnt vmcnt(" #n ")" ::: "memory")
#define PG8_WAIT_L(n) asm volatile("s_waitcnt lgkmcnt(" #n ")" ::: "memory")
#define PG8_BAR __builtin_amdgcn_s_barrier()
#define PG8_SCHED __builtin_amdgcn_sched_barrier(0)
    Unit cur, nxt; int ui = 0;
    if (!S.next(0, cur)) return;
    f32x4 acc[2][2][4][2];
#pragma unroll
    for (int a = 0; a < 2; ++a)
#pragma unroll
        for (int b = 0; b < 2; ++b)
#pragma unroll
            for (int m = 0; m < 4; ++m)
#pragma unroll
                for (int n = 0; n < 2; ++n) acc[a][b][m][n] = (f32x4){0.f, 0.f, 0.f, 0.f};
    bf16x8 At[4][2], B0[2][2], B1[2][2];
    const char* cA = a_tile(g, cur.pm); const char* cB = b_tile(g, cur.pn);
    PG8_STAGE(PG8_SB(0, 0), cB, voffB); PG8_STAGE(PG8_SB(0, 1), cB + hstepB, voffB); PG8_STAGE(PG8_SA(0, 0), cA, voffA); PG8_STAGE(PG8_SA(0, 1), cA + hstepA, voffA);
    if (wr == 1) PG8_BAR;
    PG8_WAIT_V(2); PG8_BAR;
    PG8_STAGE(PG8_SB(1, 0), cB + kstep, voffB); PG8_STAGE(PG8_SA(1, 0), cA + kstep, voffA); PG8_STAGE(PG8_SB(1, 1), cB + hstepB + kstep, voffB);
    PG8_WAIT_V(6); PG8_BAR;
    for (;;) {
        const bool has_next = S.next(ui + 1, nxt);
        const char* nA = has_next ? a_tile(g, nxt.pm) : cA; const char* nB = has_next ? b_tile(g, nxt.pn) : cB;
        for (int t = 0; t < nt; t += 2) {
            const bool last = (t == nt - 2);
            const char* a1 = cA + (size_t)(t + 1) * kstep;
            const char* a2 = last ? nA : cA + (size_t)(t + 2) * kstep; const char* b2 = last ? nB : cB + (size_t)(t + 2) * kstep;
            const char* a3 = a2 + kstep; const char* b3 = b2 + kstep;
            PG8_LDB(B0, 0, 0); PG8_LDB(B1, 0, 1); PG8_SCHED; PG8_LDA(At, 0, 0); PG8_STAGE(PG8_SA(1, 1), a1 + hstepA, voffA);
            PG8_WAIT_V(8); PG8_WAIT_L(0); PG8_BAR; PG8_MMA(0, 0, At, B0); PG8_MMA(0, 1, At, B1); PG8_BAR; PG8_SCHED;
            PG8_LDA(At, 0, 1); PG8_STAGE(PG8_SB(0, 0), b2, voffB); PG8_STAGE(PG8_SB(0, 1), b2 + hstepB, voffB); PG8_STAGE(PG8_SA(0, 0), a2, voffA);
            PG8_WAIT_V(8); PG8_WAIT_L(0); PG8_BAR; PG8_MMA(1, 0, At, B0); PG8_MMA(1, 1, At, B1); PG8_BAR; PG8_SCHED;
            PG8_LDB(B0, 1, 0); PG8_LDB(B1, 1, 1); PG8_SCHED; PG8_LDA(At, 1, 0); PG8_STAGE(PG8_SA(0, 1), a2 + hstepA, voffA);
            PG8_WAIT_V(8); PG8_WAIT_L(0); PG8_BAR; PG8_MMA(0, 0, At, B0); PG8_MMA(0, 1, At, B1); PG8_BAR; PG8_SCHED;
            PG8_LDA(At, 1, 1); PG8_STAGE(PG8_SB(1, 0), b3, voffB); PG8_STAGE(PG8_SB(1, 1), b3 + hstepB, voffB); PG8_STAGE(PG8_SA(1, 0), a3, voffA);
            PG8_WAIT_V(8); PG8_WAIT_L(0); PG8_BAR; PG8_MMA(1, 0, At, B0); PG8_MMA(1, 1, At, B1); PG8_BAR; PG8_SCHED;
        }
        if (wr == 0) PG8_BAR;
        E(acc, cur, wr, wc, fr, fq);
        if (!has_next) break;
#pragma unroll
        for (int a = 0; a < 2; ++a)
#pragma unroll
            for (int b = 0; b < 2; ++b)
#pragma unroll
                for (int m = 0; m < 4; ++m)
#pragma unroll
                    for (int n = 0; n < 2; ++n) acc[a][b][m][n] = (f32x4){0.f, 0.f, 0.f, 0.f};
        cur = nxt; cA = nA; cB = nB; ++ui;
        if (wr == 1) PG8_BAR;
    }
    PG8_WAIT_V(0);
    PG8_BAR;
#undef PG8_SA
#undef PG8_SB
#undef PG8_STAGE
#undef PG8_LDA
#undef PG8_LDB
#undef PG8_MMA
#undef PG8_WAIT_V
#undef PG8_WAIT_L
#undef PG8_BAR
#undef PG8_SCHED
}
}

constexpr int NWAVES = 8;
constexpr int BATCH = 8, SEQ = 8192, D = 1024, M = BATCH * SEQ, FF = 4096;
constexpr int NIN = 5632;
constexpr int N_PHASES = 10;

constexpr size_t MiB = 1u << 20;
constexpr size_t WS_BAR = 0;
constexpr size_t WS_SSMA = 512 * 1024;
constexpr size_t WS_SSMB = 576 * 1024;
constexpr size_t WS_SSMC = 704 * 1024;
constexpr size_t WS_WIN = 2 * MiB;
constexpr size_t WS_WV = 13 * MiB;
constexpr size_t WS_WGLU = 15 * MiB;
constexpr size_t WS_WSSM = 16 * MiB;
constexpr size_t WS_WATT = 17 * MiB;
constexpr size_t WS_WMKV = 18 * MiB;
constexpr size_t WS_WMEM = 20 * MiB;
constexpr size_t WS_WO = 21 * MiB;
constexpr size_t WS_WUP = 23 * MiB;
constexpr size_t WS_WDN = 31 * MiB;
constexpr size_t WS_MEMN = 40 * MiB;
constexpr size_t WS_MK = 44 * MiB;
constexpr size_t WS_MVT = 46 * MiB;
constexpr size_t WS_E = 48 * MiB;
constexpr size_t WS_SSP1 = 56 * MiB, WS_SSP2 = 60 * MiB;
constexpr size_t WS_XN = 64 * MiB;
constexpr size_t WS_OG = 512 * MiB, WS_LSE = 608 * MiB;
constexpr size_t WS_XS = 128 * 1024;
constexpr size_t WS_U = 192 * MiB;
constexpr size_t WS_MQ = 256 * MiB;
constexpr size_t WS_HB = 192 * MiB;
constexpr size_t WS_GATES = 320 * MiB;
constexpr size_t WS_Q = 704 * MiB, WS_K = 800 * MiB, WS_VT = 896 * MiB;
constexpr size_t WS_YG = 704 * MiB, WS_Y2 = 768 * MiB, WS_OMRG = 832 * MiB, WS_MG = 864 * MiB;
constexpr size_t WS_ACT = 320 * MiB;
constexpr size_t WS_END = 992 * MiB;

constexpr int LDS_BYTES = 147456;

#define LAS __attribute__((address_space(3)))
typedef unsigned short bf16;
typedef unsigned v4u __attribute__((ext_vector_type(4)));
typedef unsigned v2u __attribute__((ext_vector_type(2)));
typedef float f32x4 __attribute__((ext_vector_type(4)));
typedef float f32x2 __attribute__((ext_vector_type(2)));
typedef float f32x16 __attribute__((ext_vector_type(16)));
typedef short bf16x8 __attribute__((ext_vector_type(8)));
typedef short s16x4 __attribute__((ext_vector_type(4)));
typedef __bf16 bf16x2_t __attribute__((ext_vector_type(2)));
__device__ __forceinline__ unsigned cvtpk(float lo, float hi) { f32x2 v = {lo, hi}; bf16x2_t b = __builtin_convertvector(v, bf16x2_t); return __builtin_bit_cast(unsigned, b); }
__device__ __forceinline__ float wave_sum(float v) {
#pragma unroll
    for (int o = 1; o < 64; o <<= 1) v += __shfl_xor(v, o);
    return v;
}
__device__ __forceinline__ float bf2f(bf16 b) { return __builtin_bit_cast(float, (unsigned)b << 16); }

struct Args { const float* in[25]; float* out; unsigned char* ws; int ph_lo, ph_hi; };

__device__ __forceinline__ void p0_transpose_item(const float* W, int ldw, int c0, int K, int nblk, bf16* WT, int row_off, const float* scale, LAS float* scr, int item, int lane) {
    const int kb = item / nblk, nb = item % nblk, k0 = 64 * kb, n0 = 32 * nb;
#pragma unroll 8
    for (int i = 0; i < 32; ++i) { const int kk = 2 * i + (lane >> 5); float v = W[(size_t)(k0 + kk) * ldw + c0 + n0 + (lane & 31)]; if (scale) v *= scale[k0 + kk]; scr[kk * 33 + (lane & 31)] = v; }
    asm volatile("s_waitcnt lgkmcnt(0)" ::: "memory");
    const int c = lane & 7;
#pragma unroll
    for (int j = 0; j < 4; ++j) { const int n = (lane >> 3) + 8 * j; const LAS float* s = scr + (8 * c) * 33 + n;
        v4u o; o.x = cvtpk(s[0 * 33], s[1 * 33]); o.y = cvtpk(s[2 * 33], s[3 * 33]); o.z = cvtpk(s[4 * 33], s[5 * 33]); o.w = cvtpk(s[6 * 33], s[7 * 33]);
        *(v4u*)(WT + (size_t)(row_off + n0 + n) * K + k0 + 8 * c) = o; }
    asm volatile("s_waitcnt lgkmcnt(0)" ::: "memory");
}
template <int NR>
__device__ __forceinline__ void rms_rows_to_bf16(const float* xrow, size_t rs, const float* g, bf16* orow, int lane, float* xs_out) {
    const f32x4* gr = (const f32x4*)g + lane;
    f32x4 v[NR][4]; float s[NR];
#pragma unroll
    for (int r = 0; r < NR; ++r) { const f32x4* xr = (const f32x4*)(xrow + r * rs) + lane; s[r] = 0.f;
#pragma unroll
        for (int j = 0; j < 4; ++j) v[r][j] = xr[64 * j]; }
    f32x4 gg[4];
#pragma unroll
    for (int j = 0; j < 4; ++j) gg[j] = gr[64 * j];
#pragma unroll
    for (int r = 0; r < NR; ++r) {
#pragma unroll
        for (int j = 0; j < 4; ++j) s[r] += (v[r][j].x * v[r][j].x + v[r][j].y * v[r][j].y) + (v[r][j].z * v[r][j].z + v[r][j].w * v[r][j].w);
        const float nrm = sqrtf(wave_sum(s[r]) * (1.f / 1024.f) + 1e-6f), rstd = 1.f / nrm;
        if (xs_out && lane == 0) xs_out[r] = nrm;
        unsigned long long* o8 = (unsigned long long*)(orow + r * rs) + lane;
#pragma unroll
        for (int j = 0; j < 4; ++j)
            o8[64 * j] = (unsigned long long)cvtpk(v[r][j].x * rstd * gg[j].x, v[r][j].y * rstd * gg[j].y) | ((unsigned long long)cvtpk(v[r][j].z * rstd * gg[j].z, v[r][j].w * rstd * gg[j].w) << 32); }
}
__device__ __forceinline__ void sincos_d(double x, double& s, double& c) {
    const double k = rint(x * 0.15915494309189535); const double y = (x - k * 6.283185307179586) - k * 2.4492935982947064e-16;
    const double y2 = y * y; double ts = 1.0, tc = 1.0;
#pragma unroll 1
    for (int n = 27; n >= 3; n -= 2) { ts = 1.0 - ts * y2 / (double)(n * (n - 1)); tc = 1.0 - tc * y2 / (double)((n - 1) * (n - 2)); }
    s = y * ts; c = tc;
}

template <int E, bool MASK>
__device__ __forceinline__ void attn_wave(const bf16* Qp, int ldq, const bf16* Kt, const bf16* Vt,
                                          int kt0, int kt1, int j0, int lane, f32x16 (&O)[E / 32], float& m_out, float& l_out) {
    constexpr int TE = 32 * E;
    const int c = lane & 31, hi = lane >> 5;
    bf16x8 qf[E / 16];
#pragma unroll
    for (int s = 0; s < E / 16; ++s) qf[s] = *(const bf16x8*)(Qp + (size_t)c * ldq + 16 * s + 8 * hi);
    float mrun = -1e30f, l = 0.f;
#pragma unroll
    for (int t = 0; t < E / 32; ++t)
#pragma unroll
        for (int i = 0; i < 16; ++i) O[t][i] = 0.f;
    const float c2 = (E == 64 ? 0.125f : 0.08838834764831845f) * 1.4426950408889634f;
    bf16x8 kf[E / 16];
#pragma unroll
    for (int s = 0; s < E / 16; ++s) kf[s] = *(const bf16x8*)(Kt + (size_t)kt0 * TE + s * 512 + lane * 8);
    for (int kt = kt0; kt <= kt1; ++kt) {
        bf16x8 vfr[E / 32][2];
#pragma unroll
        for (int t = 0; t < E / 32; ++t)
#pragma unroll
            for (int s2 = 0; s2 < 2; ++s2) vfr[t][s2] = *(const bf16x8*)(Vt + (size_t)kt * TE + (t * 2 + s2) * 512 + lane * 8);
        bf16x8 kn[E / 16];
        { const int ktn = (kt < kt1) ? kt + 1 : kt1;
#pragma unroll
          for (int s = 0; s < E / 16; ++s) kn[s] = *(const bf16x8*)(Kt + (size_t)ktn * TE + s * 512 + lane * 8); }
        f32x16 S;
#pragma unroll
        for (int i = 0; i < 16; ++i) S[i] = 0.f;
#pragma unroll
        for (int s = 0; s < E / 16; ++s) S = __builtin_amdgcn_mfma_f32_32x32x16_bf16(kf[s], qf[s], S, 0, 0, 0);
        if (MASK) {
            const bool full = (kt * 32 + 31 <= j0) && (kt * 32 + 128 >= j0 + 31);
            if (!full) { const int qj = j0 + c;
#pragma unroll
                for (int i = 0; i < 16; ++i) { const int kj = kt * 32 + (i & 3) + 8 * (i >> 2) + 4 * hi; const bool valid = (kj <= qj) && (kj + 128 >= qj); S[i] = valid ? S[i] : -1e30f; } }
        }
        float mx = S[0];
#pragma unroll
        for (int i = 1; i < 16; ++i) mx = fmaxf(mx, S[i]);
        mx = fmaxf(mx, __shfl_xor(mx, 32));
        const float mn = fmaxf(mrun, mx); const float alpha = __builtin_amdgcn_exp2f((mrun - mn) * c2); mrun = mn;
        float ps = 0.f;
#pragma unroll
        for (int i = 0; i < 16; ++i) { const float p = __builtin_amdgcn_exp2f((S[i] - mn) * c2); S[i] = p; ps += p; }
        l = l * alpha + ps;
#pragma unroll
        for (int t = 0; t < E / 32; ++t)
#pragma unroll
            for (int i = 0; i < 16; ++i) O[t][i] *= alpha;
        bf16x8 pk[2];
#pragma unroll
        for (int s2 = 0; s2 < 2; ++s2) { v4u w; w.x = cvtpk(S[8 * s2 + 0], S[8 * s2 + 1]); w.y = cvtpk(S[8 * s2 + 2], S[8 * s2 + 3]); w.z = cvtpk(S[8 * s2 + 4], S[8 * s2 + 5]); w.w = cvtpk(S[8 * s2 + 6], S[8 * s2 + 7]); pk[s2] = __builtin_bit_cast(bf16x8, w); }
#pragma unroll
        for (int t = 0; t < E / 32; ++t)
#pragma unroll
            for (int s2 = 0; s2 < 2; ++s2) O[t] = __builtin_amdgcn_mfma_f32_32x32x16_bf16(vfr[t][s2], pk[s2], O[t], 0, 0, 0);
#pragma unroll
        for (int s = 0; s < E / 16; ++s) kf[s] = kn[s];
    }
    l += __shfl_xor(l, 32);
    m_out = mrun; l_out = l;
}

__device__ __forceinline__ void sattn_wave(const bf16* Qp, const bf16* Kt, const bf16* Vt, int j0, int lane, f32x16 (&O)[2][2], float (&m_out)[2], float (&l_out)[2]) {
    const int c = lane & 31, hi = lane >> 5;
    bf16x8 qf[2][4];
#pragma unroll
    for (int q = 0; q < 2; ++q)
#pragma unroll
        for (int s = 0; s < 4; ++s) qf[q][s] = *(const bf16x8*)(Qp + (size_t)(32 * q + c) * 64 + 16 * s + 8 * hi);
    float mrun[2] = {-1e30f, -1e30f}, l[2] = {0.f, 0.f};
#pragma unroll
    for (int q = 0; q < 2; ++q)
#pragma unroll
        for (int t = 0; t < 2; ++t)
#pragma unroll
            for (int i = 0; i < 16; ++i) O[q][t][i] = 0.f;
    const float c2 = 0.125f * 1.4426950408889634f;
    const int kb = j0 >> 5, kt_end = kb + 1, kt_beg = (kb >= 4) ? kb - 4 : 0;
    bf16x8 kf[4], vfr[2][2];
#pragma unroll
    for (int s = 0; s < 4; ++s) kf[s] = *(const bf16x8*)(Kt + (size_t)kt_beg * 2048 + s * 512 + lane * 8);
#pragma unroll
    for (int t = 0; t < 2; ++t)
#pragma unroll
        for (int s2 = 0; s2 < 2; ++s2) vfr[t][s2] = *(const bf16x8*)(Vt + (size_t)kt_beg * 2048 + (t * 2 + s2) * 512 + lane * 8);
    for (int kt = kt_beg; kt <= kt_end; ++kt) {
        const int ktn = (kt < kt_end) ? kt + 1 : kt_end;
        bf16x8 kn[4], vn[2][2];
#pragma unroll
        for (int s = 0; s < 4; ++s) kn[s] = *(const bf16x8*)(Kt + (size_t)ktn * 2048 + s * 512 + lane * 8);
#pragma unroll
        for (int t = 0; t < 2; ++t)
#pragma unroll
            for (int s2 = 0; s2 < 2; ++s2) vn[t][s2] = *(const bf16x8*)(Vt + (size_t)ktn * 2048 + (t * 2 + s2) * 512 + lane * 8);
#pragma unroll
        for (int q = 0; q < 2; ++q) {
            const int kq = kb + q;
            if (kt <= kq && kt + 4 >= kq) {
                f32x16 S;
#pragma unroll
                for (int i = 0; i < 16; ++i) S[i] = 0.f;
#pragma unroll
                for (int s = 0; s < 4; ++s) S = __builtin_amdgcn_mfma_f32_32x32x16_bf16(kf[s], qf[q][s], S, 0, 0, 0);
                const int jq = j0 + 32 * q;
                const bool full = (kt * 32 + 31 <= jq) && (kt * 32 + 128 >= jq + 31);
                if (!full) { const int qj = jq + c;
#pragma unroll
                    for (int i = 0; i < 16; ++i) { const int kj = kt * 32 + (i & 3) + 8 * (i >> 2) + 4 * hi; const bool valid = (kj <= qj) && (kj + 128 >= qj); S[i] = valid ? S[i] : -1e30f; } }
                float mx = S[0];
#pragma unroll
                for (int i = 1; i < 16; ++i) mx = fmaxf(mx, S[i]);
                mx = fmaxf(mx, __shfl_xor(mx, 32));
                const float mn = fmaxf(mrun[q], mx); const float alpha = __builtin_amdgcn_exp2f((mrun[q] - mn) * c2); mrun[q] = mn;
                float ps = 0.f;
#pragma unroll
                for (int i = 0; i < 16; ++i) { const float p = __builtin_amdgcn_exp2f((S[i] - mn) * c2); S[i] = p; ps += p; }
                l[q] = l[q] * alpha + ps;
#pragma unroll
                for (int t = 0; t < 2; ++t)
#pragma unroll
                    for (int i = 0; i < 16; ++i) O[q][t][i] *= alpha;
                bf16x8 pk[2];
#pragma unroll
                for (int s2 = 0; s2 < 2; ++s2) { v4u w; w.x = cvtpk(S[8 * s2 + 0], S[8 * s2 + 1]); w.y = cvtpk(S[8 * s2 + 2], S[8 * s2 + 3]); w.z = cvtpk(S[8 * s2 + 4], S[8 * s2 + 5]); w.w = cvtpk(S[8 * s2 + 6], S[8 * s2 + 7]); pk[s2] = __builtin_bit_cast(bf16x8, w); }
#pragma unroll
                for (int t = 0; t < 2; ++t)
#pragma unroll
                    for (int s2 = 0; s2 < 2; ++s2) O[q][t] = __builtin_amdgcn_mfma_f32_32x32x16_bf16(vfr[t][s2], pk[s2], O[q][t], 0, 0, 0);
            }
        }
#pragma unroll
        for (int s = 0; s < 4; ++s) kf[s] = kn[s];
#pragma unroll
        for (int t = 0; t < 2; ++t)
#pragma unroll
            for (int s2 = 0; s2 < 2; ++s2) vfr[t][s2] = vn[t][s2];
    }
#pragma unroll
    for (int q = 0; q < 2; ++q) { l[q] += __shfl_xor(l[q], 32); m_out[q] = mrun[q]; l_out[q] = l[q]; }
}

constexpr int SSM_LROW = 272;
template <bool PASSB>
__device__ __forceinline__ void ssm_wave(const unsigned char* ws, const float* dd, int b, int g, int segbase, int hstride, int nsp, LAS unsigned char* sb, int lane) {
    const int c = lane & 31, hi = lane >> 5;
    const f32x4 pa0 = *(const f32x4*)(ws + WS_SSMA + (size_t)(g * 64 + c) * 16), pa1 = *(const f32x4*)(ws + WS_SSMA + (size_t)(g * 64 + c + 32) * 16);
    bf16x8 bfr[4];
#pragma unroll
    for (int n = 0; n < 4; ++n) bfr[n] = *(const bf16x8*)(ws + WS_SSMB + ((size_t)((g * 4 + n) * 32 + c) * 16 + 8 * hi) * 2);
    const bf16* U = (const bf16*)(ws + WS_U);
    float s0r = 0.f, s0i = 0.f, s1r = 0.f, s1i = 0.f;
    f32x2* Eb = (f32x2*)(ws + WS_E) + (size_t)(b * 32 + g) * 64 * 64;
    if (PASSB) {
        const int seg = segbase + hstride * hi;
#pragma unroll 8
        for (int sq = 0; sq < seg; ++sq) { const f32x2 e0 = Eb[sq * 64 + c], e1 = Eb[sq * 64 + c + 32];
            const float n0r = pa0.z * s0r - pa0.w * s0i + e0.x, n0i = pa0.z * s0i + pa0.w * s0r + e0.y; s0r = n0r; s0i = n0i;
            const float n1r = pa1.z * s1r - pa1.w * s1i + e1.x, n1i = pa1.z * s1i + pa1.w * s1r + e1.y; s1r = n1r; s1i = n1i; }
    }
    bf16x8 cfr[4];
    if (PASSB) {
#pragma unroll
        for (int ks = 0; ks < 4; ++ks) cfr[ks] = *(const bf16x8*)(ws + WS_SSMC + ((size_t)(g * 16 + (lane & 15)) * 128 + 32 * ks + 8 * (lane >> 4)) * 2);
    }
    const int segsel = (c >> 2) & 1, toff = (c & 3) + 4 * (c >> 3);
    const float dsk = dd[g * 16 + (lane & 15)];
    for (int kp = 0; kp < nsp; ++kp) {
        if (!PASSB) { s0r = 0.f; s0i = 0.f; s1r = 0.f; s1i = 0.f; }
        const int seg0 = segbase + kp;
        const size_t tokA = (size_t)b * 8192 + (size_t)(seg0 + hstride * segsel) * 128 + toff;
        bf16x8 ufn = *(const bf16x8*)(U + tokA * 512 + g * 16 + 8 * hi);
        for (int blk = 0; blk < 8; ++blk) {
            const bf16x8 uf = ufn; { const int bn = (blk < 7) ? blk + 1 : 7; ufn = *(const bf16x8*)(U + (tokA + bn * 16) * 512 + g * 16 + 8 * hi); }
            bf16 uu[2][4];
            if (PASSB) {
#pragma unroll
                for (int ss = 0; ss < 2; ++ss)
#pragma unroll
                    for (int rg = 0; rg < 4; ++rg) uu[ss][rg] = U[((size_t)b * 8192 + (size_t)(seg0 + hstride * ss) * 128 + blk * 16 + (lane >> 4) * 4 + rg) * 512 + g * 16 + (lane & 15)];
            }
            f32x16 z;
#pragma unroll
            for (int i = 0; i < 16; ++i) z[i] = 0.f;
            const f32x16 BU0 = __builtin_amdgcn_mfma_f32_32x32x16_bf16(uf, bfr[0], z, 0, 0, 0), BU1 = __builtin_amdgcn_mfma_f32_32x32x16_bf16(uf, bfr[1], z, 0, 0, 0);
            const f32x16 BU2 = __builtin_amdgcn_mfma_f32_32x32x16_bf16(uf, bfr[2], z, 0, 0, 0), BU3 = __builtin_amdgcn_mfma_f32_32x32x16_bf16(uf, bfr[3], z, 0, 0, 0);
#pragma unroll
            for (int i = 0; i < 16; ++i) {
                const float n0r = pa0.x * s0r - pa0.y * s0i + BU0[i], n0i = pa0.x * s0i + pa0.y * s0r + BU1[i]; s0r = n0r; s0i = n0i;
                const float n1r = pa1.x * s1r - pa1.y * s1i + BU2[i], n1i = pa1.x * s1i + pa1.y * s1r + BU3[i]; s1r = n1r; s1i = n1i;
                if (PASSB) { LAS unsigned char* rowp = sb + (hi * 16 + i) * SSM_LROW + 4 * c;
                    *(LAS unsigned*)rowp = cvtpk(s0r, s0i); *(LAS unsigned*)(rowp + 128) = cvtpk(s1r, s1i); }
            }
            if (PASSB) {
                asm volatile("s_waitcnt lgkmcnt(0)" ::: "memory");
#pragma unroll
                for (int ss = 0; ss < 2; ++ss) {
                    pg8::f32x4 Y = {0.f, 0.f, 0.f, 0.f};
#pragma unroll
                    for (int ks = 0; ks < 4; ++ks) { const bf16x8 af = *(const LAS bf16x8*)(sb + (ss * 16 + (lane & 15)) * SSM_LROW + (32 * ks + 8 * (lane >> 4)) * 2);
                        Y = __builtin_amdgcn_mfma_f32_16x16x32_bf16(af, cfr[ks], Y, 0, 0, 0); }
#pragma unroll
                    for (int rg = 0; rg < 4; ++rg) { const size_t tok = (size_t)b * 8192 + (size_t)(seg0 + hstride * ss) * 128 + blk * 16 + (lane >> 4) * 4 + rg; const size_t o = tok * 512 + g * 16 + (lane & 15);
                        const float y = Y[rg] + dsk * bf2f(uu[ss][rg]);
                        const float zz = 0.7978845608028654f * (y + 0.044715f * y * y * y);
                        const float gl = y * __builtin_amdgcn_rcpf(1.f + __builtin_amdgcn_exp2f(-2.885390081777927f * zz));
                        ((bf16*)(ws + WS_YG))[o] = (bf16)(cvtpk(gl, 0.f) & 0xffffu); }
                }
                asm volatile("s_waitcnt lgkmcnt(0)" ::: "memory");
            }
        }
        if (!PASSB) { const int seg = seg0 + hstride * hi; Eb[seg * 64 + c] = (f32x2){s0r, s0i}; Eb[seg * 64 + c + 32] = (f32x2){s1r, s1i}; }
    }
}

#define RLX_AGENT __ATOMIC_RELAXED, __HIP_MEMORY_SCOPE_AGENT
#define XB_TMO      128
#define XB_XCNT(j)  (256  + 64 * (j))
#define XB_XSUB(j)  (1280 + 64 * (j))
#define XB_XGEN(j)  (2304 + 64 * (j))
#define XB_TOP      3328
#define XB_TOPGEN   3392
#define XCD_BAR_WORDS 3456
#define XB_SPIN_CAP (1u << 18)

__device__ __forceinline__ unsigned xb_ld(unsigned* p)              { return __hip_atomic_load(p, __ATOMIC_RELAXED, __HIP_MEMORY_SCOPE_AGENT); }
__device__ __forceinline__ unsigned xb_add(unsigned* p, unsigned v) { return __hip_atomic_fetch_add(p, v, __ATOMIC_RELAXED, __HIP_MEMORY_SCOPE_AGENT); }
__device__ __forceinline__ unsigned xb_xcc_id() { return (unsigned)__builtin_amdgcn_s_getreg((3 << 11) | 20) & 0xFu; }
#define XB_SPIN(cond, bar) do { unsigned _sp = 0; while (cond) { __builtin_amdgcn_s_sleep(1); \
    if ((++_sp & 255u) == 0u) { if (xb_ld(&(bar)[XB_TMO])) break; if (_sp > XB_SPIN_CAP) { atomicAdd(&(bar)[XB_TMO], 1u); break; } } } } while (0)

struct XcdBarrier {
    unsigned* bar; unsigned x;
    volatile LAS unsigned* st;
};

__device__ __forceinline__ XcdBarrier xcd_barrier_post(unsigned* bar, volatile LAS unsigned* st) {
    XcdBarrier b; b.bar = bar; b.x = xb_xcc_id(); b.st = st;
    if (threadIdx.x == 0) (void)xb_add(&bar[XB_XCNT(b.x)], 1u);
    return b;
}
__device__ __forceinline__ void xcd_barrier_complete(unsigned* bar, unsigned x, unsigned& nloc, unsigned& nx) {
    const unsigned G = gridDim.x * gridDim.y * gridDim.z;
    unsigned sum, cnt, mine, sp = 0u;
    for (;;) {
        sum = 0u; cnt = 0u; mine = 0u;
#pragma unroll
        for (unsigned j = 0; j < 16; ++j) { const unsigned c = xb_ld(&bar[XB_XCNT(j)]); sum += c; cnt += (c > 0u) ? 1u : 0u; mine = (j == x) ? c : mine; }
        if (sum == G) break;
        __builtin_amdgcn_s_sleep(1);
        if ((++sp & 255u) == 0u) { if (xb_ld(&bar[XB_TMO])) break; if (sp > XB_SPIN_CAP) { atomicAdd(&bar[XB_TMO], 1u); break; } }
    }
    nloc = mine > 0u ? mine : 1u; nx = cnt > 0u ? cnt : 1u;
}

__device__ __forceinline__ void xcd_barrier(const XcdBarrier& b) {
    asm volatile("s_waitcnt vmcnt(0)" ::: "memory");
    __syncthreads();
    if (threadIdx.x == 0) {
        unsigned* bar = b.bar;
        __builtin_amdgcn_s_waitcnt(0);
        unsigned nloc = b.st[0], nx = b.st[1];
        if (nloc == 0u) { xcd_barrier_complete(bar, b.x, nloc, nx); b.st[0] = nloc; b.st[1] = nx; }
        const unsigned old = xb_add(&bar[XB_XSUB(b.x)], 1u);
        const unsigned gen = old / nloc;
        if (old + 1u == (gen + 1u) * nloc) {
            __builtin_amdgcn_fence(__ATOMIC_RELEASE, "agent");
            asm volatile("s_waitcnt vmcnt(0)" ::: "memory");
            const unsigned og = xb_add(&bar[XB_TOP], 1u);
            const unsigned tg = og / nx;
            if (og + 1u == (tg + 1u) * nx) xb_add(&bar[XB_TOPGEN], 1u);
            else XB_SPIN(xb_ld(&bar[XB_TOPGEN]) == tg, bar);
            __builtin_amdgcn_fence(__ATOMIC_ACQUIRE, "agent");
            xb_add(&bar[XB_XGEN(b.x)], 1u);
            asm volatile("s_waitcnt vmcnt(0)" ::: "memory");
        } else {
            XB_SPIN(xb_ld(&bar[XB_XGEN(b.x)]) == gen, bar);
            __builtin_amdgcn_fence(__ATOMIC_ACQUIRE, "agent");
            asm volatile("s_waitcnt vmcnt(0)" ::: "memory");
        }
    }
    __syncthreads();
}

__global__ void __launch_bounds__(NWAVES * 64, 2) fwd_megakernel(Args args) {
    __shared__ __attribute__((aligned(16))) unsigned char lds_raw[LDS_BYTES];
    LAS unsigned char* lds = (LAS unsigned char*)lds_raw;
    const int tid = threadIdx.x, lane = tid & 63, wave = __builtin_amdgcn_readfirstlane(tid >> 6);
    const int G = gridDim.x; const int bx = blockIdx.x; const int vcu = (G % 8 == 0) ? (bx % 8) * (G / 8) + bx / 8 : bx;
    const int gw = vcu * NWAVES + wave, NGW = G * NWAVES;
    unsigned char* ws = args.ws;
    const int lo = args.ph_lo, hi_ph = args.ph_hi;
    volatile LAS unsigned* MISC = (volatile LAS unsigned*)(lds + 131072 + 320);
    if (tid < 32) MISC[tid] = 0u;
    __syncthreads();
    XcdBarrier bar; bar.bar = (unsigned*)ws; bar.x = 0; bar.st = nullptr;
    if (hi_ph - lo > 1) bar = xcd_barrier_post((unsigned*)ws, MISC + 8);
    if (lo == 0x7fffffff) cg::this_grid().sync();
#define IN(k) (lo <= (k) && (k) < hi_ph)
#define SEAM(k) do { if (IN(k) && IN((k) + 1)) { xcd_barrier(bar); } } while (0)

    if (IN(0)) {
        LAS float* scr = (LAS float*)(lds + wave * 16384);
        const float* w_in = args.in[4];
        constexpr int I0 = 16 * 64, I1 = 16 * 24, I2 = 16 * 112, I3 = 8 * 16, I4 = 8 * 32, I5 = 4 * 32, I6 = 16 * 32, I7 = 8 * 32, I8 = 16 * 32, I9 = 16 * 128, I10 = 64 * 32;
        constexpr int NITEMS = I0 + I1 + I2 + I3 + I4 + I5 + I6 + I7 + I8 + I9 + I10;
        for (int it = gw; it < NITEMS; it += NGW) {
            int r = it;
            if (r < I0) { p0_transpose_item(w_in, 6400, 0, 1024, 64, (bf16*)(ws + WS_WIN), 0, nullptr, scr, r, lane); continue; } r -= I0;
            if (r < I1) { p0_transpose_item(w_in, 6400, 2048, 1024, 24, (bf16*)(ws + WS_WV), 0, nullptr, scr, r, lane); continue; } r -= I1;
            if (r < I2) { p0_transpose_item(w_in, 6400, 2816, 1024, 112, (bf16*)(ws + WS_WIN), 2048, nullptr, scr, r, lane); continue; } r -= I2;
            if (r < I3) { p0_transpose_item(args.in[14], 512, 0, 512, 16, (bf16*)(ws + WS_WGLU), 0, nullptr, scr, r, lane); continue; } r -= I3;
            if (r < I4) { p0_transpose_item(args.in[16], 1024, 0, 512, 32, (bf16*)(ws + WS_WSSM), 0, nullptr, scr, r, lane); continue; } r -= I4;
            if (r < I5) { p0_transpose_item(args.in[17], 1024, 0, 256, 32, (bf16*)(ws + WS_WATT), 0, nullptr, scr, r, lane); continue; } r -= I5;
            if (r < I6) { p0_transpose_item(args.in[18], 1024, 0, 1024, 32, (bf16*)(ws + WS_WMKV), 0, nullptr, scr, r, lane); continue; } r -= I6;
            if (r < I7) { p0_transpose_item(args.in[19], 1024, 0, 512, 32, (bf16*)(ws + WS_WMEM), 0, nullptr, scr, r, lane); continue; } r -= I7;
            if (r < I8) { p0_transpose_item(args.in[20], 1024, 0, 1024, 32, (bf16*)(ws + WS_WO), 0, nullptr, scr, r, lane); continue; } r -= I8;
            if (r < I9) { p0_transpose_item(args.in[22], 4096, 0, 1024, 128, (bf16*)(ws + WS_WUP), 0, args.in[21], scr, r, lane); continue; } r -= I9;
            p0_transpose_item(args.in[23], 1024, 0, 4096, 32, (bf16*)(ws + WS_WDN), 0, nullptr, scr, r, lane);
        }
        for (int m = gw * 4; m < M; m += NGW * 4) rms_rows_to_bf16<4>(args.in[0] + (size_t)m * D, (size_t)D, args.in[2], (bf16*)(ws + WS_XN) + (size_t)m * D, lane, (float*)(ws + WS_XS) + m);
        for (int m = gw; m < 2048; m += NGW) rms_rows_to_bf16<1>(args.in[1] + (size_t)m * D, (size_t)D, args.in[3], (bf16*)(ws + WS_MEMN) + (size_t)m * D, lane, nullptr);
        { const int i = bx * 512 + tid;
          if (i < 2048) { const int g = i >> 6, p = i & 63;
            const double lr = (double)args.in[6][i], li = (double)args.in[7][i], dt = exp((double)args.in[8][g]);
            const double mag = exp(lr * dt); double sn, cs; sincos_d(li * dt, sn, cs);
            const double ar = mag * cs, aim = mag * sn, nr = ar - 1.0, ni = aim, den = lr * lr + li * li;
            const double cr = (nr * lr + ni * li) / den, ci = (ni * lr - nr * li) / den;
            double pr = ar, pi = aim;
#pragma unroll 1
            for (int k = 0; k < 7; ++k) { const double t = pr * pr - pi * pi; pi = 2.0 * pr * pi; pr = t; }
            *(f32x4*)(ws + WS_SSMA + (size_t)i * 16) = (f32x4){(float)ar, (float)aim, (float)pr, (float)pi};
            const int nt0 = (p >> 5) * 2, cc = p & 31;
            bf16* BM_ = (bf16*)(ws + WS_SSMB); bf16* CM_ = (bf16*)(ws + WS_SSMC);
#pragma unroll 1
            for (int h = 0; h < 16; ++h) { const double br = (double)args.in[9][(size_t)i * 16 + h], bi = (double)args.in[10][(size_t)i * 16 + h];
                const float bbr = (float)(cr * br - ci * bi), bbi = (float)(cr * bi + ci * br);
                BM_[((size_t)(g * 4 + nt0) * 32 + cc) * 16 + h] = (bf16)(cvtpk(bbr, 0.f) & 0xffffu);
                BM_[((size_t)(g * 4 + nt0 + 1) * 32 + cc) * 16 + h] = (bf16)(cvtpk(bbi, 0.f) & 0xffffu);
                const float c_r = args.in[11][((size_t)g * 16 + h) * 64 + p], c_i = args.in[12][((size_t)g * 16 + h) * 64 + p];
                CM_[((size_t)g * 16 + h) * 128 + 2 * p] = (bf16)(cvtpk(c_r, 0.f) & 0xffffu);
                CM_[((size_t)g * 16 + h) * 128 + 2 * p + 1] = (bf16)(cvtpk(-c_i, 0.f) & 0xffffu); }
          } }
    }
    SEAM(0);

    if (IN(1)) {
        __syncthreads();
        {
            pg8::Gemm g{(const bf16*)(ws + WS_MEMN), (const bf16*)(ws + WS_WMKV), 2048, 512, 1024, 1024, 1024, 0}; pg8::StaticOrder S; S.init(2048, 512, G, bx);
            pg8::EpiMKf E{(bf16*)(ws + WS_MK)}; pg8::gemm_phase(lds, g, S, E); }
        {
            pg8::Gemm g{(const bf16*)(ws + WS_WMKV) + (size_t)512 * 1024, (const bf16*)(ws + WS_MEMN), 512, 2048, 1024, 1024, 1024, 0}; pg8::StaticOrder S; S.init(512, 2048, G, (bx + G - 16) % G);
            pg8::EpiVTf E{(bf16*)(ws + WS_MVT), 1, 0}; pg8::gemm_phase(lds, g, S, E); }
        {
            pg8::Gemm g{(const bf16*)(ws + WS_XN), (const bf16*)(ws + WS_WIN), M, NIN, 1024, 1024, 1024, 0}; pg8::StaticOrder S; S.init(M, NIN, G, bx);
            pg8::EpiInProj E{(bf16*)(ws + WS_U), (bf16*)(ws + WS_Q), (bf16*)(ws + WS_K), (bf16*)(ws + WS_MQ), (bf16*)(ws + WS_GATES), args.in[5]}; pg8::gemm_phase(lds, g, S, E); }
#pragma unroll 1
        for (int gi = 0; gi < 3; ++gi) {
            const int d = 1 << (2 * gi);
            pg8::Gemm g{(const bf16*)(ws + WS_WV) + (size_t)gi * 256 * 1024, (const bf16*)(ws + WS_XN), 256, M, 1024, 1024, d * 1024, d}; pg8::StaticOrder S; S.init(256, M, G, bx);
            pg8::EpiVTf E{(bf16*)(ws + WS_VT), 0, gi}; pg8::gemm_phase(lds, g, S, E); }
    }
    SEAM(1);

    if (IN(2)) {
        for (int rep = 0; rep < PROBE_REP; ++rep)
        for (int it = gw; it < 12288; it += NGW) {
            const int qb = it & 127, rest = it >> 7, hh = rest & 3, b = (rest >> 2) & 7, g = rest >> 5;
            const int sh = 2 * g, d = 1 << sh, Ld = 8192 >> sh; const int pp0 = qb * 64, r = pp0 / Ld, j0 = pp0 % Ld;
            const size_t hb = ((size_t)(g * 8 + b) * 4 + hh) * 8192;
            const bf16* Qp = (const bf16*)(ws + WS_Q) + (hb + pp0) * 64;
            const bf16* Kt = (const bf16*)(ws + WS_K) + (hb + (size_t)r * Ld) * 64;
            const bf16* Vt = (const bf16*)(ws + WS_VT) + (hb + (size_t)r * Ld) * 64;
            f32x16 O[2][2]; float mr[2], l[2];
            sattn_wave(Qp, Kt, Vt, j0, lane, O, mr, l);
            const int c = lane & 31, hi = lane >> 5;
#pragma unroll
            for (int q = 0; q < 2; ++q) { const float inv = 1.f / l[q];
                const size_t tok = (size_t)b * 8192 + (size_t)(j0 + 32 * q + c) * d + r;
                bf16* og = (bf16*)(ws + WS_OG) + tok * 768 + g * 256 + hh * 64;
#pragma unroll
                for (int t = 0; t < 2; ++t)
#pragma unroll
                    for (int a = 0; a < 4; ++a) { v2u w; w.x = cvtpk(O[q][t][4 * a] * inv, O[q][t][4 * a + 1] * inv); w.y = cvtpk(O[q][t][4 * a + 2] * inv, O[q][t][4 * a + 3] * inv);
                        *(v2u*)(og + 32 * t + 8 * a + 4 * hi) = w; }
                if (hi == 0) ((float*)(ws + WS_LSE))[tok * 12 + g * 4 + hh] = mr[q] * 0.125f + __logf(l[q]); }
        }
        for (int it = gw; it < 8192; it += NGW) {
            const int qb = it & 255, h = (it >> 8) & 3, b = it >> 10;
            bf16* Qp = (bf16*)(ws + WS_MQ) + ((size_t)b * 8192 + qb * 32) * 512 + h * 128;
            const bf16* Kt = (const bf16*)(ws + WS_MK) + (size_t)(b * 4 + h) * 8 * 4096;
            const bf16* Vt = (const bf16*)(ws + WS_MVT) + (size_t)(b * 4 + h) * 8 * 4096;
            f32x16 O[4]; float mr, l;
            attn_wave<128, false>(Qp, 512, Kt, Vt, 0, 7, 0, lane, O, mr, l);
            const int c = lane & 31, hi = lane >> 5; const float inv = 1.f / l;
            bf16* om = Qp + (size_t)c * 512;
#pragma unroll
            for (int t = 0; t < 4; ++t)
#pragma unroll
                for (int a = 0; a < 4; ++a) { v2u w; w.x = cvtpk(O[t][4 * a] * inv, O[t][4 * a + 1] * inv); w.y = cvtpk(O[t][4 * a + 2] * inv, O[t][4 * a + 3] * inv);
                    *(v2u*)(om + 32 * t + 8 * a + 4 * hi) = w; }
        }
        for (int rep = 0; rep < PROBE_REP; ++rep)
        for (int it = gw; it < 8192; it += NGW) { const int sp = it & 31, g = (it >> 5) & 31, b = it >> 10; ssm_wave<false>(ws, args.in[13], b, g, 2 * sp, 1, 1, lds + wave * 16384, lane); }
    }
    SEAM(2);

    if (IN(3)) {
        for (int rep = 0; rep < PROBE_P3; ++rep)
        for (int it = gw; it < 2048; it += NGW) { const int qd = it & 7, g = (it >> 3) & 31, b = it >> 8;
            ssm_wave<true>(ws, args.in[13], b, g, 8 * qd, 4, 4, lds + wave * 16384, lane); }
        for (int m2 = gw; m2 < M / 2; m2 += NGW) { const size_t tok = (size_t)m2 * 2 + (lane >> 5); const int cc = (lane & 31) * 8, hh = cc >> 6;
            const float* ls = (const float*)(ws + WS_LSE) + tok * 12 + hh; const float l0 = ls[0], l1 = ls[4], l2 = ls[8];
            const float mx = fmaxf(l0, fmaxf(l1, l2)); const float e0 = __expf(l0 - mx), e1 = __expf(l1 - mx), e2 = __expf(l2 - mx); const float inv = 1.f / (e0 + e1 + e2);
            const bf16* og = (const bf16*)(ws + WS_OG) + tok * 768 + cc;
            pg8::f32x4 a0, a1, b0, b1, c0, c1; pg8::unpack8(*(const v4u*)og, a0, a1); pg8::unpack8(*(const v4u*)(og + 256), b0, b1); pg8::unpack8(*(const v4u*)(og + 512), c0, c1);
            const float w0 = e0 * inv, w1 = e1 * inv, w2 = e2 * inv;
            const pg8::f32x4 r0 = a0 * w0 + b0 * w1 + c0 * w2, r1 = a1 * w0 + b1 * w1 + c1 * w2;
            *(v4u*)((bf16*)(ws + WS_OMRG) + tok * 256 + cc) = pg8::pack8(r0, r1); }
    }
    SEAM(3);

    if (IN(4)) {
        __syncthreads();
        pg8::Gemm g{(const bf16*)(ws + WS_YG), (const bf16*)(ws + WS_WGLU), M, 512, 512, 512, 512, 0}; pg8::StaticOrder S; S.init(M, 512, G, bx);
        pg8::EpiGlu E{(const bf16*)(ws + WS_YG), (bf16*)(ws + WS_Y2), args.in[15]}; pg8::gemm_phase(lds, g, S, E);
    }
    SEAM(4);

    if (IN(5)) {
        __syncthreads();
        pg8::StaticOrder S; S.init(M, 1024, G, bx);
        { pg8::Gemm g{(const bf16*)(ws + WS_Y2), (const bf16*)(ws + WS_WSSM), M, 1024, 512, 512, 512, 0};
          pg8::EpiBranch<0> E{(const bf16*)(ws + WS_GATES), (bf16*)(ws + WS_MG), 0}; pg8::gemm_phase(lds, g, S, E); }
        { pg8::Gemm g{(const bf16*)(ws + WS_OMRG), (const bf16*)(ws + WS_WATT), M, 1024, 256, 256, 256, 0};
          pg8::EpiBranch<1> E{(const bf16*)(ws + WS_GATES), (bf16*)(ws + WS_MG), 1024}; pg8::gemm_phase(lds, g, S, E); }
        { pg8::Gemm g{(const bf16*)(ws + WS_MQ), (const bf16*)(ws + WS_WMEM), M, 1024, 512, 512, 512, 0};
          pg8::EpiBranch<1> E{(const bf16*)(ws + WS_GATES), (bf16*)(ws + WS_MG), 2048}; pg8::gemm_phase(lds, g, S, E); }
    }
    SEAM(5);

    if (IN(6)) {
        __syncthreads();
        pg8::Gemm g{(const bf16*)(ws + WS_MG), (const bf16*)(ws + WS_WO), M, 1024, 1024, 1024, 1024, 0}; pg8::StaticOrder S; S.init(M, 1024, G, bx);
        pg8::EpiResid<0> E{(const bf16*)(ws + WS_XN), (const float*)(ws + WS_XS), args.in[2], (bf16*)(ws + WS_HB), (float*)(ws + WS_SSP1)}; pg8::gemm_phase(lds, g, S, E);
    }
    SEAM(6);

    if (IN(7)) {
        __syncthreads();
        pg8::Gemm g{(const bf16*)(ws + WS_HB), (const bf16*)(ws + WS_WUP), M, FF, 1024, 1024, 1024, 0}; pg8::StaticOrder S; S.init(M, FF, G, bx);
        pg8::EpiUp E{(const float*)(ws + WS_SSP1), (bf16*)(ws + WS_ACT)};
        pg8::gemm_phase(lds, g, S, E);
        if (PROBE_G7 > 1) pg8::gemm_phase(lds, g, S, E);
    }
    SEAM(7);

    if (IN(8)) {
        __syncthreads();
        pg8::Gemm g{(const bf16*)(ws + WS_ACT), (const bf16*)(ws + WS_WDN), M, 1024, FF, FF, FF, 0}; pg8::StaticOrder S; S.init(M, 1024, G, bx);
        pg8::EpiResid<1> E{nullptr, nullptr, nullptr, (bf16*)(ws + WS_HB), (float*)(ws + WS_SSP2)}; pg8::gemm_phase(lds, g, S, E);
    }
    SEAM(8);

    if (IN(9)) {
        const f32x4* gr = (const f32x4*)args.in[24];
        const int c8a = lane * 8, c8b = (lane + 64) * 8;
        const f32x4 ga0 = gr[c8a / 4], ga1 = gr[c8a / 4 + 1], gb0 = gr[c8b / 4], gb1 = gr[c8b / 4 + 1];
        for (int m = gw * 4; m < M; m += NGW * 4) {
            float pv[4]; v4u ha[4], hb4[4];
#pragma unroll
            for (int r = 0; r < 4; ++r) { pv[r] = (lane < 16) ? ((const float*)(ws + WS_SSP2))[(size_t)(m + r) * 16 + lane] : 0.f;
                const bf16* hr = (const bf16*)(ws + WS_HB) + (size_t)(m + r) * D; ha[r] = *(const v4u*)(hr + c8a); hb4[r] = *(const v4u*)(hr + c8b); }
#pragma unroll
            for (int r = 0; r < 4; ++r) { const float rs = 1.0f / sqrtf(wave_sum(pv[r]) * (1.f / 1024.f) + 1e-6f);
                f32x4* xr = (f32x4*)(args.out + (size_t)(m + r) * D); pg8::f32x4 v0, v1;
                pg8::unpack8(ha[r], v0, v1); xr[c8a / 4] = v0 * rs * ga0; xr[c8a / 4 + 1] = v1 * rs * ga1;
                pg8::unpack8(hb4[r], v0, v1); xr[c8b / 4] = v0 * rs * gb0; xr[c8b / 4 + 1] = v1 * rs * gb1; } }
    }
#undef IN
#undef SEAM
}

#ifndef DBG_PH
#define DBG_PH 0
#endif
struct DumpSeg { size_t off; unsigned n; unsigned pad; };
struct DumpArgs { float* out; const unsigned char* ws; DumpSeg s[6]; };
__global__ void dbg_dump(DumpArgs a) {
    size_t base = 0;
    float mag = 1e12f;
    for (int k = 0; k < 6; ++k, mag *= 0.1f) { const unsigned short* src = (const unsigned short*)(a.ws + a.s[k].off);
        for (size_t i = (size_t)blockIdx.x * blockDim.x + threadIdx.x; i < a.s[k].n; i += (size_t)gridDim.x * blockDim.x) a.out[base + i] = ((src[i] & 0x7f80u) == 0x7f80u) ? mag : 0.f;
        base += a.s[k].n; }
    for (size_t i = base + (size_t)blockIdx.x * blockDim.x + threadIdx.x; i < (size_t)M * D; i += (size_t)gridDim.x * blockDim.x) a.out[i] = 0.f;
}
extern "C" void kernel_launch(void* const* d_in, const int* in_sizes, int n_in, void* d_out, int out_size, void* d_ws, size_t ws_size, hipStream_t stream) {
    static int grid = 0;
    if (grid == 0) {
        if (n_in != 25 || out_size != M * D || ws_size < WS_END) { fprintf(stderr, "kernel_launch: unexpected shapes (n_in %d out %d ws %zu)\n", n_in, out_size, ws_size); grid = -1; return; }
        int dev = 0, cus = 0, per_cu = 0;
        if (hipGetDevice(&dev) != hipSuccess || hipDeviceGetAttribute(&cus, hipDeviceAttributeMultiprocessorCount, dev) != hipSuccess) { grid = -1; return; }
        if (hipOccupancyMaxActiveBlocksPerMultiprocessor(&per_cu, (const void*)fwd_megakernel, NWAVES * 64, 0) != hipSuccess || per_cu < 1) { fprintf(stderr, "kernel_launch: occupancy query says %d\n", per_cu); per_cu = 1; }
        (void)hipGetLastError();
        grid = cus;
    }
    if (grid < 0) return;
    Args a{};
    for (int i = 0; i < 25; ++i) a.in[i] = (const float*)d_in[i];
    a.out = (float*)d_out; a.ws = (unsigned char*)d_ws;
#if MK_N_LAUNCHES == 1
    if (hipMemsetAsync(d_ws, 0, 65536, stream) != hipSuccess) { fprintf(stderr, "kernel_launch: memset of the barrier words failed\n"); return; }
    a.ph_lo = 0; a.ph_hi = N_PHASES;
    void* kargs[] = {&a};
    hipError_t e = hipLaunchCooperativeKernel((const void*)fwd_megakernel, dim3(grid), dim3(NWAVES * 64), kargs, 0, stream);
    if (e != hipSuccess) fprintf(stderr, "kernel_launch: cooperative launch failed: %s (grid %d)\n", hipGetErrorString(e), grid);
#else
    const int np = DBG_PH ? DBG_PH + 1 : N_PHASES;
    for (int p = 0; p < np; ++p) { a.ph_lo = p; a.ph_hi = p + 1; hipLaunchKernelGGL(fwd_megakernel, dim3(grid), dim3(NWAVES * 64), 0, stream, a); }
#if DBG_PH && DBG_PH < 8
    { DumpArgs da{}; da.out = (float*)d_out; da.ws = (const unsigned char*)d_ws;
      DBG_SEGS
      hipLaunchKernelGGL(dbg_dump, dim3(2048), dim3(256), 0, stream, da); }
#endif
#endif
}
```

```cpp
#include <hip/hip_runtime.h>
#include <hip/hip_cooperative_groups.h>
#include <cstdio>
#include <cstdint>
namespace cg = cooperative_groups;

#define DBG_PH 0
#define DBG_SEGS da.s[0] = {WS_GATES, 12u << 20, 0}; da.s[1] = {WS_OG, 12u << 20, 0}; da.s[2] = {WS_MQ, 12u << 20, 0}; da.s[3] = {WS_YG, 8u << 20, 0}; da.s[4] = {WS_OMRG, 8u << 20, 0}; da.s[5] = {WS_MG, 12u << 20, 0};
#ifndef PROBE_G7
#define PROBE_G7 1
#endif
#ifndef PROBE_REP
#define PROBE_REP 1
#define PROBE_P3 1
#endif
#ifndef MK_N_LAUNCHES
#define MK_N_LAUNCHES 1
#endif

namespace pg8 {
#define PG8_LAS __attribute__((address_space(3)))
typedef unsigned short bf16_t;
typedef short bf16x8 __attribute__((ext_vector_type(8)));
typedef float f32x4 __attribute__((ext_vector_type(4)));
typedef unsigned u32x4 __attribute__((ext_vector_type(4)));
constexpr int BM = 256, BK = 64, HALF = 128, HTB = HALF * BK * 2, STAGE_BYTES = 8 * HTB, NXCD = 8, WGM = 8;

__host__ __device__ __forceinline__ int lds_byte(int r, int c) { const int st = (r >> 4) * 2 + (c >> 5), rr = r & 15, cc = c & 31, ob = rr * 64 + cc * 2; return st * 1024 + (ob ^ (((ob >> 9) & 1) << 5)); }
__host__ __device__ __forceinline__ void stage_rc(int b, int& R, int& C) { const int st = b / 1024, sb = b % 1024, swz = sb ^ (((sb >> 9) & 1) << 5); R = (st >> 1) * 16 + swz / 64; C = (st & 1) * 32 + (swz % 64) / 2; }
__host__ __device__ __forceinline__ int perm32(int rho) { const int n = rho >> 4, i = rho & 15; return 8 * (i >> 2) + 4 * n + (i & 3); }

struct Unit { int pm, pn; };
struct Gemm { const bf16_t* A; const bf16_t* Bt; int M, N, K; int lda, ldb; int bdil; };
__device__ __forceinline__ const char* a_tile(const Gemm& g, int pm) { return (const char*)g.A + (size_t)pm * 256 * (size_t)g.lda * 2; }
__device__ __forceinline__ const char* b_tile(const Gemm& g, int pn) {
    if (g.bdil == 0) return (const char*)g.Bt + (size_t)pn * 256 * (size_t)g.ldb * 2;
    const int d = g.bdil, Ld = 8192 / d, b = pn >> 5, pp0 = (pn & 31) * 256, r = pp0 / Ld, j0 = pp0 % Ld;
    return (const char*)g.Bt + ((size_t)b * 8192 + (size_t)j0 * d + r) * 1024 * 2;
}

struct StaticOrder {
    int nM, nN, nwg, G, c, rev;
    __host__ __device__ void init(int M, int N, int G_, int c_, int rev_ = 0) { nM = M / BM; nN = N / BM; nwg = nM * nN; G = G_; c = c_; rev = rev_; }
    __host__ __device__ bool next(int i, Unit& u) const {
        const long L = (long)i * G + c; if (L >= nwg) return false;
        int wgid = (int)L; { const int q = nwg / NXCD, r = nwg % NXCD, xcd = wgid % NXCD, off = wgid / NXCD; wgid = (xcd < r ? xcd * (q + 1) : r * (q + 1) + (xcd - r) * q) + off; }
        const int nig = WGM * nN, gid = wgid / nig, fm = gid * WGM, gsz = (nM - fm) < WGM ? (nM - fm) : WGM;
        u.pm = fm + ((wgid % nig) % gsz); u.pn = (wgid % nig) / gsz; if (rev) u.pm = nM - 1 - u.pm; return true;
    }
};

typedef float f32x2_ __attribute__((ext_vector_type(2))); typedef __bf16 bf16x2_ __attribute__((ext_vector_type(2)));
__device__ __forceinline__ unsigned cvt_pk_bf16(float lo, float hi) { f32x2_ v = {lo, hi}; bf16x2_ b = __builtin_convertvector(v, bf16x2_); return __builtin_bit_cast(unsigned, b); }
__device__ __forceinline__ float bf_lo(unsigned w) { return __builtin_bit_cast(float, w << 16); }
__device__ __forceinline__ float bf_hi(unsigned w) { return __builtin_bit_cast(float, w & 0xffff0000u); }
__device__ __forceinline__ u32x4 pack8(const f32x4 v0, const f32x4 v1) { u32x4 w; w.x = cvt_pk_bf16(v0[0], v0[1]); w.y = cvt_pk_bf16(v0[2], v0[3]); w.z = cvt_pk_bf16(v1[0], v1[1]); w.w = cvt_pk_bf16(v1[2], v1[3]); return w; }
__device__ __forceinline__ void unpack8(const u32x4 w, f32x4& v0, f32x4& v1) { v0 = (f32x4){bf_lo(w.x), bf_hi(w.x), bf_lo(w.y), bf_hi(w.y)}; v1 = (f32x4){bf_lo(w.z), bf_hi(w.z), bf_lo(w.w), bf_hi(w.w)}; }
typedef unsigned u32x2 __attribute__((ext_vector_type(2)));
__device__ __forceinline__ unsigned q8x4(const f32x4 v) {
    unsigned r = 0u;
    r = __builtin_amdgcn_cvt_pk_u8_f32(__builtin_rintf(v[0] * 255.f), 0, r); r = __builtin_amdgcn_cvt_pk_u8_f32(__builtin_rintf(v[1] * 255.f), 1, r);
    r = __builtin_amdgcn_cvt_pk_u8_f32(__builtin_rintf(v[2] * 255.f), 2, r); r = __builtin_amdgcn_cvt_pk_u8_f32(__builtin_rintf(v[3] * 255.f), 3, r); return r; }
__device__ __forceinline__ f32x4 dq8x4(unsigned w) { const float k = 1.f / 255.f;
    return (f32x4){(float)(w & 0xffu) * k, (float)((w >> 8) & 0xffu) * k, (float)((w >> 16) & 0xffu) * k, (float)(w >> 24) * k}; }
__device__ __forceinline__ float sigm(float x) { return __builtin_amdgcn_rcpf(1.f + __builtin_amdgcn_exp2f(-1.4426950408889634f * x)); }

#define EPI_LOOP _Pragma("unroll") for (int ai = 0; ai < 2; ++ai) _Pragma("unroll") for (int m = 0; m < 4; ++m) _Pragma("unroll") for (int bj = 0; bj < 2; ++bj)
#define EPI_ROW (u.pm * 256 + ai * 128 + wr * 64 + m * 16 + fr)
#define EPI_COL (u.pn * 256 + bj * 128 + wc * 32 + 8 * fq)
typedef f32x4 AccT[2][2][4][2];

struct EpiPlain {
    bf16_t* O; size_t ldc;
    __device__ __forceinline__ void operator()(const AccT& acc, const Unit& u, int wr, int wc, int fr, int fq) const {
        EPI_LOOP { const int row = EPI_ROW, col = EPI_COL; *(u32x4*)(O + (size_t)row * ldc + col) = pack8(acc[ai][bj][m][0], acc[ai][bj][m][1]); }
    }
};
struct EpiVTf {
    bf16_t* O; int mem; int g;
    __device__ __forceinline__ void operator()(const AccT& acc, const Unit& u, int wr, int wc, int fr, int fq) const {
        EPI_LOOP { const int row = EPI_ROW, col = EPI_COL;
            int e, kk; size_t tb;
            if (mem) { const int h = row >> 7, b = col >> 8; e = row & 127; kk = col & 255; tb = ((size_t)((b * 4 + h) * 8 + (kk >> 5))) * 4096; }
            else { const int hh = row >> 6, b = col >> 13; e = row & 63; kk = col & 8191; tb = (((size_t)(g * 8 + b) * 4 + hh) * 8192) * 64 + (size_t)(kk >> 5) * 2048; }
            const int t = e >> 5, c = e & 31, k0 = kk & 31, s2 = k0 >> 4, half = (k0 >> 3) & 1;
            bf16_t* d0 = O + tb + (((t * 2 + s2) * 2 + 0) * 32 + c) * 8 + half * 4;
            const f32x4 v0 = acc[ai][bj][m][0], v1 = acc[ai][bj][m][1];
            typedef unsigned u32x2 __attribute__((ext_vector_type(2)));
            u32x2 w0, w1; w0.x = cvt_pk_bf16(v0[0], v0[1]); w0.y = cvt_pk_bf16(v0[2], v0[3]); w1.x = cvt_pk_bf16(v1[0], v1[1]); w1.y = cvt_pk_bf16(v1[2], v1[3]);
            *(u32x2*)d0 = w0; *(u32x2*)(d0 + 256) = w1; }
    }
};
struct EpiMKf {
    bf16_t* O;
    __device__ __forceinline__ void operator()(const AccT& acc, const Unit& u, int wr, int wc, int fr, int fq) const {
        EPI_LOOP { const int row = EPI_ROW, col = EPI_COL; const int b = row >> 8, key = row & 255, h = col >> 7, e = col & 127;
            *(u32x4*)(O + ((size_t)((b * 4 + h) * 8 + (key >> 5))) * 4096 + (((e >> 4) * 2 + ((e >> 3) & 1)) * 32 + (key & 31)) * 8) = pack8(acc[ai][bj][m][0], acc[ai][bj][m][1]); }
    }
};
struct EpiInProj {
    bf16_t *U, *Q, *Kb, *MQ, *GATES; const float* b_gate;
    __device__ __forceinline__ void operator()(const AccT& acc, const Unit& u, int wr, int wc, int fr, int fq) const {
        const int pn = u.pn;
        if (pn < 2) { EPI_LOOP { const int row = EPI_ROW, col = EPI_COL; *(u32x4*)(U + (size_t)row * 512 + col) = pack8(acc[ai][bj][m][0], acc[ai][bj][m][1]); } }
        else if (pn < 8) {
            const int g = (pn < 5) ? pn - 2 : pn - 5; bf16_t* base = (pn < 5) ? Q : Kb; const int sh = 2 * g  , Ld = 8192 >> sh, dm = (1 << sh) - 1;
            const bool isk = (pn >= 5);
            EPI_LOOP { const int row = EPI_ROW, colw = bj * 128 + wc * 32 + 8 * fq; const int hh = colw >> 6, e = colw & 63, b = row >> 13, t = row & 8191;
                const int pp = (t & dm) * Ld + (t >> sh);
                const size_t hbase = (((size_t)(g * 8 + b) * 4 + hh) * 8192) * 64;
                const size_t off = isk ? hbase + (size_t)(pp >> 5) * 2048 + ((((e >> 4) * 2 + ((e >> 3) & 1)) * 32 + (pp & 31)) * 8) : hbase + (size_t)pp * 64 + e;
                *(u32x4*)(base + off) = pack8(acc[ai][bj][m][0], acc[ai][bj][m][1]); }
        }
        else if (pn < 10) { EPI_LOOP { const int row = EPI_ROW, col = EPI_COL - 2048; *(u32x4*)(MQ + (size_t)row * 512 + col) = pack8(acc[ai][bj][m][0], acc[ai][bj][m][1]); } }
        else {
            f32x4 bb0[2], bb1[2];
#pragma unroll
            for (int bj = 0; bj < 2; ++bj) { const int col = EPI_COL - 2560; bb0[bj] = *(const f32x4*)(b_gate + col); bb1[bj] = *(const f32x4*)(b_gate + col + 4); }
            EPI_LOOP { const int row = EPI_ROW, col = EPI_COL - 2560;
                f32x4 v0 = acc[ai][bj][m][0] + bb0[bj], v1 = acc[ai][bj][m][1] + bb1[bj];
#pragma unroll
                for (int i = 0; i < 4; ++i) { v0[i] = sigm(v0[i]); v1[i] = sigm(v1[i]); }
                u32x2 w; w.x = q8x4(v0); w.y = q8x4(v1);
                *(u32x2*)((unsigned char*)GATES + (size_t)row * 3072 + col) = w; }
        }
    }
};
struct EpiGlu {
    const bf16_t* YG; bf16_t* Y2; const float* b;
    __device__ __forceinline__ void operator()(const AccT& acc, const Unit& u, int wr, int wc, int fr, int fq) const {
        f32x4 bb0[2], bb1[2];
#pragma unroll
        for (int bj = 0; bj < 2; ++bj) { const int col = EPI_COL; bb0[bj] = *(const f32x4*)(b + col); bb1[bj] = *(const f32x4*)(b + col + 4); }
#pragma unroll
        for (int ai = 0; ai < 2; ++ai) {
            u32x4 yv[4][2];
#pragma unroll
            for (int m = 0; m < 4; ++m)
#pragma unroll
                for (int bj = 0; bj < 2; ++bj) { const int row = EPI_ROW, col = EPI_COL; yv[m][bj] = *(const u32x4*)(YG + (size_t)row * 512 + col); }
#pragma unroll
            for (int m = 0; m < 4; ++m)
#pragma unroll
                for (int bj = 0; bj < 2; ++bj) { const int row = EPI_ROW, col = EPI_COL;
                    f32x4 y0, y1; unpack8(yv[m][bj], y0, y1);
                    f32x4 v0 = acc[ai][bj][m][0] + bb0[bj], v1 = acc[ai][bj][m][1] + bb1[bj];
#pragma unroll
                    for (int i = 0; i < 4; ++i) { v0[i] = y0[i] * sigm(v0[i]); v1[i] = y1[i] * sigm(v1[i]); }
                    *(u32x4*)(Y2 + (size_t)row * 512 + col) = pack8(v0, v1); }
        }
    }
};
template <int MODE> struct EpiBranch {
    const bf16_t* GATES; bf16_t* MG; int goff;
    __device__ __forceinline__ void operator()(const AccT& acc, const Unit& u, int wr, int wc, int fr, int fq) const {
#pragma unroll
        for (int ai = 0; ai < 2; ++ai) {
            u32x2 gv[4][2]; u32x4 pv[4][2];
#pragma unroll
            for (int m = 0; m < 4; ++m)
#pragma unroll
                for (int bj = 0; bj < 2; ++bj) { const int row = EPI_ROW, col = EPI_COL; gv[m][bj] = *(const u32x2*)((const unsigned char*)GATES + (size_t)row * 3072 + goff + col);
                    if (MODE == 1) pv[m][bj] = *(const u32x4*)(MG + (size_t)row * 1024 + col); }
#pragma unroll
            for (int m = 0; m < 4; ++m)
#pragma unroll
                for (int bj = 0; bj < 2; ++bj) { const int row = EPI_ROW, col = EPI_COL; const f32x4 g0 = dq8x4(gv[m][bj].x), g1 = dq8x4(gv[m][bj].y);
                    f32x4 v0 = acc[ai][bj][m][0] * g0, v1 = acc[ai][bj][m][1] * g1;
                    if (MODE == 1) { f32x4 p0, p1; unpack8(pv[m][bj], p0, p1); v0 += p0; v1 += p1; }
                    *(u32x4*)(MG + (size_t)row * 1024 + col) = pack8(v0, v1); }
        }
    }
};
template <int MODE> struct EpiResid {
    const bf16_t* XN; const float* XS; const float* G1; bf16_t* HB; float* SS;
    __device__ __forceinline__ void operator()(const AccT& acc, const Unit& u, int wr, int wc, int fr, int fq) const {
        f32x4 ig0[2], ig1[2];
        if (MODE == 0) {
#pragma unroll
            for (int bj = 0; bj < 2; ++bj) { const int col = EPI_COL; const f32x4 a = *(const f32x4*)(G1 + col), b = *(const f32x4*)(G1 + col + 4);
#pragma unroll
                for (int i = 0; i < 4; ++i) { ig0[bj][i] = 1.0f / a[i]; ig1[bj][i] = 1.0f / b[i]; } }
        }
#pragma unroll
        for (int ai = 0; ai < 2; ++ai) {
            u32x4 hv[4][2]; float xs[4];
#pragma unroll
            for (int m = 0; m < 4; ++m) { const int row = EPI_ROW; if (MODE == 0) xs[m] = XS[row];
#pragma unroll
                for (int bj = 0; bj < 2; ++bj) { const int col = EPI_COL; const size_t o = (size_t)row * 1024 + col;
                    hv[m][bj] = *(const u32x4*)((MODE == 0 ? XN : HB) + o); } }
#pragma unroll
            for (int m = 0; m < 4; ++m) { const int row = EPI_ROW; float ss = 0.f;
#pragma unroll
                for (int bj = 0; bj < 2; ++bj) { const int col = EPI_COL; const size_t o = (size_t)row * 1024 + col;
                    f32x4 r0, r1; unpack8(hv[m][bj], r0, r1);
                    if (MODE == 0) { r0 = r0 * xs[m] * ig0[bj]; r1 = r1 * xs[m] * ig1[bj]; }
                    const f32x4 v0 = acc[ai][bj][m][0] + r0, v1 = acc[ai][bj][m][1] + r1;
                    *(u32x4*)(HB + o) = pack8(v0, v1);
                    ss += (v0[0] * v0[0] + v0[1] * v0[1]) + (v0[2] * v0[2] + v0[3] * v0[3]) + (v1[0] * v1[0] + v1[1] * v1[1]) + (v1[2] * v1[2] + v1[3] * v1[3]); }
                ss += __shfl_xor(ss, 16); ss += __shfl_xor(ss, 32);
                if (fq == 0) SS[(size_t)row * 16 + u.pn * 4 + wc] = ss; }
        }
    }
};
struct EpiUp {
    const float* SS; bf16_t* ACT;
    __device__ __forceinline__ void operator()(const AccT& acc, const Unit& u, int wr, int wc, int fr, int fq) const {
        float rsv[2][4];
#pragma unroll
        for (int ai = 0; ai < 2; ++ai) { f32x4 q[4][4];
#pragma unroll
            for (int m = 0; m < 4; ++m) { const int row = EPI_ROW; const f32x4* sp = (const f32x4*)(SS + (size_t)row * 16);
#pragma unroll
                for (int k = 0; k < 4; ++k) q[m][k] = sp[k]; }
#pragma unroll
            for (int m = 0; m < 4; ++m) { const float tot = ((q[m][0][0] + q[m][0][1]) + (q[m][0][2] + q[m][0][3])) + ((q[m][1][0] + q[m][1][1]) + (q[m][1][2] + q[m][1][3])) + ((q[m][2][0] + q[m][2][1]) + (q[m][2][2] + q[m][2][3])) + ((q[m][3][0] + q[m][3][1]) + (q[m][3][2] + q[m][3][3]));
                rsv[ai][m] = 1.0f / sqrtf(tot * (1.f / 1024.f) + 1e-6f); } }
#pragma unroll
        for (int ai = 0; ai < 2; ++ai)
#pragma unroll
            for (int m = 0; m < 4; ++m) { const int row = EPI_ROW; const float rs = rsv[ai][m];
#pragma unroll
                for (int bj = 0; bj < 2; ++bj) { const int col = EPI_COL; f32x4 v0 = acc[ai][bj][m][0] * rs, v1 = acc[ai][bj][m][1] * rs;
#pragma unroll
                    for (int i = 0; i < 4; ++i) { const float a = fmaxf(v0[i], 0.f), b = fmaxf(v1[i], 0.f); v0[i] = a * a; v1[i] = b * b; }
                    *(u32x4*)(ACT + (size_t)row * 4096 + col) = pack8(v0, v1); } }
    }
};

template <class Epi>
__device__ __forceinline__ void gemm_phase(PG8_LAS unsigned char* lds, const Gemm g, const StaticOrder& S, const Epi& E) {
    const int tid = threadIdx.x, wid = __builtin_amdgcn_readfirstlane(tid >> 6), lane = tid & 63, wr = wid >> 2, wc = wid & 3, fr = lane & 15, fq = lane >> 4;
    const int K = g.K, nt = K / BK;
    unsigned voffA[2], voffB[2];
#pragma unroll
    for (int i = 0; i < 2; ++i) { int R, C; stage_rc(tid * 16 + i * 8192, R, C); const int Rb = (R & ~31) + perm32(R & 31);
        voffA[i] = (unsigned)(R * g.lda + C) * 2u; voffB[i] = (unsigned)(Rb * g.ldb + C) * 2u; }
    const size_t kstep = (size_t)(BK * 2);
    const size_t hstepA = (size_t)HALF * g.lda * 2, hstepB = (size_t)HALF * g.ldb * 2;
    const unsigned ldsw = (unsigned)wid * 1024u;
    const int aoff = lds_byte(wr * 64 + fr, fq * 8), boff = lds_byte(wc * 32 + fr, fq * 8);
#define PG8_SA(b, h) (((b) * 2 + (h)) * HTB)
#define PG8_SB(b, h) ((4 + (b) * 2 + (h)) * HTB)
#define PG8_STAGE(bufoff, gbase, voff) do { _Pragma("unroll") for (int _i = 0; _i < 2; ++_i) \
        __builtin_amdgcn_global_load_lds((const unsigned*)((const char*)(gbase) + (voff)[_i]), (PG8_LAS unsigned*)(lds + (bufoff) + ldsw + _i * 8192), 16, 0, 0); } while (0)
#define PG8_LDA(dst, b, h) do { _Pragma("unroll") for (int m = 0; m < 4; ++m) _Pragma("unroll") for (int k = 0; k < 2; ++k) dst[m][k] = *(const PG8_LAS bf16x8*)(lds + PG8_SA(b, h) + aoff + m * 2048 + k * 1024); } while (0)
#define PG8_LDB(dst, b, h) do { _Pragma("unroll") for (int n = 0; n < 2; ++n) _Pragma("unroll") for (int k = 0; k < 2; ++k) dst[n][k] = *(const PG8_LAS bf16x8*)(lds + PG8_SB(b, h) + boff + n * 2048 + k * 1024); } while (0)
#define PG8_MMA(ai, bj, At, Bt) do { __builtin_amdgcn_s_setprio(1); _Pragma("unroll") for (int m = 0; m < 4; ++m) _Pragma("unroll") for (int n = 0; n < 2; ++n) _Pragma("unroll") for (int k = 0; k < 2; ++k) \
        acc[ai][bj][m][n] = __builtin_amdgcn_mfma_f32_16x16x32_bf16(Bt[n][k], At[m][k], acc[ai][bj][m][n], 0, 0, 0); __builtin_amdgcn_s_setprio(0); } while (0)
#define PG8_WAIT_V(n) asm volatile("s_waitcnt vmcnt(" #n ")" ::: "memory")
#define PG8_WAIT_L(n) asm volatile("s_waitcnt lgkmcnt(" #n ")" ::: "memory")
#define PG8_BAR __builtin_amdgcn_s_barrier()
#define PG8_SCHED __builtin_amdgcn_sched_barrier(0)
    Unit cur, nxt; int ui = 0;
    if (!S.next(0, cur)) return;
    f32x4 acc[2][2][4][2];
#pragma unroll
    for (int a = 0; a < 2; ++a)
#pragma unroll
        for (int b = 0; b < 2; ++b)
#pragma unroll
            for (int m = 0; m < 4; ++m)
#pragma unroll
                for (int n = 0; n < 2; ++n) acc[a][b][m][n] = (f32x4){0.f, 0.f, 0.f, 0.f};
    bf16x8 At[4][2], B0[2][2], B1[2][2];
    const char* cA = a_tile(g, cur.pm); const char* cB = b_tile(g, cur.pn);
    PG8_STAGE(PG8_SB(0, 0), cB, voffB); PG8_STAGE(PG8_SB(0, 1), cB + hstepB, voffB); PG8_STAGE(PG8_SA(0, 0), cA, voffA); PG8_STAGE(PG8_SA(0, 1), cA + hstepA, voffA);
    if (wr == 1) PG8_BAR;
    PG8_WAIT_V(2); PG8_BAR;
    PG8_STAGE(PG8_SB(1, 0), cB + kstep, voffB); PG8_STAGE(PG8_SA(1, 0), cA + kstep, voffA); PG8_STAGE(PG8_SB(1, 1), cB + hstepB + kstep, voffB);
    PG8_WAIT_V(6); PG8_BAR;
    for (;;) {
        const bool has_next = S.next(ui + 1, nxt);
        const char* nA = has_next ? a_tile(g, nxt.pm) : cA; const char* nB = has_next ? b_tile(g, nxt.pn) : cB;
        for (int t = 0; t < nt; t += 2) {
            const bool last = (t == nt - 2);
            const char* a1 = cA + (size_t)(t + 1) * kstep;
            const char* a2 = last ? nA : cA + (size_t)(t + 2) * kstep; const char* b2 = last ? nB : cB + (size_t)(t + 2) * kstep;
            const char* a3 = a2 + kstep; const char* b3 = b2 + kstep;
            PG8_LDB(B0, 0, 0); PG8_LDB(B1, 0, 1); PG8_SCHED; PG8_LDA(At, 0, 0); PG8_STAGE(PG8_SA(1, 1), a1 + hstepA, voffA);
            PG8_WAIT_V(8); PG8_WAIT_L(0); PG8_BAR; PG8_MMA(0, 0, At, B0); PG8_MMA(0, 1, At, B1); PG8_BAR; PG8_SCHED;
            PG8_LDA(At, 0, 1); PG8_STAGE(PG8_SB(0, 0), b2, voffB); PG8_STAGE(PG8_SB(0, 1), b2 + hstepB, voffB); PG8_STAGE(PG8_SA(0, 0), a2, voffA);
            PG8_WAIT_V(8); PG8_WAIT_L(0); PG8_BAR; PG8_MMA(1, 0, At, B0); PG8_MMA(1, 1, At, B1); PG8_BAR; PG8_SCHED;
            PG8_LDB(B0, 1, 0); PG8_LDB(B1, 1, 1); PG8_SCHED; PG8_LDA(At, 1, 0); PG8_STAGE(PG8_SA(0, 1), a2 + hstepA, voffA);
            PG8_WAIT_V(8); PG8_WAIT_L(0); PG8_BAR; PG8_MMA(0, 0, At, B0); PG8_MMA(0, 1, At, B1); PG8_BAR; PG8_SCHED;
            PG8_LDA(At, 1, 1); PG8_STAGE(PG8_SB(1, 0), b3, voffB); PG8_STAGE(PG8_SB(1, 1), b3 + hstepB, voffB); PG8_STAGE(PG8_SA(1, 0), a3, voffA);
            PG8_WAIT_V(8); PG8_WAIT_L(0); PG8_BAR; PG8_MMA(1, 0, At, B0); PG8_MMA(1, 1, At, B1); PG8_BAR; PG8_SCHED;
        }
        if (wr == 0) PG8_BAR;
        E(acc, cur, wr, wc, fr, fq);
        if (!has_next) break;
#pragma unroll
        for (int a = 0; a < 2; ++a)
#pragma unroll
            for (int b = 0; b < 2; ++b)
#pragma unroll
                for (int m = 0; m < 4; ++m)
#pragma unroll
                    for (int n = 0; n < 2; ++n) acc[a][b][m][n] = (f32x4){0.f, 0.f, 0.f, 0.f};
        cur = nxt; cA = nA; cB = nB; ++ui;
        if (wr == 1) PG8_BAR;
    }
    PG8_WAIT_V(0);
    PG8_BAR;
#undef PG8_SA
#undef PG8_SB
#undef PG8_STAGE
#undef PG8_LDA
#undef PG8_LDB
#undef PG8_MMA
#undef PG8_WAIT_V
#undef PG8_WAIT_L
#undef PG8_BAR
#undef PG8_SCHED
}
}

constexpr int NWAVES = 8;
constexpr int BATCH = 8, SEQ = 8192, D = 1024, M = BATCH * SEQ, FF = 4096;
constexpr int NIN = 5632;
constexpr int N_PHASES = 10;

constexpr size_t MiB = 1u << 20;
constexpr size_t WS_BAR = 0;
constexpr size_t WS_SSMA = 512 * 1024;
constexpr size_t WS_SSMB = 576 * 1024;
constexpr size_t WS_SSMC = 704 * 1024;
constexpr size_t WS_WIN = 2 * MiB;
constexpr size_t WS_WV = 13 * MiB;
constexpr size_t WS_WGLU = 15 * MiB;
constexpr size_t WS_WSSM = 16 * MiB;
constexpr size_t WS_WATT = 17 * MiB;
constexpr size_t WS_WMKV = 18 * MiB;
constexpr size_t WS_WMEM = 20 * MiB;
constexpr size_t WS_WO = 21 * MiB;
constexpr size_t WS_WUP = 23 * MiB;
constexpr size_t WS_WDN = 31 * MiB;
constexpr size_t WS_MEMN = 40 * MiB;
constexpr size_t WS_MK = 44 * MiB;
constexpr size_t WS_MVT = 46 * MiB;
constexpr size_t WS_E = 48 * MiB;
constexpr size_t WS_SSP1 = 56 * MiB, WS_SSP2 = 60 * MiB;
constexpr size_t WS_XN = 64 * MiB;
constexpr size_t WS_OG = 512 * MiB, WS_LSE = 608 * MiB;
constexpr size_t WS_XS = 128 * 1024;
constexpr size_t WS_U = 192 * MiB;
constexpr size_t WS_MQ = 256 * MiB;
constexpr size_t WS_HB = 192 * MiB;
constexpr size_t WS_GATES = 320 * MiB;
constexpr size_t WS_Q = 704 * MiB, WS_K = 800 * MiB, WS_VT = 896 * MiB;
constexpr size_t WS_YG = 704 * MiB, WS_Y2 = 768 * MiB, WS_OMRG = 832 * MiB, WS_MG = 864 * MiB;
constexpr size_t WS_ACT = 320 * MiB;
constexpr size_t WS_END = 992 * MiB;

constexpr int LDS_BYTES = 147456;

#define LAS __attribute__((address_space(3)))
typedef unsigned short bf16;
typedef unsigned v4u __attribute__((ext_vector_type(4)));
typedef unsigned v2u __attribute__((ext_vector_type(2)));
typedef float f32x4 __attribute__((ext_vector_type(4)));
typedef float f32x2 __attribute__((ext_vector_type(2)));
typedef float f32x16 __attribute__((ext_vector_type(16)));
typedef short bf16x8 __attribute__((ext_vector_type(8)));
typedef short s16x4 __attribute__((ext_vector_type(4)));
typedef __bf16 bf16x2_t __attribute__((ext_vector_type(2)));
__device__ __forceinline__ unsigned cvtpk(float lo, float hi) { f32x2 v = {lo, hi}; bf16x2_t b = __builtin_convertvector(v, bf16x2_t); return __builtin_bit_cast(unsigned, b); }
__device__ __forceinline__ float wave_sum(float v) {
#pragma unroll
    for (int o = 1; o < 64; o <<= 1) v += __shfl_xor(v, o);
    return v;
}
__device__ __forceinline__ float bf2f(bf16 b) { return __builtin_bit_cast(float, (unsigned)b << 16); }

struct Args { const float* in[25]; float* out; unsigned char* ws; int ph_lo, ph_hi; };

__device__ __forceinline__ void p0_transpose_item(const float* W, int ldw, int c0, int K, int nblk, bf16* WT, int row_off, const float* scale, LAS float* scr, int item, int lane) {
    const int kb = item / nblk, nb = item % nblk, k0 = 64 * kb, n0 = 32 * nb;
#pragma unroll 8
    for (int i = 0; i < 32; ++i) { const int kk = 2 * i + (lane >> 5); float v = W[(size_t)(k0 + kk) * ldw + c0 + n0 + (lane & 31)]; if (scale) v *= scale[k0 + kk]; scr[kk * 33 + (lane & 31)] = v; }
    asm volatile("s_waitcnt lgkmcnt(0)" ::: "memory");
    const int c = lane & 7;
#pragma unroll
    for (int j = 0; j < 4; ++j) { const int n = (lane >> 3) + 8 * j; const LAS float* s = scr + (8 * c) * 33 + n;
        v4u o; o.x = cvtpk(s[0 * 33], s[1 * 33]); o.y = cvtpk(s[2 * 33], s[3 * 33]); o.z = cvtpk(s[4 * 33], s[5 * 33]); o.w = cvtpk(s[6 * 33], s[7 * 33]);
        *(v4u*)(WT + (size_t)(row_off + n0 + n) * K + k0 + 8 * c) = o; }
    asm volatile("s_waitcnt lgkmcnt(0)" ::: "memory");
}
template <int NR>
__device__ __forceinline__ void rms_rows_to_bf16(const float* xrow, size_t rs, const float* g, bf16* orow, int lane, float* xs_out) {
    const f32x4* gr = (const f32x4*)g + lane;
    f32x4 v[NR][4]; float s[NR];
#pragma unroll
    for (int r = 0; r < NR; ++r) { const f32x4* xr = (const f32x4*)(xrow + r * rs) + lane; s[r] = 0.f;
#pragma unroll
        for (int j = 0; j < 4; ++j) v[r][j] = xr[64 * j]; }
    f32x4 gg[4];
#pragma unroll
    for (int j = 0; j < 4; ++j) gg[j] = gr[64 * j];
#pragma unroll
    for (int r = 0; r < NR; ++r) {
#pragma unroll
        for (int j = 0; j < 4; ++j) s[r] += (v[r][j].x * v[r][j].x + v[r][j].y * v[r][j].y) + (v[r][j].z * v[r][j].z + v[r][j].w * v[r][j].w);
        const float nrm = sqrtf(wave_sum(s[r]) * (1.f / 1024.f) + 1e-6f), rstd = 1.f / nrm;
        if (xs_out && lane == 0) xs_out[r] = nrm;
        unsigned long long* o8 = (unsigned long long*)(orow + r * rs) + lane;
#pragma unroll
        for (int j = 0; j < 4; ++j)
            o8[64 * j] = (unsigned long long)cvtpk(v[r][j].x * rstd * gg[j].x, v[r][j].y * rstd * gg[j].y) | ((unsigned long long)cvtpk(v[r][j].z * rstd * gg[j].z, v[r][j].w * rstd * gg[j].w) << 32); }
}
__device__ __forceinline__ void sincos_d(double x, double& s, double& c) {
    const double k = rint(x * 0.15915494309189535); const double y = (x - k * 6.283185307179586) - k * 2.4492935982947064e-16;
    const double y2 = y * y; double ts = 1.0, tc = 1.0;
#pragma unroll 1
    for (int n = 27; n >= 3; n -= 2) { ts = 1.0 - ts * y2 / (double)(n * (n - 1)); tc = 1.0 - tc * y2 / (double)((n - 1) * (n - 2)); }
    s = y * ts; c = tc;
}

template <int E, bool MASK>
__device__ __forceinline__ void attn_wave(const bf16* Qp, int ldq, const bf16* Kt, const bf16* Vt,
                                          int kt0, int kt1, int j0, int lane, f32x16 (&O)[E / 32], float& m_out, float& l_out) {
    constexpr int TE = 32 * E;
    const int c = lane & 31, hi = lane >> 5;
    bf16x8 qf[E / 16];
#pragma unroll
    for (int s = 0; s < E / 16; ++s) qf[s] = *(const bf16x8*)(Qp + (size_t)c * ldq + 16 * s + 8 * hi);
    float mrun = -1e30f, l = 0.f;
#pragma unroll
    for (int t = 0; t < E / 32; ++t)
#pragma unroll
        for (int i = 0; i < 16; ++i) O[t][i] = 0.f;
    const float c2 = (E == 64 ? 0.125f : 0.08838834764831845f) * 1.4426950408889634f;
    bf16x8 kf[E / 16];
#pragma unroll
    for (int s = 0; s < E / 16; ++s) kf[s] = *(const bf16x8*)(Kt + (size_t)kt0 * TE + s * 512 + lane * 8);
    for (int kt = kt0; kt <= kt1; ++kt) {
        bf16x8 vfr[E / 32][2];
#pragma unroll
        for (int t = 0; t < E / 32; ++t)
#pragma unroll
            for (int s2 = 0; s2 < 2; ++s2) vfr[t][s2] = *(const bf16x8*)(Vt + (size_t)kt * TE + (t * 2 + s2) * 512 + lane * 8);
        bf16x8 kn[E / 16];
        { const int ktn = (kt < kt1) ? kt + 1 : kt1;
#pragma unroll
          for (int s = 0; s < E / 16; ++s) kn[s] = *(const bf16x8*)(Kt + (size_t)ktn * TE + s * 512 + lane * 8); }
        f32x16 S;
#pragma unroll
        for (int i = 0; i < 16; ++i) S[i] = 0.f;
#pragma unroll
        for (int s = 0; s < E / 16; ++s) S = __builtin_amdgcn_mfma_f32_32x32x16_bf16(kf[s], qf[s], S, 0, 0, 0);
        if (MASK) {
            const bool full = (kt * 32 + 31 <= j0) && (kt * 32 + 128 >= j0 + 31);
            if (!full) { const int qj = j0 + c;
#pragma unroll
                for (int i = 0; i < 16; ++i) { const int kj = kt * 32 + (i & 3) + 8 * (i >> 2) + 4 * hi; const bool valid = (kj <= qj) && (kj + 128 >= qj); S[i] = valid ? S[i] : -1e30f; } }
        }
        float mx = S[0];
#pragma unroll
        for (int i = 1; i < 16; ++i) mx = fmaxf(mx, S[i]);
        mx = fmaxf(mx, __shfl_xor(mx, 32));
        const float mn = fmaxf(mrun, mx); const float alpha = __builtin_amdgcn_exp2f((mrun - mn) * c2); mrun = mn;
        float ps = 0.f;
#pragma unroll
        for (int i = 0; i < 16; ++i) { const float p = __builtin_amdgcn_exp2f((S[i] - mn) * c2); S[i] = p; ps += p; }
        l = l * alpha + ps;
#pragma unroll
        for (int t = 0; t < E / 32; ++t)
#pragma unroll
            for (int i = 0; i < 16; ++i) O[t][i] *= alpha;
        bf16x8 pk[2];
#pragma unroll
        for (int s2 = 0; s2 < 2; ++s2) { v4u w; w.x = cvtpk(S[8 * s2 + 0], S[8 * s2 + 1]); w.y = cvtpk(S[8 * s2 + 2], S[8 * s2 + 3]); w.z = cvtpk(S[8 * s2 + 4], S[8 * s2 + 5]); w.w = cvtpk(S[8 * s2 + 6], S[8 * s2 + 7]); pk[s2] = __builtin_bit_cast(bf16x8, w); }
#pragma unroll
        for (int t = 0; t < E / 32; ++t)
#pragma unroll
            for (int s2 = 0; s2 < 2; ++s2) O[t] = __builtin_amdgcn_mfma_f32_32x32x16_bf16(vfr[t][s2], pk[s2], O[t], 0, 0, 0);
#pragma unroll
        for (int s = 0; s < E / 16; ++s) kf[s] = kn[s];
    }
    l += __shfl_xor(l, 32);
    m_out = mrun; l_out = l;
}

__device__ __forceinline__ void sattn_wave(const bf16* Qp, const bf16* Kt, const bf16* Vt, int j0, int lane, f32x16 (&O)[2][2], float (&m_out)[2], float (&l_out)[2]) {
    const int c = lane & 31, hi = lane >> 5;
    bf16x8 qf[2][4];
#pragma unroll
    for (int q = 0; q < 2; ++q)
#pragma unroll
        for (int s = 0; s < 4; ++s) qf[q][s] = *(const bf16x8*)(Qp + (size_t)(32 * q + c) * 64 + 16 * s + 8 * hi);
    float mrun[2] = {-1e30f, -1e30f}, l[2] = {0.f, 0.f};
#pragma unroll
    for (int q = 0; q < 2; ++q)
#pragma unroll
        for (int t = 0; t < 2; ++t)
#pragma unroll
            for (int i = 0; i < 16; ++i) O[q][t][i] = 0.f;
    const float c2 = 0.125f * 1.4426950408889634f;
    const int kb = j0 >> 5, kt_end = kb + 1, kt_beg = (kb >= 4) ? kb - 4 : 0;
    bf16x8 kf[4], vfr[2][2];
#pragma unroll
    for (int s = 0; s < 4; ++s) kf[s] = *(const bf16x8*)(Kt + (size_t)kt_beg * 2048 + s * 512 + lane * 8);
#pragma unroll
    for (int t = 0; t < 2; ++t)
#pragma unroll
        for (int s2 = 0; s2 < 2; ++s2) vfr[t][s2] = *(const bf16x8*)(Vt + (size_t)kt_beg * 2048 + (t * 2 + s2) * 512 + lane * 8);
    for (int kt = kt_beg; kt <= kt_end; ++kt) {
        const int ktn = (kt < kt_end) ? kt + 1 : kt_end;
        bf16x8 kn[4], vn[2][2];
#pragma unroll
        for (int s = 0; s < 4; ++s) kn[s] = *(const bf16x8*)(Kt + (size_t)ktn * 2048 + s * 512 + lane * 8);
#pragma unroll
        for (int t = 0; t < 2; ++t)
#pragma unroll
            for (int s2 = 0; s2 < 2; ++s2) vn[t][s2] = *(const bf16x8*)(Vt + (size_t)ktn * 2048 + (t * 2 + s2) * 512 + lane * 8);
#pragma unroll
        for (int q = 0; q < 2; ++q) {
            const int kq = kb + q;
            if (kt <= kq && kt + 4 >= kq) {
                f32x16 S;
#pragma unroll
                for (int i = 0; i < 16; ++i) S[i] = 0.f;
#pragma unroll
                for (int s = 0; s < 4; ++s) S = __builtin_amdgcn_mfma_f32_32x32x16_bf16(kf[s], qf[q][s], S, 0, 0, 0);
                const int jq = j0 + 32 * q;
                const bool full = (kt * 32 + 31 <= jq) && (kt * 32 + 128 >= jq + 31);
                if (!full) { const int qj = jq + c;
#pragma unroll
                    for (int i = 0; i < 16; ++i) { const int kj = kt * 32 + (i & 3) + 8 * (i >> 2) + 4 * hi; const bool valid = (kj <= qj) && (kj + 128 >= qj); S[i] = valid ? S[i] : -1e30f; } }
                float mx = S[0];
#pragma unroll
                for (int i = 1; i < 16; ++i) mx = fmaxf(mx, S[i]);
                mx = fmaxf(mx, __shfl_xor(mx, 32));
                const float mn = fmaxf(mrun[q], mx); const float alpha = __builtin_amdgcn_exp2f((mrun[q] - mn) * c2); mrun[q] = mn;
                float ps = 0.f;
#pragma unroll
                for (int i = 0; i < 16; ++i) { const float p = __builtin_amdgcn_exp2f((S[i] - mn) * c2); S[i] = p; ps += p; }
                l[q] = l[q] * alpha + ps;
#pragma unroll
                for (int t = 0; t < 2; ++t)
#pragma unroll
                    for (int i = 0; i < 16; ++i) O[q][t][i] *= alpha;
                bf16x8 pk[2];
#pragma unroll
                for (int s2 = 0; s2 < 2; ++s2) { v4u w; w.x = cvtpk(S[8 * s2 + 0], S[8 * s2 + 1]); w.y = cvtpk(S[8 * s2 + 2], S[8 * s2 + 3]); w.z = cvtpk(S[8 * s2 + 4], S[8 * s2 + 5]); w.w = cvtpk(S[8 * s2 + 6], S[8 * s2 + 7]); pk[s2] = __builtin_bit_cast(bf16x8, w); }
#pragma unroll
                for (int t = 0; t < 2; ++t)
#pragma unroll
                    for (int s2 = 0; s2 < 2; ++s2) O[q][t] = __builtin_amdgcn_mfma_f32_32x32x16_bf16(vfr[t][s2], pk[s2], O[q][t], 0, 0, 0);
            }
        }
#pragma unroll
        for (int s = 0; s < 4; ++s) kf[s] = kn[s];
#pragma unroll
        for (int t = 0; t < 2; ++t)
#pragma unroll
            for (int s2 = 0; s2 < 2; ++s2) vfr[t][s2] = vn[t][s2];
    }
#pragma unroll
    for (int q = 0; q < 2; ++q) { l[q] += __shfl_xor(l[q], 32); m_out[q] = mrun[q]; l_out[q] = l[q]; }
}

constexpr int SSM_LROW = 272;
template <bool PASSB>
__device__ __forceinline__ void ssm_wave(const unsigned char* ws, const float* dd, int b, int g, int segbase, int hstride, int nsp, LAS unsigned char* sb, int lane) {
    const int c = lane & 31, hi = lane >> 5;
    const f32x4 pa0 = *(const f32x4*)(ws + WS_SSMA + (size_t)(g * 64 + c) * 16), pa1 = *(const f32x4*)(ws + WS_SSMA + (size_t)(g * 64 + c + 32) * 16);
    bf16x8 bfr[4];
#pragma unroll
    for (int n = 0; n < 4; ++n) bfr[n] = *(const bf16x8*)(ws + WS_SSMB + ((size_t)((g * 4 + n) * 32 + c) * 16 + 8 * hi) * 2);
    const bf16* U = (const bf16*)(ws + WS_U);
    float s0r = 0.f, s0i = 0.f, s1r = 0.f, s1i = 0.f;
    f32x2* Eb = (f32x2*)(ws + WS_E) + (size_t)(b * 32 + g) * 64 * 64;
    if (PASSB) {
        const int seg = segbase + hstride * hi;
#pragma unroll 8
        for (int sq = 0; sq < seg; ++sq) { const f32x2 e0 = Eb[sq * 64 + c], e1 = Eb[sq * 64 + c + 32];
            const float n0r = pa0.z * s0r - pa0.w * s0i + e0.x, n0i = pa0.z * s0i + pa0.w * s0r + e0.y; s0r = n0r; s0i = n0i;
            const float n1r = pa1.z * s1r - pa1.w * s1i + e1.x, n1i = pa1.z * s1i + pa1.w * s1r + e1.y; s1r = n1r; s1i = n1i; }
    }
    bf16x8 cfr[4];
    if (PASSB) {
#pragma unroll
        for (int ks = 0; ks < 4; ++ks) cfr[ks] = *(const bf16x8*)(ws + WS_SSMC + ((size_t)(g * 16 + (lane & 15)) * 128 + 32 * ks + 8 * (lane >> 4)) * 2);
    }
    const int segsel = (c >> 2) & 1, toff = (c & 3) + 4 * (c >> 3);
    const float dsk = dd[g * 16 + (lane & 15)];
    for (int kp = 0; kp < nsp; ++kp) {
        if (!PASSB) { s0r = 0.f; s0i = 0.f; s1r = 0.f; s1i = 0.f; }
        const int seg0 = segbase + kp;
        const size_t tokA = (size_t)b * 8192 + (size_t)(seg0 + hstride * segsel) * 128 + toff;
        bf16x8 ufn = *(const bf16x8*)(U + tokA * 512 + g * 16 + 8 * hi);
        for (int blk = 0; blk < 8; ++blk) {
            const bf16x8 uf = ufn; { const int bn = (blk < 7) ? blk + 1 : 7; ufn = *(const bf16x8*)(U + (tokA + bn * 16) * 512 + g * 16 + 8 * hi); }
            bf16 uu[2][4];
            if (PASSB) {
#pragma unroll
                for (int ss = 0; ss < 2; ++ss)
#pragma unroll
                    for (int rg = 0; rg < 4; ++rg) uu[ss][rg] = U[((size_t)b * 8192 + (size_t)(seg0 + hstride * ss) * 128 + blk * 16 + (lane >> 4) * 4 + rg) * 512 + g * 16 + (lane & 15)];
            }
            f32x16 z;
#pragma unroll
            for (int i = 0; i < 16; ++i) z[i] = 0.f;
            const f32x16 BU0 = __builtin_amdgcn_mfma_f32_32x32x16_bf16(uf, bfr[0], z, 0, 0, 0), BU1 = __builtin_amdgcn_mfma_f32_32x32x16_bf16(uf, bfr[1], z, 0, 0, 0);
            const f32x16 BU2 = __builtin_amdgcn_mfma_f32_32x32x16_bf16(uf, bfr[2], z, 0, 0, 0), BU3 = __builtin_amdgcn_mfma_f32_32x32x16_bf16(uf, bfr[3], z, 0, 0, 0);
#pragma unroll
            for (int i = 0; i < 16; ++i) {
                const float n0r = pa0.x * s0r - pa0.y * s0i + BU0[i], n0i = pa0.x * s0i + pa0.y * s0r + BU1[i]; s0r = n0r; s0i = n0i;
                const float n1r = pa1.x * s1r - pa1.y * s1i + BU2[i], n1i = pa1.x * s1i + pa1.y * s1r + BU3[i]; s1r = n1r; s1i = n1i;
                if (PASSB) { LAS unsigned char* rowp = sb + (hi * 16 + i) * SSM_LROW + 4 * c;
                    *(LAS unsigned*)rowp = cvtpk(s0r, s0i); *(LAS unsigned*)(rowp + 128) = cvtpk(s1r, s1i); }
            }
            if (PASSB) {
                asm volatile("s_waitcnt lgkmcnt(0)" ::: "memory");
#pragma unroll
                for (int ss = 0; ss < 2; ++ss) {
                    pg8::f32x4 Y = {0.f, 0.f, 0.f, 0.f};
#pragma unroll
                    for (int ks = 0; ks < 4; ++ks) { const bf16x8 af = *(const LAS bf16x8*)(sb + (ss * 16 + (lane & 15)) * SSM_LROW + (32 * ks + 8 * (lane >> 4)) * 2);
                        Y = __builtin_amdgcn_mfma_f32_16x16x32_bf16(af, cfr[ks], Y, 0, 0, 0); }
#pragma unroll
                    for (int rg = 0; rg < 4; ++rg) { const size_t tok = (size_t)b * 8192 + (size_t)(seg0 + hstride * ss) * 128 + blk * 16 + (lane >> 4) * 4 + rg; const size_t o = tok * 512 + g * 16 + (lane & 15);
                        const float y = Y[rg] + dsk * bf2f(uu[ss][rg]);
                        const float zz = 0.7978845608028654f * (y + 0.044715f * y * y * y);
                        const float gl = y * __builtin_amdgcn_rcpf(1.f + __builtin_amdgcn_exp2f(-2.885390081777927f * zz));
                        ((bf16*)(ws + WS_YG))[o] = (bf16)(cvtpk(gl, 0.f) & 0xffffu); }
                }
                asm volatile("s_waitcnt lgkmcnt(0)" ::: "memory");
            }
        }
        if (!PASSB) { const int seg = seg0 + hstride * hi; Eb[seg * 64 + c] = (f32x2){s0r, s0i}; Eb[seg * 64 + c + 32] = (f32x2){s1r, s1i}; }
    }
}

#define RLX_AGENT __ATOMIC_RELAXED, __HIP_MEMORY_SCOPE_AGENT
#define XB_TMO      128
#define XB_XCNT(j)  (256  + 64 * (j))
#define XB_XSUB(j)  (1280 + 64 * (j))
#define XB_XGEN(j)  (2304 + 64 * (j))
#define XB_TOP      3328
#define XB_TOPGEN   3392
#define XCD_BAR_WORDS 3456
#define XB_SPIN_CAP (1u << 18)

__device__ __forceinline__ unsigned xb_ld(unsigned* p)              { return __hip_atomic_load(p, __ATOMIC_RELAXED, __HIP_MEMORY_SCOPE_AGENT); }
__device__ __forceinline__ unsigned xb_add(unsigned* p, unsigned v) { return __hip_atomic_fetch_add(p, v, __ATOMIC_RELAXED, __HIP_MEMORY_SCOPE_AGENT); }
__device__ __forceinline__ unsigned xb_xcc_id() { return (unsigned)__builtin_amdgcn_s_getreg((3 << 11) | 20) & 0xFu; }
#define XB_SPIN(cond, bar) do { unsigned _sp = 0; while (cond) { __builtin_amdgcn_s_sleep(1); \
    if ((++_sp & 255u) == 0u) { if (xb_ld(&(bar)[XB_TMO])) break; if (_sp > XB_SPIN_CAP) { atomicAdd(&(bar)[XB_TMO], 1u); break; } } } } while (0)

struct XcdBarrier {
    unsigned* bar; unsigned x;
    volatile LAS unsigned* st;
};

__device__ __forceinline__ XcdBarrier xcd_barrier_post(unsigned* bar, volatile LAS unsigned* st) {
    XcdBarrier b; b.bar = bar; b.x = xb_xcc_id(); b.st = st;
    if (threadIdx.x == 0) (void)xb_add(&bar[XB_XCNT(b.x)], 1u);
    return b;
}
__device__ __forceinline__ void xcd_barrier_complete(unsigned* bar, unsigned x, unsigned& nloc, unsigned& nx) {
    const unsigned G = gridDim.x * gridDim.y * gridDim.z;
    unsigned sum, cnt, mine, sp = 0u;
    for (;;) {
        sum = 0u; cnt = 0u; mine = 0u;
#pragma unroll
        for (unsigned j = 0; j < 16; ++j) { const unsigned c = xb_ld(&bar[XB_XCNT(j)]); sum += c; cnt += (c > 0u) ? 1u : 0u; mine = (j == x) ? c : mine; }
        if (sum == G) break;
        __builtin_amdgcn_s_sleep(1);
        if ((++sp & 255u) == 0u) { if (xb_ld(&bar[XB_TMO])) break; if (sp > XB_SPIN_CAP) { atomicAdd(&bar[XB_TMO], 1u); break; } }
    }
    nloc = mine > 0u ? mine : 1u; nx = cnt > 0u ? cnt : 1u;
}

__device__ __forceinline__ void xcd_barrier(const XcdBarrier& b) {
    asm volatile("s_waitcnt vmcnt(0)" ::: "memory");
    __syncthreads();
    if (threadIdx.x == 0) {
        unsigned* bar = b.bar;
        __builtin_amdgcn_s_waitcnt(0);
        unsigned nloc = b.st[0], nx = b.st[1];
        if (nloc == 0u) { xcd_barrier_complete(bar, b.x, nloc, nx); b.st[0] = nloc; b.st[1] = nx; }
        const unsigned old = xb_add(&bar[XB_XSUB(b.x)], 1u);
        const unsigned gen = old / nloc;
        if (old + 1u == (gen + 1u) * nloc) {
            __builtin_amdgcn_fence(__ATOMIC_RELEASE, "agent");
            asm volatile("s_waitcnt vmcnt(0)" ::: "memory");
            const unsigned og = xb_add(&bar[XB_TOP], 1u);
            const unsigned tg = og / nx;
            if (og + 1u == (tg + 1u) * nx) xb_add(&bar[XB_TOPGEN], 1u);
            else XB_SPIN(xb_ld(&bar[XB_TOPGEN]) == tg, bar);
            __builtin_amdgcn_fence(__ATOMIC_ACQUIRE, "agent");
            xb_add(&bar[XB_XGEN(b.x)], 1u);
            asm volatile("s_waitcnt vmcnt(0)" ::: "memory");
        } else {
            XB_SPIN(xb_ld(&bar[XB_XGEN(b.x)]) == gen, bar);
            __builtin_amdgcn_fence(__ATOMIC_ACQUIRE, "agent");
            asm volatile("s_waitcnt vmcnt(0)" ::: "memory");
        }
    }
    __syncthreads();
}

__global__ void __launch_bounds__(NWAVES * 64, 2) fwd_megakernel(Args args) {
    __shared__ __attribute__((aligned(16))) unsigned char lds_raw[LDS_BYTES];
    LAS unsigned char* lds = (LAS unsigned char*)lds_raw;
    const int tid = threadIdx.x, lane = tid & 63, wave = __builtin_amdgcn_readfirstlane(tid >> 6);
    const int G = gridDim.x; const int bx = blockIdx.x; const int vcu = (G % 8 == 0) ? (bx % 8) * (G / 8) + bx / 8 : bx;
    const int gw = vcu * NWAVES + wave, NGW = G * NWAVES;
    unsigned char* ws = args.ws;
    const int lo = args.ph_lo, hi_ph = args.ph_hi;
    volatile LAS unsigned* MISC = (volatile LAS unsigned*)(lds + 131072 + 320);
    if (tid < 32) MISC[tid] = 0u;
    __syncthreads();
    XcdBarrier bar; bar.bar = (unsigned*)ws; bar.x = 0; bar.st = nullptr;
    if (hi_ph - lo > 1) bar = xcd_barrier_post((unsigned*)ws, MISC + 8);
    if (lo == 0x7fffffff) cg::this_grid().sync();
#define IN(k) (lo <= (k) && (k) < hi_ph)
#define SEAM(k) do { if (IN(k) && IN((k) + 1)) { xcd_barrier(bar); } } while (0)

    if (IN(0)) {
        LAS float* scr = (LAS float*)(lds + wave * 16384);
        const float* w_in = args.in[4];
        constexpr int I0 = 16 * 64, I1 = 16 * 24, I2 = 16 * 112, I3 = 8 * 16, I4 = 8 * 32, I5 = 4 * 32, I6 = 16 * 32, I7 = 8 * 32, I8 = 16 * 32, I9 = 16 * 128, I10 = 64 * 32;
        constexpr int NITEMS = I0 + I1 + I2 + I3 + I4 + I5 + I6 + I7 + I8 + I9 + I10;
        for (int it = gw; it < NITEMS; it += NGW) {
            int r = it;
            if (r < I0) { p0_transpose_item(w_in, 6400, 0, 1024, 64, (bf16*)(ws + WS_WIN), 0, nullptr, scr, r, lane); continue; } r -= I0;
            if (r < I1) { p0_transpose_item(w_in, 6400, 2048, 1024, 24, (bf16*)(ws + WS_WV), 0, nullptr, scr, r, lane); continue; } r -= I1;
            if (r < I2) { p0_transpose_item(w_in, 6400, 2816, 1024, 112, (bf16*)(ws + WS_WIN), 2048, nullptr, scr, r, lane); continue; } r -= I2;
            if (r < I3) { p0_transpose_item(args.in[14], 512, 0, 512, 16, (bf16*)(ws + WS_WGLU), 0, nullptr, scr, r, lane); continue; } r -= I3;
            if (r < I4) { p0_transpose_item(args.in[16], 1024, 0, 512, 32, (bf16*)(ws + WS_WSSM), 0, nullptr, scr, r, lane); continue; } r -= I4;
            if (r < I5) { p0_transpose_item(args.in[17], 1024, 0, 256, 32, (bf16*)(ws + WS_WATT), 0, nullptr, scr, r, lane); continue; } r -= I5;
            if (r < I6) { p0_transpose_item(args.in[18], 1024, 0, 1024, 32, (bf16*)(ws + WS_WMKV), 0, nullptr, scr, r, lane); continue; } r -= I6;
            if (r < I7) { p0_transpose_item(args.in[19], 1024, 0, 512, 32, (bf16*)(ws + WS_WMEM), 0, nullptr, scr, r, lane); continue; } r -= I7;
            if (r < I8) { p0_transpose_item(args.in[20], 1024, 0, 1024, 32, (bf16*)(ws + WS_WO), 0, nullptr, scr, r, lane); continue; } r -= I8;
            if (r < I9) { p0_transpose_item(args.in[22], 4096, 0, 1024, 128, (bf16*)(ws + WS_WUP), 0, args.in[21], scr, r, lane); continue; } r -= I9;
            p0_transpose_item(args.in[23], 1024, 0, 4096, 32, (bf16*)(ws + WS_WDN), 0, nullptr, scr, r, lane);
        }
        for (int m = gw * 4; m < M; m += NGW * 4) rms_rows_to_bf16<4>(args.in[0] + (size_t)m * D, (size_t)D, args.in[2], (bf16*)(ws + WS_XN) + (size_t)m * D, lane, (float*)(ws + WS_XS) + m);
        for (int m = gw; m < 2048; m += NGW) rms_rows_to_bf16<1>(args.in[1] + (size_t)m * D, (size_t)D, args.in[3], (bf16*)(ws + WS_MEMN) + (size_t)m * D, lane, nullptr);
        { const int i = bx * 512 + tid;
          if (i < 2048) { const int g = i >> 6, p = i & 63;
            const double lr = (double)args.in[6][i], li = (double)args.in[7][i], dt = exp((double)args.in[8][g]);
            const double mag = exp(lr * dt); double sn, cs; sincos_d(li * dt, sn, cs);
            const double ar = mag * cs, aim = mag * sn, nr = ar - 1.0, ni = aim, den = lr * lr + li * li;
            const double cr = (nr * lr + ni * li) / den, ci = (ni * lr - nr * li) / den;
            double pr = ar, pi = aim;
#pragma unroll 1
            for (int k = 0; k < 7; ++k) { const double t = pr * pr - pi * pi; pi = 2.0 * pr * pi; pr = t; }
            *(f32x4*)(ws + WS_SSMA + (size_t)i * 16) = (f32x4){(float)ar, (float)aim, (float)pr, (float)pi};
            const int nt0 = (p >> 5) * 2, cc = p & 31;
            bf16* BM_ = (bf16*)(ws + WS_SSMB); bf16* CM_ = (bf16*)(ws + WS_SSMC);
#pragma unroll 1
            for (int h = 0; h < 16; ++h) { const double br = (double)args.in[9][(size_t)i * 16 + h], bi = (double)args.in[10][(size_t)i * 16 + h];
                const float bbr = (float)(cr * br - ci * bi), bbi = (float)(cr * bi + ci * br);
                BM_[((size_t)(g * 4 + nt0) * 32 + cc) * 16 + h] = (bf16)(cvtpk(bbr, 0.f) & 0xffffu);
                BM_[((size_t)(g * 4 + nt0 + 1) * 32 + cc) * 16 + h] = (bf16)(cvtpk(bbi, 0.f) & 0xffffu);
                const float c_r = args.in[11][((size_t)g * 16 + h) * 64 + p], c_i = args.in[12][((size_t)g * 16 + h) * 64 + p];
                CM_[((size_t)g * 16 + h) * 128 + 2 * p] = (bf16)(cvtpk(c_r, 0.f) & 0xffffu);
                CM_[((size_t)g * 16 + h) * 128 + 2 * p + 1] = (bf16)(cvtpk(-c_i, 0.f) & 0xffffu); }
          } }
    }
    SEAM(0);

    if (IN(1)) {
        __syncthreads();
        {
            pg8::Gemm g{(const bf16*)(ws + WS_MEMN), (const bf16*)(ws + WS_WMKV), 2048, 512, 1024, 1024, 1024, 0}; pg8::StaticOrder S; S.init(2048, 512, G, bx);
            pg8::EpiMKf E{(bf16*)(ws + WS_MK)}; pg8::gemm_phase(lds, g, S, E); }
        {
            pg8::Gemm g{(const bf16*)(ws + WS_WMKV) + (size_t)512 * 1024, (const bf16*)(ws + WS_MEMN), 512, 2048, 1024, 1024, 1024, 0}; pg8::StaticOrder S; S.init(512, 2048, G, (bx + G - 16) % G);
            pg8::EpiVTf E{(bf16*)(ws + WS_MVT), 1, 0}; pg8::gemm_phase(lds, g, S, E); }
        {
            pg8::Gemm g{(const bf16*)(ws + WS_XN), (const bf16*)(ws + WS_WIN), M, NIN, 1024, 1024, 1024, 0}; pg8::StaticOrder S; S.init(M, NIN, G, bx);
            pg8::EpiInProj E{(bf16*)(ws + WS_U), (bf16*)(ws + WS_Q), (bf16*)(ws + WS_K), (bf16*)(ws + WS_MQ), (bf16*)(ws + WS_GATES), args.in[5]}; pg8::gemm_phase(lds, g, S, E); }
#pragma unroll 1
        for (int gi = 0; gi < 3; ++gi) {
            const int d = 1 << (2 * gi);
            pg8::Gemm g{(const bf16*)(ws + WS_WV) + (size_t)gi * 256 * 1024, (const bf16*)(ws + WS_XN), 256, M, 1024, 1024, d * 1024, d}; pg8::StaticOrder S; S.init(256, M, G, bx);
            pg8::EpiVTf E{(bf16*)(ws + WS_VT), 0, gi}; pg8::gemm_phase(lds, g, S, E); }
    }
    SEAM(1);

    if (IN(2)) {
        for (int rep = 0; rep < PROBE_REP; ++rep)
        for (int it = gw; it < 12288; it += NGW) {
            const int qb = it & 127, rest = it >> 7, hh = rest & 3, b = (rest >> 2) & 7, g = rest >> 5;
            const int sh = 2 * g, d = 1 << sh, Ld = 8192 >> sh; const int pp0 = qb * 64, r = pp0 / Ld, j0 = pp0 % Ld;
            const size_t hb = ((size_t)(g * 8 + b) * 4 + hh) * 8192;
            const bf16* Qp = (const bf16*)(ws + WS_Q) + (hb + pp0) * 64;
            const bf16* Kt = (const bf16*)(ws + WS_K) + (hb + (size_t)r * Ld) * 64;
            const bf16* Vt = (const bf16*)(ws + WS_VT) + (hb + (size_t)r * Ld) * 64;
            f32x16 O[2][2]; float mr[2], l[2];
            sattn_wave(Qp, Kt, Vt, j0, lane, O, mr, l);
            const int c = lane & 31, hi = lane >> 5;
#pragma unroll
            for (int q = 0; q < 2; ++q) { const float inv = 1.f / l[q];
                const size_t tok = (size_t)b * 8192 + (size_t)(j0 + 32 * q + c) * d + r;
                bf16* og = (bf16*)(ws + WS_OG) + tok * 768 + g * 256 + hh * 64;
#pragma unroll
                for (int t = 0; t < 2; ++t)
#pragma unroll
                    for (int a = 0; a < 4; ++a) { v2u w; w.x = cvtpk(O[q][t][4 * a] * inv, O[q][t][4 * a + 1] * inv); w.y = cvtpk(O[q][t][4 * a + 2] * inv, O[q][t][4 * a + 3] * inv);
                        *(v2u*)(og + 32 * t + 8 * a + 4 * hi) = w; }
                if (hi == 0) ((float*)(ws + WS_LSE))[tok * 12 + g * 4 + hh] = mr[q] * 0.125f + __logf(l[q]); }
        }
        for (int it = gw; it < 8192; it += NGW) {
            const int qb = it & 255, h = (it >> 8) & 3, b = it >> 10;
            bf16* Qp = (bf16*)(ws + WS_MQ) + ((size_t)b * 8192 + qb * 32) * 512 + h * 128;
            const bf16* Kt = (const bf16*)(ws + WS_MK) + (size_t)(b * 4 + h) * 8 * 4096;
            const bf16* Vt = (const bf16*)(ws + WS_MVT) + (size_t)(b * 4 + h) * 8 * 4096;
            f32x16 O[4]; float mr, l;
            attn_wave<128, false>(Qp, 512, Kt, Vt, 0, 7, 0, lane, O, mr, l);
            const int c = lane & 31, hi = lane >> 5; const float inv = 1.f / l;
            bf16* om = Qp + (size_t)c * 512;
#pragma unroll
            for (int t = 0; t < 4; ++t)
#pragma unroll
                for (int a = 0; a < 4; ++a) { v2u w; w.x = cvtpk(O[t][4 * a] * inv, O[t][4 * a + 1] * inv); w.y = cvtpk(O[t][4 * a + 2] * inv, O[t][4 * a + 3] * inv);
                    *(v2u*)(om + 32 * t + 8 * a + 4 * hi) = w; }
        }
        for (int rep = 0; rep < PROBE_REP; ++rep)
        for (int it = gw; it < 8192; it += NGW) { const int sp = it & 31, g = (it >> 5) & 31, b = it >> 10; ssm_wave<false>(ws, args.in[13], b, g, 2 * sp, 1, 1, lds + wave * 16384, lane); }
    }
    SEAM(2);

    if (IN(3)) {
        for (int rep = 0; rep < PROBE_P3; ++rep)
        for (int it = gw; it < 2048; it += NGW) { const int qd = it & 7, g = (it >> 3) & 31, b = it >> 8;
            ssm_wave<true>(ws, args.in[13], b, g, 8 * qd, 4, 4, lds + wave * 16384, lane); }
        for (int m2 = gw; m2 < M / 2; m2 += NGW) { const size_t tok = (size_t)m2 * 2 + (lane >> 5); const int cc = (lane & 31) * 8, hh = cc >> 6;
            const float* ls = (const float*)(ws + WS_LSE) + tok * 12 + hh; const float l0 = ls[0], l1 = ls[4], l2 = ls[8];
            const float mx = fmaxf(l0, fmaxf(l1, l2)); const float e0 = __expf(l0 - mx), e1 = __expf(l1 - mx), e2 = __expf(l2 - mx); const float inv = 1.f / (e0 + e1 + e2);
            const bf16* og = (const bf16*)(ws + WS_OG) + tok * 768 + cc;
            pg8::f32x4 a0, a1, b0, b1, c0, c1; pg8::unpack8(*(const v4u*)og, a0, a1); pg8::unpack8(*(const v4u*)(og + 256), b0, b1); pg8::unpack8(*(const v4u*)(og + 512), c0, c1);
            const float w0 = e0 * inv, w1 = e1 * inv, w2 = e2 * inv;
            const pg8::f32x4 r0 = a0 * w0 + b0 * w1 + c0 * w2, r1 = a1 * w0 + b1 * w1 + c1 * w2;
            *(v4u*)((bf16*)(ws + WS_OMRG) + tok * 256 + cc) = pg8::pack8(r0, r1); }
    }
    SEAM(3);

    if (IN(4)) {
        __syncthreads();
        pg8::Gemm g{(const bf16*)(ws + WS_YG), (const bf16*)(ws + WS_WGLU), M, 512, 512, 512, 512, 0}; pg8::StaticOrder S; S.init(M, 512, G, bx);
        pg8::EpiGlu E{(const bf16*)(ws + WS_YG), (bf16*)(ws + WS_Y2), args.in[15]}; pg8::gemm_phase(lds, g, S, E);
    }
    SEAM(4);

    if (IN(5)) {
        __syncthreads();
        pg8::StaticOrder S; S.init(M, 1024, G, bx);
        { pg8::Gemm g{(const bf16*)(ws + WS_Y2), (const bf16*)(ws + WS_WSSM), M, 1024, 512, 512, 512, 0};
          pg8::EpiBranch<0> E{(const bf16*)(ws + WS_GATES), (bf16*)(ws + WS_MG), 0}; pg8::gemm_phase(lds, g, S, E); }
        { pg8::Gemm g{(const bf16*)(ws + WS_OMRG), (const bf16*)(ws + WS_WATT), M, 1024, 256, 256, 256, 0};
          pg8::EpiBranch<1> E{(const bf16*)(ws + WS_GATES), (bf16*)(ws + WS_MG), 1024}; pg8::gemm_phase(lds, g, S, E); }
        { pg8::Gemm g{(const bf16*)(ws + WS_MQ), (const bf16*)(ws + WS_WMEM), M, 1024, 512, 512, 512, 0};
          pg8::EpiBranch<1> E{(const bf16*)(ws + WS_GATES), (bf16*)(ws + WS_MG), 2048}; pg8::gemm_phase(lds, g, S, E); }
    }
    SEAM(5);

    if (IN(6)) {
        __syncthreads();
        pg8::Gemm g{(const bf16*)(ws + WS_MG), (const bf16*)(ws + WS_WO), M, 1024, 1024, 1024, 1024, 0}; pg8::StaticOrder S; S.init(M, 1024, G, bx);
        pg8::EpiResid<0> E{(const bf16*)(ws + WS_XN), (const float*)(ws + WS_XS), args.in[2], (bf16*)(ws + WS_HB), (float*)(ws + WS_SSP1)}; pg8::gemm_phase(lds, g, S, E);
    }
    SEAM(6);

    if (IN(7)) {
        __syncthreads();
        pg8::Gemm g{(const bf16*)(ws + WS_HB), (const bf16*)(ws + WS_WUP), M, FF, 1024, 1024, 1024, 0}; pg8::StaticOrder S; S.init(M, FF, G, bx);
        pg8::EpiUp E{(const float*)(ws + WS_SSP1), (bf16*)(ws + WS_ACT)};
        pg8::gemm_phase(lds, g, S, E);
        if (PROBE_G7 > 1) pg8::gemm_phase(lds, g, S, E);
    }
    SEAM(7);

    if (IN(8)) {
        __syncthreads();
        pg8::Gemm g{(const bf16*)(ws + WS_ACT), (const bf16*)(ws + WS_WDN), M, 1024, FF, FF, FF, 0}; pg8::StaticOrder S; S.init(M, 1024, G, bx, 1);
        pg8::EpiResid<1> E{nullptr, nullptr, nullptr, (bf16*)(ws + WS_HB), (float*)(ws + WS_SSP2)}; pg8::gemm_phase(lds, g, S, E);
    }
    SEAM(8);

    if (IN(9)) {
        const f32x4* gr = (const f32x4*)args.in[24];
        const int c8a = lane * 8, c8b = (lane + 64) * 8;
        const f32x4 ga0 = gr[c8a / 4], ga1 = gr[c8a / 4 + 1], gb0 = gr[c8b / 4], gb1 = gr[c8b / 4 + 1];
        for (int m = gw * 4; m < M; m += NGW * 4) {
            float pv[4]; v4u ha[4], hb4[4];
#pragma unroll
            for (int r = 0; r < 4; ++r) { pv[r] = (lane < 16) ? ((const float*)(ws + WS_SSP2))[(size_t)(m + r) * 16 + lane] : 0.f;
                const bf16* hr = (const bf16*)(ws + WS_HB) + (size_t)(m + r) * D; ha[r] = *(const v4u*)(hr + c8a); hb4[r] = *(const v4u*)(hr + c8b); }
#pragma unroll
            for (int r = 0; r < 4; ++r) { const float rs = 1.0f / sqrtf(wave_sum(pv[r]) * (1.f / 1024.f) + 1e-6f);
                f32x4* xr = (f32x4*)(args.out + (size_t)(m + r) * D); pg8::f32x4 v0, v1;
                pg8::unpack8(ha[r], v0, v1); xr[c8a / 4] = v0 * rs * ga0; xr[c8a / 4 + 1] = v1 * rs * ga1;
                pg8::unpack8(hb4[r], v0, v1); xr[c8b / 4] = v0 * rs * gb0; xr[c8b / 4 + 1] = v1 * rs * gb1; } }
    }
#undef IN
#undef SEAM
}

#ifndef DBG_PH
#define DBG_PH 0
#endif
struct DumpSeg { size_t off; unsigned n; unsigned pad; };
struct DumpArgs { float* out; const unsigned char* ws; DumpSeg s[6]; };
__global__ void dbg_dump(DumpArgs a) {
    size_t base = 0;
    float mag = 1e12f;
    for (int k = 0; k < 6; ++k, mag *= 0.1f) { const unsigned short* src = (const unsigned short*)(a.ws + a.s[k].off);
        for (size_t i = (size_t)blockIdx.x * blockDim.x + threadIdx.x; i < a.s[k].n; i += (size_t)gridDim.x * blockDim.x) a.out[base + i] = ((src[i] & 0x7f80u) == 0x7f80u) ? mag : 0.f;
        base += a.s[k].n; }
    for (size_t i = base + (size_t)blockIdx.x * blockDim.x + threadIdx.x; i < (size_t)M * D; i += (size_t)gridDim.x * blockDim.x) a.out[i] = 0.f;
}
extern "C" void kernel_launch(void* const* d_in, const int* in_sizes, int n_in, void* d_out, int out_size, void* d_ws, size_t ws_size, hipStream_t stream) {
    static int grid = 0;
    if (grid == 0) {
        if (n_in != 25 || out_size != M * D || ws_size < WS_END) { fprintf(stderr, "kernel_launch: unexpected shapes (n_in %d out %d ws %zu)\n", n_in, out_size, ws_size); grid = -1; return; }
        int dev = 0, cus = 0, per_cu = 0;
        if (hipGetDevice(&dev) != hipSuccess || hipDeviceGetAttribute(&cus, hipDeviceAttributeMultiprocessorCount, dev) != hipSuccess) { grid = -1; return; }
        if (hipOccupancyMaxActiveBlocksPerMultiprocessor(&per_cu, (const void*)fwd_megakernel, NWAVES * 64, 0) != hipSuccess || per_cu < 1) { fprintf(stderr, "kernel_launch: occupancy query says %d\n", per_cu); per_cu = 1; }
        (void)hipGetLastError();
        grid = cus;
    }
    if (grid < 0) return;
    Args a{};
    for (int i = 0; i < 25; ++i) a.in[i] = (const float*)d_in[i];
    a.out = (float*)d_out; a.ws = (unsigned char*)d_ws;
#if MK_N_LAUNCHES == 1
    if (hipMemsetAsync(d_ws, 0, 65536, stream) != hipSuccess) { fprintf(stderr, "kernel_launch: memset of the barrier words failed\n"); return; }
    a.ph_lo = 0; a.ph_hi = N_PHASES;
    void* kargs[] = {&a};
    hipError_t e = hipLaunchCooperativeKernel((const void*)fwd_megakernel, dim3(grid), dim3(NWAVES * 64), kargs, 0, stream);
    if (e != hipSuccess) fprintf(stderr, "kernel_launch: cooperative launch failed: %s (grid %d)\n", hipGetErrorString(e), grid);
#else
    const int np = DBG_PH ? DBG_PH + 1 : N_PHASES;
    for (int p = 0; p < np; ++p) { a.ph_lo = p; a.ph_hi = p + 1; hipLaunchKernelGGL(fwd_megakernel, dim3(grid), dim3(NWAVES * 64), 0, stream, a); }
#if DBG_PH && DBG_PH < 8
    { DumpArgs da{}; da.out = (float*)d_out; da.ws = (const unsigned char*)d_ws;
      DBG_SEGS
      hipLaunchKernelGGL(dbg_dump, dim3(2048), dim3(256), 0, stream, da); }
#endif
#endif
}
```

```cpp
#include <hip/hip_runtime.h>
#include <hip/hip_cooperative_groups.h>
#include <cstdio>
#include <cstdint>
namespace cg = cooperative_groups;

#define DBG_PH 0
#define DBG_SEGS da.s[0] = {WS_GATES, 12u << 20, 0}; da.s[1] = {WS_OG, 12u << 20, 0}; da.s[2] = {WS_MQ, 12u << 20, 0}; da.s[3] = {WS_YG, 8u << 20, 0}; da.s[4] = {WS_OMRG, 8u << 20, 0}; da.s[5] = {WS_MG, 12u << 20, 0};
#ifndef PROBE_G7
#define PROBE_G7 1
#endif
#ifndef PROBE_REP
#define PROBE_REP 1
#define PROBE_P3 1
#endif
#ifndef MK_N_LAUNCHES
#define MK_N_LAUNCHES 1
#endif

namespace pg8 {
#define PG8_LAS __attribute__((address_space(3)))
typedef unsigned short bf16_t;
typedef short bf16x8 __attribute__((ext_vector_type(8)));
typedef float f32x4 __attribute__((ext_vector_type(4)));
typedef unsigned u32x4 __attribute__((ext_vector_type(4)));
constexpr int BM = 256, BK = 64, HALF = 128, HTB = HALF * BK * 2, STAGE_BYTES = 8 * HTB, NXCD = 8, WGM = 8;

__host__ __device__ __forceinline__ int lds_byte(int r, int c) { const int st = (r >> 4) * 2 + (c >> 5), rr = r & 15, cc = c & 31, ob = rr * 64 + cc * 2; return st * 1024 + (ob ^ (((ob >> 9) & 1) << 5)); }
__host__ __device__ __forceinline__ void stage_rc(int b, int& R, int& C) { const int st = b / 1024, sb = b % 1024, swz = sb ^ (((sb >> 9) & 1) << 5); R = (st >> 1) * 16 + swz / 64; C = (st & 1) * 32 + (swz % 64) / 2; }
__host__ __device__ __forceinline__ int perm32(int rho) { const int n = rho >> 4, i = rho & 15; return 8 * (i >> 2) + 4 * n + (i & 3); }

struct Unit { int pm, pn; };
struct Gemm { const bf16_t* A; const bf16_t* Bt; int M, N, K; int lda, ldb; int bdil; };
__device__ __forceinline__ const char* a_tile(const Gemm& g, int pm) { return (const char*)g.A + (size_t)pm * 256 * (size_t)g.lda * 2; }
__device__ __forceinline__ const char* b_tile(const Gemm& g, int pn) {
    if (g.bdil == 0) return (const char*)g.Bt + (size_t)pn * 256 * (size_t)g.ldb * 2;
    const int d = g.bdil, Ld = 8192 / d, b = pn >> 5, pp0 = (pn & 31) * 256, r = pp0 / Ld, j0 = pp0 % Ld;
    return (const char*)g.Bt + ((size_t)b * 8192 + (size_t)j0 * d + r) * 1024 * 2;
}

struct StaticOrder {
    int nM, nN, nwg, G, c, rev;
    __host__ __device__ void init(int M, int N, int G_, int c_, int rev_ = 0) { nM = M / BM; nN = N / BM; nwg = nM * nN; G = G_; c = c_; rev = rev_; }
    __host__ __device__ bool next(int i, Unit& u) const {
        const long L = (long)i * G + c; if (L >= nwg) return false;
        int wgid = (int)L; { const int q = nwg / NXCD, r = nwg % NXCD, xcd = wgid % NXCD, off = wgid / NXCD; wgid = (xcd < r ? xcd * (q + 1) : r * (q + 1) + (xcd - r) * q) + off; }
        const int nig = WGM * nN, gid = wgid / nig, fm = gid * WGM, gsz = (nM - fm) < WGM ? (nM - fm) : WGM;
        u.pm = fm + ((wgid % nig) % gsz); u.pn = (wgid % nig) / gsz; if (rev) u.pm = nM - 1 - u.pm; return true;
    }
};

typedef float f32x2_ __attribute__((ext_vector_type(2))); typedef __bf16 bf16x2_ __attribute__((ext_vector_type(2)));
__device__ __forceinline__ unsigned cvt_pk_bf16(float lo, float hi) { f32x2_ v = {lo, hi}; bf16x2_ b = __builtin_convertvector(v, bf16x2_); return __builtin_bit_cast(unsigned, b); }
__device__ __forceinline__ float bf_lo(unsigned w) { return __builtin_bit_cast(float, w << 16); }
__device__ __forceinline__ float bf_hi(unsigned w) { return __builtin_bit_cast(float, w & 0xffff0000u); }
__device__ __forceinline__ u32x4 pack8(const f32x4 v0, const f32x4 v1) { u32x4 w; w.x = cvt_pk_bf16(v0[0], v0[1]); w.y = cvt_pk_bf16(v0[2], v0[3]); w.z = cvt_pk_bf16(v1[0], v1[1]); w.w = cvt_pk_bf16(v1[2], v1[3]); return w; }
__device__ __forceinline__ void unpack8(const u32x4 w, f32x4& v0, f32x4& v1) { v0 = (f32x4){bf_lo(w.x), bf_hi(w.x), bf_lo(w.y), bf_hi(w.y)}; v1 = (f32x4){bf_lo(w.z), bf_hi(w.z), bf_lo(w.w), bf_hi(w.w)}; }
typedef unsigned u32x2 __attribute__((ext_vector_type(2)));
__device__ __forceinline__ unsigned q8x4(const f32x4 v) {
    unsigned r = 0u;
    r = __builtin_amdgcn_cvt_pk_u8_f32(__builtin_rintf(v[0] * 255.f), 0, r); r = __builtin_amdgcn_cvt_pk_u8_f32(__builtin_rintf(v[1] * 255.f), 1, r);
    r = __builtin_amdgcn_cvt_pk_u8_f32(__builtin_rintf(v[2] * 255.f), 2, r); r = __builtin_amdgcn_cvt_pk_u8_f32(__builtin_rintf(v[3] * 255.f), 3, r); return r; }
__device__ __forceinline__ f32x4 dq8x4(unsigned w) { const float k = 1.f / 255.f;
    return (f32x4){(float)(w & 0xffu) * k, (float)((w >> 8) & 0xffu) * k, (float)((w >> 16) & 0xffu) * k, (float)(w >> 24) * k}; }
__device__ __forceinline__ float sigm(float x) { return __builtin_amdgcn_rcpf(1.f + __builtin_amdgcn_exp2f(-1.4426950408889634f * x)); }

#define EPI_LOOP _Pragma("unroll") for (int ai = 0; ai < 2; ++ai) _Pragma("unroll") for (int m = 0; m < 4; ++m) _Pragma("unroll") for (int bj = 0; bj < 2; ++bj)
#define EPI_ROW (u.pm * 256 + ai * 128 + wr * 64 + m * 16 + fr)
#define EPI_COL (u.pn * 256 + bj * 128 + wc * 32 + 8 * fq)
typedef f32x4 AccT[2][2][4][2];

struct EpiPlain {
    bf16_t* O; size_t ldc;
    __device__ __forceinline__ void operator()(const AccT& acc, const Unit& u, int wr, int wc, int fr, int fq) const {
        EPI_LOOP { const int row = EPI_ROW, col = EPI_COL; *(u32x4*)(O + (size_t)row * ldc + col) = pack8(acc[ai][bj][m][0], acc[ai][bj][m][1]); }
    }
};
struct EpiVTf {
    bf16_t* O; int mem; int g;
    __device__ __forceinline__ void operator()(const AccT& acc, const Unit& u, int wr, int wc, int fr, int fq) const {
        EPI_LOOP { const int row = EPI_ROW, col = EPI_COL;
            int e, kk; size_t tb;
            if (mem) { const int h = row >> 7, b = col >> 8; e = row & 127; kk = col & 255; tb = ((size_t)((b * 4 + h) * 8 + (kk >> 5))) * 4096; }
            else { const int hh = row >> 6, b = col >> 13; e = row & 63; kk = col & 8191; tb = (((size_t)(g * 8 + b) * 4 + hh) * 8192) * 64 + (size_t)(kk >> 5) * 2048; }
            const int t = e >> 5, c = e & 31, k0 = kk & 31, s2 = k0 >> 4, half = (k0 >> 3) & 1;
            bf16_t* d0 = O + tb + (((t * 2 + s2) * 2 + 0) * 32 + c) * 8 + half * 4;
            const f32x4 v0 = acc[ai][bj][m][0], v1 = acc[ai][bj][m][1];
            typedef unsigned u32x2 __attribute__((ext_vector_type(2)));
            u32x2 w0, w1; w0.x = cvt_pk_bf16(v0[0], v0[1]); w0.y = cvt_pk_bf16(v0[2], v0[3]); w1.x = cvt_pk_bf16(v1[0], v1[1]); w1.y = cvt_pk_bf16(v1[2], v1[3]);
            *(u32x2*)d0 = w0; *(u32x2*)(d0 + 256) = w1; }
    }
};
struct EpiMKf {
    bf16_t* O;
    __device__ __forceinline__ void operator()(const AccT& acc, const Unit& u, int wr, int wc, int fr, int fq) const {
        EPI_LOOP { const int row = EPI_ROW, col = EPI_COL; const int b = row >> 8, key = row & 255, h = col >> 7, e = col & 127;
            *(u32x4*)(O + ((size_t)((b * 4 + h) * 8 + (key >> 5))) * 4096 + (((e >> 4) * 2 + ((e >> 3) & 1)) * 32 + (key & 31)) * 8) = pack8(acc[ai][bj][m][0], acc[ai][bj][m][1]); }
    }
};
struct EpiInProj {
    bf16_t *U, *Q, *Kb, *MQ, *GATES; const float* b_gate;
    __device__ __forceinline__ void operator()(const AccT& acc, const Unit& u, int wr, int wc, int fr, int fq) const {
        const int pn = u.pn;
        if (pn < 2) { EPI_LOOP { const int row = EPI_ROW, col = EPI_COL; *(u32x4*)(U + (size_t)row * 512 + col) = pack8(acc[ai][bj][m][0], acc[ai][bj][m][1]); } }
        else if (pn < 8) {
            const int g = (pn < 5) ? pn - 2 : pn - 5; bf16_t* base = (pn < 5) ? Q : Kb; const int sh = 2 * g  , Ld = 8192 >> sh, dm = (1 << sh) - 1;
            const bool isk = (pn >= 5);
            EPI_LOOP { const int row = EPI_ROW, colw = bj * 128 + wc * 32 + 8 * fq; const int hh = colw >> 6, e = colw & 63, b = row >> 13, t = row & 8191;
                const int pp = (t & dm) * Ld + (t >> sh);
                const size_t hbase = (((size_t)(g * 8 + b) * 4 + hh) * 8192) * 64;
                const size_t off = isk ? hbase + (size_t)(pp >> 5) * 2048 + ((((e >> 4) * 2 + ((e >> 3) & 1)) * 32 + (pp & 31)) * 8) : hbase + (size_t)pp * 64 + e;
                *(u32x4*)(base + off) = pack8(acc[ai][bj][m][0], acc[ai][bj][m][1]); }
        }
        else if (pn < 10) { EPI_LOOP { const int row = EPI_ROW, col = EPI_COL - 2048; *(u32x4*)(MQ + (size_t)row * 512 + col) = pack8(acc[ai][bj][m][0], acc[ai][bj][m][1]); } }
        else {
            f32x4 bb0[2], bb1[2];
#pragma unroll
            for (int bj = 0; bj < 2; ++bj) { const int col = EPI_COL - 2560; bb0[bj] = *(const f32x4*)(b_gate + col); bb1[bj] = *(const f32x4*)(b_gate + col + 4); }
            EPI_LOOP { const int row = EPI_ROW, col = EPI_COL - 2560;
                f32x4 v0 = acc[ai][bj][m][0] + bb0[bj], v1 = acc[ai][bj][m][1] + bb1[bj];
#pragma unroll
                for (int i = 0; i < 4; ++i) { v0[i] = sigm(v0[i]); v1[i] = sigm(v1[i]); }
                u32x2 w; w.x = q8x4(v0); w.y = q8x4(v1);
                *(u32x2*)((unsigned char*)GATES + (size_t)row * 3072 + col) = w; }
        }
    }
};
struct EpiGlu {
    const bf16_t* YG; bf16_t* Y2; const float* b;
    __device__ __forceinline__ void operator()(const AccT& acc, const Unit& u, int wr, int wc, int fr, int fq) const {
        f32x4 bb0[2], bb1[2];
#pragma unroll
        for (int bj = 0; bj < 2; ++bj) { const int col = EPI_COL; bb0[bj] = *(const f32x4*)(b + col); bb1[bj] = *(const f32x4*)(b + col + 4); }
#pragma unroll
        for (int ai = 0; ai < 2; ++ai) {
            u32x4 yv[4][2];
#pragma unroll
            for (int m = 0; m < 4; ++m)
#pragma unroll
                for (int bj = 0; bj < 2; ++bj) { const int row = EPI_ROW, col = EPI_COL; yv[m][bj] = *(const u32x4*)(YG + (size_t)row * 512 + col); }
#pragma unroll
            for (int m = 0; m < 4; ++m)
#pragma unroll
                for (int bj = 0; bj < 2; ++bj) { const int row = EPI_ROW, col = EPI_COL;
                    f32x4 y0, y1; unpack8(yv[m][bj], y0, y1);
                    f32x4 v0 = acc[ai][bj][m][0] + bb0[bj], v1 = acc[ai][bj][m][1] + bb1[bj];
#pragma unroll
                    for (int i = 0; i < 4; ++i) { v0[i] = y0[i] * sigm(v0[i]); v1[i] = y1[i] * sigm(v1[i]); }
                    *(u32x4*)(Y2 + (size_t)row * 512 + col) = pack8(v0, v1); }
        }
    }
};
template <int MODE> struct EpiBranch {
    const bf16_t* GATES; bf16_t* MG; int goff;
    __device__ __forceinline__ void operator()(const AccT& acc, const Unit& u, int wr, int wc, int fr, int fq) const {
#pragma unroll
        for (int ai = 0; ai < 2; ++ai) {
            u32x2 gv[4][2]; u32x4 pv[4][2];
#pragma unroll
            for (int m = 0; m < 4; ++m)
#pragma unroll
                for (int bj = 0; bj < 2; ++bj) { const int row = EPI_ROW, col = EPI_COL; gv[m][bj] = *(const u32x2*)((const unsigned char*)GATES + (size_t)row * 3072 + goff + col);
                    if (MODE == 1) pv[m][bj] = *(const u32x4*)(MG + (size_t)row * 1024 + col); }
#pragma unroll
            for (int m = 0; m < 4; ++m)
#pragma unroll
                for (int bj = 0; bj < 2; ++bj) { const int row = EPI_ROW, col = EPI_COL; const f32x4 g0 = dq8x4(gv[m][bj].x), g1 = dq8x4(gv[m][bj].y);
                    f32x4 v0 = acc[ai][bj][m][0] * g0, v1 = acc[ai][bj][m][1] * g1;
                    if (MODE == 1) { f32x4 p0, p1; unpack8(pv[m][bj], p0, p1); v0 += p0; v1 += p1; }
                    *(u32x4*)(MG + (size_t)row * 1024 + col) = pack8(v0, v1); }
        }
    }
};
template <int MODE> struct EpiResid {
    const bf16_t* XN; const float* XS; const float* G1; bf16_t* HB; float* SS;
    __device__ __forceinline__ void operator()(const AccT& acc, const Unit& u, int wr, int wc, int fr, int fq) const {
        f32x4 ig0[2], ig1[2];
        if (MODE == 0) {
#pragma unroll
            for (int bj = 0; bj < 2; ++bj) { const int col = EPI_COL; const f32x4 a = *(const f32x4*)(G1 + col), b = *(const f32x4*)(G1 + col + 4);
#pragma unroll
                for (int i = 0; i < 4; ++i) { ig0[bj][i] = 1.0f / a[i]; ig1[bj][i] = 1.0f / b[i]; } }
        }
#pragma unroll
        for (int ai = 0; ai < 2; ++ai) {
            u32x4 hv[4][2]; float xs[4];
#pragma unroll
            for (int m = 0; m < 4; ++m) { const int row = EPI_ROW; if (MODE == 0) xs[m] = XS[row];
#pragma unroll
                for (int bj = 0; bj < 2; ++bj) { const int col = EPI_COL; const size_t o = (size_t)row * 1024 + col;
                    hv[m][bj] = *(const u32x4*)((MODE == 0 ? XN : HB) + o); } }
#pragma unroll
            for (int m = 0; m < 4; ++m) { const int row = EPI_ROW; float ss = 0.f;
#pragma unroll
                for (int bj = 0; bj < 2; ++bj) { const int col = EPI_COL; const size_t o = (size_t)row * 1024 + col;
                    f32x4 r0, r1; unpack8(hv[m][bj], r0, r1);
                    if (MODE == 0) { r0 = r0 * xs[m] * ig0[bj]; r1 = r1 * xs[m] * ig1[bj]; }
                    const f32x4 v0 = acc[ai][bj][m][0] + r0, v1 = acc[ai][bj][m][1] + r1;
                    *(u32x4*)(HB + o) = pack8(v0, v1);
                    ss += (v0[0] * v0[0] + v0[1] * v0[1]) + (v0[2] * v0[2] + v0[3] * v0[3]) + (v1[0] * v1[0] + v1[1] * v1[1]) + (v1[2] * v1[2] + v1[3] * v1[3]); }
                ss += __shfl_xor(ss, 16); ss += __shfl_xor(ss, 32);
                if (fq == 0) SS[(size_t)row * 16 + u.pn * 4 + wc] = ss; }
        }
    }
};
struct EpiUp {
    const float* SS; bf16_t* ACT;
    __device__ __forceinline__ void operator()(const AccT& acc, const Unit& u, int wr, int wc, int fr, int fq) const {
        float rsv[2][4];
#pragma unroll
        for (int ai = 0; ai < 2; ++ai) { f32x4 q[4][4];
#pragma unroll
            for (int m = 0; m < 4; ++m) { const int row = EPI_ROW; const f32x4* sp = (const f32x4*)(SS + (size_t)row * 16);
#pragma unroll
                for (int k = 0; k < 4; ++k) q[m][k] = sp[k]; }
#pragma unroll
            for (int m = 0; m < 4; ++m) { const float tot = ((q[m][0][0] + q[m][0][1]) + (q[m][0][2] + q[m][0][3])) + ((q[m][1][0] + q[m][1][1]) + (q[m][1][2] + q[m][1][3])) + ((q[m][2][0] + q[m][2][1]) + (q[m][2][2] + q[m][2][3])) + ((q[m][3][0] + q[m][3][1]) + (q[m][3][2] + q[m][3][3]));
                rsv[ai][m] = 1.0f / sqrtf(tot * (1.f / 1024.f) + 1e-6f); } }
#pragma unroll
        for (int ai = 0; ai < 2; ++ai)
#pragma unroll
            for (int m = 0; m < 4; ++m) { const int row = EPI_ROW; const float rs = rsv[ai][m];
#pragma unroll
                for (int bj = 0; bj < 2; ++bj) { const int col = EPI_COL; f32x4 v0 = acc[ai][bj][m][0] * rs, v1 = acc[ai][bj][m][1] * rs;
#pragma unroll
                    for (int i = 0; i < 4; ++i) { const float a = fmaxf(v0[i], 0.f), b = fmaxf(v1[i], 0.f); v0[i] = a * a; v1[i] = b * b; }
                    *(u32x4*)(ACT + (size_t)row * 4096 + col) = pack8(v0, v1); } }
    }
};

template <class Epi>
__device__ __forceinline__ void gemm_phase(PG8_LAS unsigned char* lds, const Gemm g, const StaticOrder& S, const Epi& E) {
    const int tid = threadIdx.x, wid = __builtin_amdgcn_readfirstlane(tid >> 6), lane = tid & 63, wr = wid >> 2, wc = wid & 3, fr = lane & 15, fq = lane >> 4;
    const int K = g.K, nt = K / BK;
    unsigned voffA[2], voffB[2];
#pragma unroll
    for (int i = 0; i < 2; ++i) { int R, C; stage_rc(tid * 16 + i * 8192, R, C); const int Rb = (R & ~31) + perm32(R & 31);
        voffA[i] = (unsigned)(R * g.lda + C) * 2u; voffB[i] = (unsigned)(Rb * g.ldb + C) * 2u; }
    const size_t kstep = (size_t)(BK * 2);
    const size_t hstepA = (size_t)HALF * g.lda * 2, hstepB = (size_t)HALF * g.ldb * 2;
    const unsigned ldsw = (unsigned)wid * 1024u;
    const int aoff = lds_byte(wr * 64 + fr, fq * 8), boff = lds_byte(wc * 32 + fr, fq * 8);
#define PG8_SA(b, h) (((b) * 2 + (h)) * HTB)
#define PG8_SB(b, h) ((4 + (b) * 2 + (h)) * HTB)
#define PG8_STAGE(bufoff, gbase, voff) do { _Pragma("unroll") for (int _i = 0; _i < 2; ++_i) \
        __builtin_amdgcn_global_load_lds((const unsigned*)((const char*)(gbase) + (voff)[_i]), (PG8_LAS unsigned*)(lds + (bufoff) + ldsw + _i * 8192), 16, 0, 0); } while (0)
#define PG8_LDA(dst, b, h) do { _Pragma("unroll") for (int m = 0; m < 4; ++m) _Pragma("unroll") for (int k = 0; k < 2; ++k) dst[m][k] = *(const PG8_LAS bf16x8*)(lds + PG8_SA(b, h) + aoff + m * 2048 + k * 1024); } while (0)
#define PG8_LDB(dst, b, h) do { _Pragma("unroll") for (int n = 0; n < 2; ++n) _Pragma("unroll") for (int k = 0; k < 2; ++k) dst[n][k] = *(const PG8_LAS bf16x8*)(lds + PG8_SB(b, h) + boff + n * 2048 + k * 1024); } while (0)
#define PG8_MMA(ai, bj, At, Bt) do { __builtin_amdgcn_s_setprio(1); _Pragma("unroll") for (int m = 0; m < 4; ++m) _Pragma("unroll") for (int n = 0; n < 2; ++n) _Pragma("unroll") for (int k = 0; k < 2; ++k) \
        acc[ai][bj][m][n] = __builtin_amdgcn_mfma_f32_16x16x32_bf16(Bt[n][k], At[m][k], acc[ai][bj][m][n], 0, 0, 0); __builtin_amdgcn_s_setprio(0); } while (0)
#define PG8_WAIT_V(n) asm volatile("s_waitcnt vmcnt(" #n ")" ::: "memory")
#define PG8_WAIT_L(n) asm volatile("s_waitcnt lgkmcnt(" #n ")" ::: "memory")
#define PG8_BAR __builtin_amdgcn_s_barrier()
#define PG8_SCHED __builtin_amdgcn_sched_barrier(0)
    Unit cur, nxt; int ui = 0;
    if (!S.next(0, cur)) return;
    f32x4 acc[2][2][4][2];
#pragma unroll
    for (int a = 0; a < 2; ++a)
#pragma unroll
        for (int b = 0; b < 2; ++b)
#pragma unroll
            for (int m = 0; m < 4; ++m)
#pragma unroll
                for (int n = 0; n < 2; ++n) acc[a][b][m][n] = (f32x4){0.f, 0.f, 0.f, 0.f};
    bf16x8 At[4][2], B0[2][2], B1[2][2];
    const char* cA = a_tile(g, cur.pm); const char* cB = b_tile(g, cur.pn);
    PG8_STAGE(PG8_SB(0, 0), cB, voffB); PG8_STAGE(PG8_SB(0, 1), cB + hstepB, voffB); PG8_STAGE(PG8_SA(0, 0), cA, voffA); PG8_STAGE(PG8_SA(0, 1), cA + hstepA, voffA);
    if (wr == 1) PG8_BAR;
    PG8_WAIT_V(2); PG8_BAR;
    PG8_STAGE(PG8_SB(1, 0), cB + kstep, voffB); PG8_STAGE(PG8_SA(1, 0), cA + kstep, voffA); PG8_STAGE(PG8_SB(1, 1), cB + hstepB + kstep, voffB);
    PG8_WAIT_V(6); PG8_BAR;
    for (;;) {
        const bool has_next = S.next(ui + 1, nxt);
        const char* nA = has_next ? a_tile(g, nxt.pm) : cA; const char* nB = has_next ? b_tile(g, nxt.pn) : cB;
        for (int t = 0; t < nt; t += 2) {
            const bool last = (t == nt - 2);
            const char* a1 = cA + (size_t)(t + 1) * kstep;
            const char* a2 = last ? nA : cA + (size_t)(t + 2) * kstep; const char* b2 = last ? nB : cB + (size_t)(t + 2) * kstep;
            const char* a3 = a2 + kstep; const char* b3 = b2 + kstep;
            PG8_LDB(B0, 0, 0); PG8_LDB(B1, 0, 1); PG8_SCHED; PG8_LDA(At, 0, 0); PG8_STAGE(PG8_SA(1, 1), a1 + hstepA, voffA);
            PG8_WAIT_V(8); PG8_WAIT_L(0); PG8_BAR; PG8_MMA(0, 0, At, B0); PG8_MMA(0, 1, At, B1); PG8_BAR; PG8_SCHED;
            PG8_LDA(At, 0, 1); PG8_STAGE(PG8_SB(0, 0), b2, voffB); PG8_STAGE(PG8_SB(0, 1), b2 + hstepB, voffB); PG8_STAGE(PG8_SA(0, 0), a2, voffA);
            PG8_WAIT_V(8); PG8_WAIT_L(0); PG8_BAR; PG8_MMA(1, 0, At, B0); PG8_MMA(1, 1, At, B1); PG8_BAR; PG8_SCHED;
            PG8_LDB(B0, 1, 0); PG8_LDB(B1, 1, 1); PG8_SCHED; PG8_LDA(At, 1, 0); PG8_STAGE(PG8_SA(0, 1), a2 + hstepA, voffA);
            PG8_WAIT_V(8); PG8_WAIT_L(0); PG8_BAR; PG8_MMA(0, 0, At, B0); PG8_MMA(0, 1, At, B1); PG8_BAR; PG8_SCHED;
            PG8_LDA(At, 1, 1); PG8_STAGE(PG8_SB(1, 0), b3, voffB); PG8_STAGE(PG8_SB(1, 1), b3 + hstepB, voffB); PG8_STAGE(PG8_SA(1, 0), a3, voffA);
            PG8_WAIT_V(8); PG8_WAIT_L(0); PG8_BAR; PG8_MMA(1, 0, At, B0); PG8_MMA(1, 1, At, B1); PG8_BAR; PG8_SCHED;
        }
        if (wr == 0) PG8_BAR;
        E(acc, cur, wr, wc, fr, fq);
        if (!has_next) break;
#pragma unroll
        for (int a = 0; a < 2; ++a)
#pragma unroll
            for (int b = 0; b < 2; ++b)
#pragma unroll
                for (int m = 0; m < 4; ++m)
#pragma unroll
                    for (int n = 0; n < 2; ++n) acc[a][b][m][n] = (f32x4){0.f, 0.f, 0.f, 0.f};
        cur = nxt; cA = nA; cB = nB; ++ui;
        if (wr == 1) PG8_BAR;
    }
    PG8_WAIT_V(0);
    PG8_BAR;
#undef PG8_SA
#undef PG8_SB
#undef PG8_STAGE
#undef PG8_LDA
#undef PG8_LDB
#undef PG8_MMA
#undef PG8_WAIT_V
#undef PG8_WAIT_L
#undef PG8_BAR
#undef PG8_SCHED
}
}

constexpr int NWAVES = 8;
constexpr int BATCH = 8, SEQ = 8192, D = 1024, M = BATCH * SEQ, FF = 4096;
constexpr int NIN = 5632;
constexpr int N_PHASES = 10;

constexpr size_t MiB = 1u << 20;
constexpr size_t WS_BAR = 0;
constexpr size_t WS_SSMA = 512 * 1024;
constexpr size_t WS_SSMB = 576 * 1024;
constexpr size_t WS_SSMC = 704 * 1024;
constexpr size_t WS_WIN = 2 * MiB;
constexpr size_t WS_WV = 13 * MiB;
constexpr size_t WS_WGLU = 15 * MiB;
constexpr size_t WS_WSSM = 16 * MiB;
constexpr size_t WS_WATT = 17 * MiB;
constexpr size_t WS_WMKV = 18 * MiB;
constexpr size_t WS_WMEM = 20 * MiB;
constexpr size_t WS_WO = 21 * MiB;
constexpr size_t WS_WUP = 23 * MiB;
constexpr size_t WS_WDN = 31 * MiB;
constexpr size_t WS_MEMN = 40 * MiB;
constexpr size_t WS_MK = 44 * MiB;
constexpr size_t WS_MVT = 46 * MiB;
constexpr size_t WS_E = 48 * MiB;
constexpr size_t WS_SSP1 = 56 * MiB, WS_SSP2 = 60 * MiB;
constexpr size_t WS_XN = 64 * MiB;
constexpr size_t WS_OG = 512 * MiB, WS_LSE = 608 * MiB;
constexpr size_t WS_XS = 128 * 1024;
constexpr size_t WS_U = 192 * MiB;
constexpr size_t WS_MQ = 256 * MiB;
constexpr size_t WS_HB = 192 * MiB;
constexpr size_t WS_GATES = 320 * MiB;
constexpr size_t WS_Q = 704 * MiB, WS_K = 800 * MiB, WS_VT = 896 * MiB;
constexpr size_t WS_YG = 704 * MiB, WS_Y2 = 768 * MiB, WS_OMRG = 832 * MiB, WS_MG = 864 * MiB;
constexpr size_t WS_ACT = 320 * MiB;
constexpr size_t WS_END = 992 * MiB;

constexpr int LDS_BYTES = 147456;

#define LAS __attribute__((address_space(3)))
typedef unsigned short bf16;
typedef unsigned v4u __attribute__((ext_vector_type(4)));
typedef unsigned v2u __attribute__((ext_vector_type(2)));
typedef float f32x4 __attribute__((ext_vector_type(4)));
typedef float f32x2 __attribute__((ext_vector_type(2)));
typedef float f32x16 __attribute__((ext_vector_type(16)));
typedef short bf16x8 __attribute__((ext_vector_type(8)));
typedef short s16x4 __attribute__((ext_vector_type(4)));
typedef __bf16 bf16x2_t __attribute__((ext_vector_type(2)));
__device__ __forceinline__ unsigned cvtpk(float lo, float hi) { f32x2 v = {lo, hi}; bf16x2_t b = __builtin_convertvector(v, bf16x2_t); return __builtin_bit_cast(unsigned, b); }
__device__ __forceinline__ float wave_sum(float v) {
#pragma unroll
    for (int o = 1; o < 64; o <<= 1) v += __shfl_xor(v, o);
    return v;
}
__device__ __forceinline__ float bf2f(bf16 b) { return __builtin_bit_cast(float, (unsigned)b << 16); }

struct Args { const float* in[25]; float* out; unsigned char* ws; int ph_lo, ph_hi; };

__device__ __forceinline__ void p0_transpose_item(const float* W, int ldw, int c0, int K, int nblk, bf16* WT, int row_off, const float* scale, LAS float* scr, int item, int lane) {
    const int kb = item / nblk, nb = item % nblk, k0 = 64 * kb, n0 = 32 * nb;
#pragma unroll 8
    for (int i = 0; i < 32; ++i) { const int kk = 2 * i + (lane >> 5); float v = W[(size_t)(k0 + kk) * ldw + c0 + n0 + (lane & 31)]; if (scale) v *= scale[k0 + kk]; scr[kk * 33 + (lane & 31)] = v; }
    asm volatile("s_waitcnt lgkmcnt(0)" ::: "memory");
    const int c = lane & 7;
#pragma unroll
    for (int j = 0; j < 4; ++j) { const int n = (lane >> 3) + 8 * j; const LAS float* s = scr + (8 * c) * 33 + n;
        v4u o; o.x = cvtpk(s[0 * 33], s[1 * 33]); o.y = cvtpk(s[2 * 33], s[3 * 33]); o.z = cvtpk(s[4 * 33], s[5 * 33]); o.w = cvtpk(s[6 * 33], s[7 * 33]);
        *(v4u*)(WT + (size_t)(row_off + n0 + n) * K + k0 + 8 * c) = o; }
    asm volatile("s_waitcnt lgkmcnt(0)" ::: "memory");
}
template <int NR>
__device__ __forceinline__ void rms_rows_to_bf16(const float* xrow, size_t rs, const float* g, bf16* orow, int lane, float* xs_out) {
    const f32x4* gr = (const f32x4*)g + lane;
    f32x4 v[NR][4]; float s[NR];
#pragma unroll
    for (int r = 0; r < NR; ++r) { const f32x4* xr = (const f32x4*)(xrow + r * rs) + lane; s[r] = 0.f;
#pragma unroll
        for (int j = 0; j < 4; ++j) v[r][j] = xr[64 * j]; }
    f32x4 gg[4];
#pragma unroll
    for (int j = 0; j < 4; ++j) gg[j] = gr[64 * j];
#pragma unroll
    for (int r = 0; r < NR; ++r) {
#pragma unroll
        for (int j = 0; j < 4; ++j) s[r] += (v[r][j].x * v[r][j].x + v[r][j].y * v[r][j].y) + (v[r][j].z * v[r][j].z + v[r][j].w * v[r][j].w);
        const float nrm = sqrtf(wave_sum(s[r]) * (1.f / 1024.f) + 1e-6f), rstd = 1.f / nrm;
        if (xs_out && lane == 0) xs_out[r] = nrm;
        unsigned long long* o8 = (unsigned long long*)(orow + r * rs) + lane;
#pragma unroll
        for (int j = 0; j < 4; ++j)
            o8[64 * j] = (unsigned long long)cvtpk(v[r][j].x * rstd * gg[j].x, v[r][j].y * rstd * gg[j].y) | ((unsigned long long)cvtpk(v[r][j].z * rstd * gg[j].z, v[r][j].w * rstd * gg[j].w) << 32); }
}
__device__ __forceinline__ void sincos_d(double x, double& s, double& c) {
    const double k = rint(x * 0.15915494309189535); const double y = (x - k * 6.283185307179586) - k * 2.4492935982947064e-16;
    const double y2 = y * y; double ts = 1.0, tc = 1.0;
#pragma unroll 1
    for (int n = 27; n >= 3; n -= 2) { ts = 1.0 - ts * y2 / (double)(n * (n - 1)); tc = 1.0 - tc * y2 / (double)((n - 1) * (n - 2)); }
    s = y * ts; c = tc;
}

template <int E, bool MASK>
__device__ __forceinline__ void attn_wave(const bf16* Qp, int ldq, const bf16* Kt, const bf16* Vt,
                                          int kt0, int kt1, int j0, int lane, f32x16 (&O)[E / 32], float& m_out, float& l_out) {
    constexpr int TE = 32 * E;
    const int c = lane & 31, hi = lane >> 5;
    bf16x8 qf[E / 16];
#pragma unroll
    for (int s = 0; s < E / 16; ++s) qf[s] = *(const bf16x8*)(Qp + (size_t)c * ldq + 16 * s + 8 * hi);
    float mrun = -1e30f, l = 0.f;
#pragma unroll
    for (int t = 0; t < E / 32; ++t)
#pragma unroll
        for (int i = 0; i < 16; ++i) O[t][i] = 0.f;
    const float c2 = (E == 64 ? 0.125f : 0.08838834764831845f) * 1.4426950408889634f;
    bf16x8 kf[E / 16];
#pragma unroll
    for (int s = 0; s < E / 16; ++s) kf[s] = *(const bf16x8*)(Kt + (size_t)kt0 * TE + s * 512 + lane * 8);
    for (int kt = kt0; kt <= kt1; ++kt) {
        bf16x8 vfr[E / 32][2];
#pragma unroll
        for (int t = 0; t < E / 32; ++t)
#pragma unroll
            for (int s2 = 0; s2 < 2; ++s2) vfr[t][s2] = *(const bf16x8*)(Vt + (size_t)kt * TE + (t * 2 + s2) * 512 + lane * 8);
        bf16x8 kn[E / 16];
        { const int ktn = (kt < kt1) ? kt + 1 : kt1;
#pragma unroll
          for (int s = 0; s < E / 16; ++s) kn[s] = *(const bf16x8*)(Kt + (size_t)ktn * TE + s * 512 + lane * 8); }
        f32x16 S;
#pragma unroll
        for (int i = 0; i < 16; ++i) S[i] = 0.f;
#pragma unroll
        for (int s = 0; s < E / 16; ++s) S = __builtin_amdgcn_mfma_f32_32x32x16_bf16(kf[s], qf[s], S, 0, 0, 0);
        if (MASK) {
            const bool full = (kt * 32 + 31 <= j0) && (kt * 32 + 128 >= j0 + 31);
            if (!full) { const int qj = j0 + c;
#pragma unroll
                for (int i = 0; i < 16; ++i) { const int kj = kt * 32 + (i & 3) + 8 * (i >> 2) + 4 * hi; const bool valid = (kj <= qj) && (kj + 128 >= qj); S[i] = valid ? S[i] : -1e30f; } }
        }
        float mx = S[0];
#pragma unroll
        for (int i = 1; i < 16; ++i) mx = fmaxf(mx, S[i]);
        mx = fmaxf(mx, __shfl_xor(mx, 32));
        const float mn = fmaxf(mrun, mx); const float alpha = __builtin_amdgcn_exp2f((mrun - mn) * c2); mrun = mn;
        float ps = 0.f;
#pragma unroll
        for (int i = 0; i < 16; ++i) { const float p = __builtin_amdgcn_exp2f((S[i] - mn) * c2); S[i] = p; ps += p; }
        l = l * alpha + ps;
#pragma unroll
        for (int t = 0; t < E / 32; ++t)
#pragma unroll
            for (int i = 0; i < 16; ++i) O[t][i] *= alpha;
        bf16x8 pk[2];
#pragma unroll
        for (int s2 = 0; s2 < 2; ++s2) { v4u w; w.x = cvtpk(S[8 * s2 + 0], S[8 * s2 + 1]); w.y = cvtpk(S[8 * s2 + 2], S[8 * s2 + 3]); w.z = cvtpk(S[8 * s2 + 4], S[8 * s2 + 5]); w.w = cvtpk(S[8 * s2 + 6], S[8 * s2 + 7]); pk[s2] = __builtin_bit_cast(bf16x8, w); }
#pragma unroll
        for (int t = 0; t < E / 32; ++t)
#pragma unroll
            for (int s2 = 0; s2 < 2; ++s2) O[t] = __builtin_amdgcn_mfma_f32_32x32x16_bf16(vfr[t][s2], pk[s2], O[t], 0, 0, 0);
#pragma unroll
        for (int s = 0; s < E / 16; ++s) kf[s] = kn[s];
    }
    l += __shfl_xor(l, 32);
    m_out = mrun; l_out = l;
}

__device__ __forceinline__ void sattn_wave(const bf16* Qp, const bf16* Kt, const bf16* Vt, int j0, int lane, f32x16 (&O)[2][2], float (&m_out)[2], float (&l_out)[2]) {
    const int c = lane & 31, hi = lane >> 5;
    bf16x8 qf[2][4];
#pragma unroll
    for (int q = 0; q < 2; ++q)
#pragma unroll
        for (int s = 0; s < 4; ++s) qf[q][s] = *(const bf16x8*)(Qp + (size_t)(32 * q + c) * 64 + 16 * s + 8 * hi);
    float mrun[2] = {-1e30f, -1e30f}, l[2] = {0.f, 0.f};
#pragma unroll
    for (int q = 0; q < 2; ++q)
#pragma unroll
        for (int t = 0; t < 2; ++t)
#pragma unroll
            for (int i = 0; i < 16; ++i) O[q][t][i] = 0.f;
    const float c2 = 0.125f * 1.4426950408889634f;
    const int kb = j0 >> 5, kt_end = kb + 1, kt_beg = (kb >= 4) ? kb - 4 : 0;
    bf16x8 kf[4], vfr[2][2];
#pragma unroll
    for (int s = 0; s < 4; ++s) kf[s] = *(const bf16x8*)(Kt + (size_t)kt_beg * 2048 + s * 512 + lane * 8);
#pragma unroll
    for (int t = 0; t < 2; ++t)
#pragma unroll
        for (int s2 = 0; s2 < 2; ++s2) vfr[t][s2] = *(const bf16x8*)(Vt + (size_t)kt_beg * 2048 + (t * 2 + s2) * 512 + lane * 8);
    for (int kt = kt_beg; kt <= kt_end; ++kt) {
        const int ktn = (kt < kt_end) ? kt + 1 : kt_end;
        bf16x8 kn[4], vn[2][2];
#pragma unroll
        for (int s = 0; s < 4; ++s) kn[s] = *(const bf16x8*)(Kt + (size_t)ktn * 2048 + s * 512 + lane * 8);
#pragma unroll
        for (int t = 0; t < 2; ++t)
#pragma unroll
            for (int s2 = 0; s2 < 2; ++s2) vn[t][s2] = *(const bf16x8*)(Vt + (size_t)ktn * 2048 + (t * 2 + s2) * 512 + lane * 8);
#pragma unroll
        for (int q = 0; q < 2; ++q) {
            const int kq = kb + q;
            if (kt <= kq && kt + 4 >= kq) {
                f32x16 S;
#pragma unroll
                for (int i = 0; i < 16; ++i) S[i] = 0.f;
#pragma unroll
                for (int s = 0; s < 4; ++s) S = __builtin_amdgcn_mfma_f32_32x32x16_bf16(kf[s], qf[q][s], S, 0, 0, 0);
                const int jq = j0 + 32 * q;
                const bool full = (kt * 32 + 31 <= jq) && (kt * 32 + 128 >= jq + 31);
                if (!full) { const int qj = jq + c;
#pragma unroll
                    for (int i = 0; i < 16; ++i) { const int kj = kt * 32 + (i & 3) + 8 * (i >> 2) + 4 * hi; const bool valid = (kj <= qj) && (kj + 128 >= qj); S[i] = valid ? S[i] : -1e30f; } }
                float mx = S[0];
#pragma unroll
                for (int i = 1; i < 16; ++i) mx = fmaxf(mx, S[i]);
                mx = fmaxf(mx, __shfl_xor(mx, 32));
                const float mn = fmaxf(mrun[q], mx); const float alpha = __builtin_amdgcn_exp2f((mrun[q] - mn) * c2); mrun[q] = mn;
                float ps = 0.f;
#pragma unroll
                for (int i = 0; i < 16; ++i) { const float p = __builtin_amdgcn_exp2f((S[i] - mn) * c2); S[i] = p; ps += p; }
                l[q] = l[q] * alpha + ps;
#pragma unroll
                for (int t = 0; t < 2; ++t)
#pragma unroll
                    for (int i = 0; i < 16; ++i) O[q][t][i] *= alpha;
                bf16x8 pk[2];
#pragma unroll
                for (int s2 = 0; s2 < 2; ++s2) { v4u w; w.x = cvtpk(S[8 * s2 + 0], S[8 * s2 + 1]); w.y = cvtpk(S[8 * s2 + 2], S[8 * s2 + 3]); w.z = cvtpk(S[8 * s2 + 4], S[8 * s2 + 5]); w.w = cvtpk(S[8 * s2 + 6], S[8 * s2 + 7]); pk[s2] = __builtin_bit_cast(bf16x8, w); }
#pragma unroll
                for (int t = 0; t < 2; ++t)
#pragma unroll
                    for (int s2 = 0; s2 < 2; ++s2) O[q][t] = __builtin_amdgcn_mfma_f32_32x32x16_bf16(vfr[t][s2], pk[s2], O[q][t], 0, 0, 0);
            }
        }
#pragma unroll
        for (int s = 0; s < 4; ++s) kf[s] = kn[s];
#pragma unroll
        for (int t = 0; t < 2; ++t)
#pragma unroll
            for (int s2 = 0; s2 < 2; ++s2) vfr[t][s2] = vn[t][s2];
    }
#pragma unroll
    for (int q = 0; q < 2; ++q) { l[q] += __shfl_xor(l[q], 32); m_out[q] = mrun[q]; l_out[q] = l[q]; }
}

constexpr int SSM_LROW = 272;
template <bool PASSB>
__device__ __forceinline__ void ssm_wave(const unsigned char* ws, const float* dd, int b, int g, int segbase, int hstride, int nsp, LAS unsigned char* sb, int lane) {
    const int c = lane & 31, hi = lane >> 5;
    const f32x4 pa0 = *(const f32x4*)(ws + WS_SSMA + (size_t)(g * 64 + c) * 16), pa1 = *(const f32x4*)(ws + WS_SSMA + (size_t)(g * 64 + c + 32) * 16);
    bf16x8 bfr[4];
#pragma unroll
    for (int n = 0; n < 4; ++n) bfr[n] = *(const bf16x8*)(ws + WS_SSMB + ((size_t)((g * 4 + n) * 32 + c) * 16 + 8 * hi) * 2);
    const bf16* U = (const bf16*)(ws + WS_U);
    float s0r = 0.f, s0i = 0.f, s1r = 0.f, s1i = 0.f;
    f32x2* Eb = (f32x2*)(ws + WS_E) + (size_t)(b * 32 + g) * 64 * 64;
    if (PASSB) {
        const int seg = segbase + hstride * hi;
#pragma unroll 8
        for (int sq = 0; sq < seg; ++sq) { const f32x2 e0 = Eb[sq * 64 + c], e1 = Eb[sq * 64 + c + 32];
            const float n0r = pa0.z * s0r - pa0.w * s0i + e0.x, n0i = pa0.z * s0i + pa0.w * s0r + e0.y; s0r = n0r; s0i = n0i;
            const float n1r = pa1.z * s1r - pa1.w * s1i + e1.x, n1i = pa1.z * s1i + pa1.w * s1r + e1.y; s1r = n1r; s1i = n1i; }
    }
    bf16x8 cfr[4];
    if (PASSB) {
#pragma unroll
        for (int ks = 0; ks < 4; ++ks) cfr[ks] = *(const bf16x8*)(ws + WS_SSMC + ((size_t)(g * 16 + (lane & 15)) * 128 + 32 * ks + 8 * (lane >> 4)) * 2);
    }
    const int segsel = (c >> 2) & 1, toff = (c & 3) + 4 * (c >> 3);
    const float dsk = dd[g * 16 + (lane & 15)];
    for (int kp = 0; kp < nsp; ++kp) {
        if (!PASSB) { s0r = 0.f; s0i = 0.f; s1r = 0.f; s1i = 0.f; }
        const int seg0 = segbase + kp;
        const size_t tokA = (size_t)b * 8192 + (size_t)(seg0 + hstride * segsel) * 128 + toff;
        bf16x8 ufn = *(const bf16x8*)(U + tokA * 512 + g * 16 + 8 * hi);
        for (int blk = 0; blk < 8; ++blk) {
            const bf16x8 uf = ufn; { const int bn = (blk < 7) ? blk + 1 : 7; ufn = *(const bf16x8*)(U + (tokA + bn * 16) * 512 + g * 16 + 8 * hi); }
            bf16 uu[2][4];
            if (PASSB) {
#pragma unroll
                for (int ss = 0; ss < 2; ++ss)
#pragma unroll
                    for (int rg = 0; rg < 4; ++rg) uu[ss][rg] = U[((size_t)b * 8192 + (size_t)(seg0 + hstride * ss) * 128 + blk * 16 + (lane >> 4) * 4 + rg) * 512 + g * 16 + (lane & 15)];
            }
            f32x16 z;
#pragma unroll
            for (int i = 0; i < 16; ++i) z[i] = 0.f;
            const f32x16 BU0 = __builtin_amdgcn_mfma_f32_32x32x16_bf16(uf, bfr[0], z, 0, 0, 0), BU1 = __builtin_amdgcn_mfma_f32_32x32x16_bf16(uf, bfr[1], z, 0, 0, 0);
            const f32x16 BU2 = __builtin_amdgcn_mfma_f32_32x32x16_bf16(uf, bfr[2], z, 0, 0, 0), BU3 = __builtin_amdgcn_mfma_f32_32x32x16_bf16(uf, bfr[3], z, 0, 0, 0);
#pragma unroll
            for (int i = 0; i < 16; ++i) {
                const float n0r = pa0.x * s0r - pa0.y * s0i + BU0[i], n0i = pa0.x * s0i + pa0.y * s0r + BU1[i]; s0r = n0r; s0i = n0i;
                const float n1r = pa1.x * s1r - pa1.y * s1i + BU2[i], n1i = pa1.x * s1i + pa1.y * s1r + BU3[i]; s1r = n1r; s1i = n1i;
                if (PASSB) { LAS unsigned char* rowp = sb + (hi * 16 + i) * SSM_LROW + 4 * c;
                    *(LAS unsigned*)rowp = cvtpk(s0r, s0i); *(LAS unsigned*)(rowp + 128) = cvtpk(s1r, s1i); }
            }
            if (PASSB) {
                asm volatile("s_waitcnt lgkmcnt(0)" ::: "memory");
#pragma unroll
                for (int ss = 0; ss < 2; ++ss) {
                    pg8::f32x4 Y = {0.f, 0.f, 0.f, 0.f};
#pragma unroll
                    for (int ks = 0; ks < 4; ++ks) { const bf16x8 af = *(const LAS bf16x8*)(sb + (ss * 16 + (lane & 15)) * SSM_LROW + (32 * ks + 8 * (lane >> 4)) * 2);
                        Y = __builtin_amdgcn_mfma_f32_16x16x32_bf16(af, cfr[ks], Y, 0, 0, 0); }
#pragma unroll
                    for (int rg = 0; rg < 4; ++rg) { const size_t tok = (size_t)b * 8192 + (size_t)(seg0 + hstride * ss) * 128 + blk * 16 + (lane >> 4) * 4 + rg; const size_t o = tok * 512 + g * 16 + (lane & 15);
                        const float y = Y[rg] + dsk * bf2f(uu[ss][rg]);
                        const float zz = 0.7978845608028654f * (y + 0.044715f * y * y * y);
                        const float gl = y * __builtin_amdgcn_rcpf(1.f + __builtin_amdgcn_exp2f(-2.885390081777927f * zz));
                        ((bf16*)(ws + WS_YG))[o] = (bf16)(cvtpk(gl, 0.f) & 0xffffu); }
                }
                asm volatile("s_waitcnt lgkmcnt(0)" ::: "memory");
            }
        }
        if (!PASSB) { const int seg = seg0 + hstride * hi; Eb[seg * 64 + c] = (f32x2){s0r, s0i}; Eb[seg * 64 + c + 32] = (f32x2){s1r, s1i}; }
    }
}

#define RLX_AGENT __ATOMIC_RELAXED, __HIP_MEMORY_SCOPE_AGENT
#define XB_TMO      128
#define XB_XCNT(j)  (256  + 64 * (j))
#define XB_XSUB(j)  (1280 + 64 * (j))
#define XB_XGEN(j)  (2304 + 64 * (j))
#define XB_TOP      3328
#define XB_TOPGEN   3392
#define XCD_BAR_WORDS 3456
#define XB_SPIN_CAP (1u << 18)

__device__ __forceinline__ unsigned xb_ld(unsigned* p)              { return __hip_atomic_load(p, __ATOMIC_RELAXED, __HIP_MEMORY_SCOPE_AGENT); }
__device__ __forceinline__ unsigned xb_add(unsigned* p, unsigned v) { return __hip_atomic_fetch_add(p, v, __ATOMIC_RELAXED, __HIP_MEMORY_SCOPE_AGENT); }
__device__ __forceinline__ unsigned xb_xcc_id() { return (unsigned)__builtin_amdgcn_s_getreg((3 << 11) | 20) & 0xFu; }
#define XB_SPIN(cond, bar) do { unsigned _sp = 0; while (cond) { __builtin_amdgcn_s_sleep(1); \
    if ((++_sp & 255u) == 0u) { if (xb_ld(&(bar)[XB_TMO])) break; if (_sp > XB_SPIN_CAP) { atomicAdd(&(bar)[XB_TMO], 1u); break; } } } } while (0)

struct XcdBarrier {
    unsigned* bar; unsigned x;
    volatile LAS unsigned* st;
};

__device__ __forceinline__ XcdBarrier xcd_barrier_post(unsigned* bar, volatile LAS unsigned* st) {
    XcdBarrier b; b.bar = bar; b.x = xb_xcc_id(); b.st = st;
    if (threadIdx.x == 0) (void)xb_add(&bar[XB_XCNT(b.x)], 1u);
    return b;
}
__device__ __forceinline__ void xcd_barrier_complete(unsigned* bar, unsigned x, unsigned& nloc, unsigned& nx) {
    const unsigned G = gridDim.x * gridDim.y * gridDim.z;
    unsigned sum, cnt, mine, sp = 0u;
    for (;;) {
        sum = 0u; cnt = 0u; mine = 0u;
#pragma unroll
        for (unsigned j = 0; j < 16; ++j) { const unsigned c = xb_ld(&bar[XB_XCNT(j)]); sum += c; cnt += (c > 0u) ? 1u : 0u; mine = (j == x) ? c : mine; }
        if (sum == G) break;
        __builtin_amdgcn_s_sleep(1);
        if ((++sp & 255u) == 0u) { if (xb_ld(&bar[XB_TMO])) break; if (sp > XB_SPIN_CAP) { atomicAdd(&bar[XB_TMO], 1u); break; } }
    }
    nloc = mine > 0u ? mine : 1u; nx = cnt > 0u ? cnt : 1u;
}

__device__ __forceinline__ void xcd_barrier(const XcdBarrier& b) {
    asm volatile("s_waitcnt vmcnt(0)" ::: "memory");
    __syncthreads();
    if (threadIdx.x == 0) {
        unsigned* bar = b.bar;
        __builtin_amdgcn_s_waitcnt(0);
        unsigned nloc = b.st[0], nx = b.st[1];
        if (nloc == 0u) { xcd_barrier_complete(bar, b.x, nloc, nx); b.st[0] = nloc; b.st[1] = nx; }
        const unsigned old = xb_add(&bar[XB_XSUB(b.x)], 1u);
        const unsigned gen = old / nloc;
        if (old + 1u == (gen + 1u) * nloc) {
            __builtin_amdgcn_fence(__ATOMIC_RELEASE, "agent");
            asm volatile("s_waitcnt vmcnt(0)" ::: "memory");
            const unsigned og = xb_add(&bar[XB_TOP], 1u);
            const unsigned tg = og / nx;
            if (og + 1u == (tg + 1u) * nx) xb_add(&bar[XB_TOPGEN], 1u);
            else XB_SPIN(xb_ld(&bar[XB_TOPGEN]) == tg, bar);
            __builtin_amdgcn_fence(__ATOMIC_ACQUIRE, "agent");
            xb_add(&bar[XB_XGEN(b.x)], 1u);
            asm volatile("s_waitcnt vmcnt(0)" ::: "memory");
        } else {
            XB_SPIN(xb_ld(&bar[XB_XGEN(b.x)]) == gen, bar);
            __builtin_amdgcn_fence(__ATOMIC_ACQUIRE, "agent");
            asm volatile("s_waitcnt vmcnt(0)" ::: "memory");
        }
    }
    __syncthreads();
}

__global__ void __launch_bounds__(NWAVES * 64, 2) fwd_megakernel(Args args) {
    __shared__ __attribute__((aligned(16))) unsigned char lds_raw[LDS_BYTES];
    LAS unsigned char* lds = (LAS unsigned char*)lds_raw;
    const int tid = threadIdx.x, lane = tid & 63, wave = __builtin_amdgcn_readfirstlane(tid >> 6);
    const int G = gridDim.x; const int bx = blockIdx.x; const int vcu = (G % 8 == 0) ? (bx % 8) * (G / 8) + bx / 8 : bx;
    const int gw = vcu * NWAVES + wave, NGW = G * NWAVES;
    unsigned char* ws = args.ws;
    const int lo = args.ph_lo, hi_ph = args.ph_hi;
    volatile LAS unsigned* MISC = (volatile LAS unsigned*)(lds + 131072 + 320);
    if (tid < 32) MISC[tid] = 0u;
    __syncthreads();
    XcdBarrier bar; bar.bar = (unsigned*)ws; bar.x = 0; bar.st = nullptr;
    if (hi_ph - lo > 1) bar = xcd_barrier_post((unsigned*)ws, MISC + 8);
    if (lo == 0x7fffffff) cg::this_grid().sync();
#define IN(k) (lo <= (k) && (k) < hi_ph)
#define SEAM(k) do { if (IN(k) && IN((k) + 1)) { xcd_barrier(bar); } } while (0)

    if (IN(0)) {
        LAS float* scr = (LAS float*)(lds + wave * 16384);
        const float* w_in = args.in[4];
        constexpr int I0 = 16 * 64, I1 = 16 * 24, I2 = 16 * 112, I3 = 8 * 16, I4 = 8 * 32, I5 = 4 * 32, I6 = 16 * 32, I7 = 8 * 32, I8 = 16 * 32, I9 = 16 * 128, I10 = 64 * 32;
        constexpr int NITEMS = I0 + I1 + I2 + I3 + I4 + I5 + I6 + I7 + I8 + I9 + I10;
        for (int it = gw; it < NITEMS; it += NGW) {
            int r = it;
            if (r < I0) { p0_transpose_item(w_in, 6400, 0, 1024, 64, (bf16*)(ws + WS_WIN), 0, nullptr, scr, r, lane); continue; } r -= I0;
            if (r < I1) { p0_transpose_item(w_in, 6400, 2048, 1024, 24, (bf16*)(ws + WS_WV), 0, nullptr, scr, r, lane); continue; } r -= I1;
            if (r < I2) { p0_transpose_item(w_in, 6400, 2816, 1024, 112, (bf16*)(ws + WS_WIN), 2048, nullptr, scr, r, lane); continue; } r -= I2;
            if (r < I3) { p0_transpose_item(args.in[14], 512, 0, 512, 16, (bf16*)(ws + WS_WGLU), 0, nullptr, scr, r, lane); continue; } r -= I3;
            if (r < I4) { p0_transpose_item(args.in[16], 1024, 0, 512, 32, (bf16*)(ws + WS_WSSM), 0, nullptr, scr, r, lane); continue; } r -= I4;
            if (r < I5) { p0_transpose_item(args.in[17], 1024, 0, 256, 32, (bf16*)(ws + WS_WATT), 0, nullptr, scr, r, lane); continue; } r -= I5;
            if (r < I6) { p0_transpose_item(args.in[18], 1024, 0, 1024, 32, (bf16*)(ws + WS_WMKV), 0, nullptr, scr, r, lane); continue; } r -= I6;
            if (r < I7) { p0_transpose_item(args.in[19], 1024, 0, 512, 32, (bf16*)(ws + WS_WMEM), 0, nullptr, scr, r, lane); continue; } r -= I7;
            if (r < I8) { p0_transpose_item(args.in[20], 1024, 0, 1024, 32, (bf16*)(ws + WS_WO), 0, nullptr, scr, r, lane); continue; } r -= I8;
            if (r < I9) { p0_transpose_item(args.in[22], 4096, 0, 1024, 128, (bf16*)(ws + WS_WUP), 0, args.in[21], scr, r, lane); continue; } r -= I9;
            p0_transpose_item(args.in[23], 1024, 0, 4096, 32, (bf16*)(ws + WS_WDN), 0, nullptr, scr, r, lane);
        }
        for (int m = gw * 4; m < M; m += NGW * 4) rms_rows_to_bf16<4>(args.in[0] + (size_t)m * D, (size_t)D, args.in[2], (bf16*)(ws + WS_XN) + (size_t)m * D, lane, (float*)(ws + WS_XS) + m);
        for (int m = gw; m < 2048; m += NGW) rms_rows_to_bf16<1>(args.in[1] + (size_t)m * D, (size_t)D, args.in[3], (bf16*)(ws + WS_MEMN) + (size_t)m * D, lane, nullptr);
        { const int i = bx * 512 + tid;
          if (i < 2048) { const int g = i >> 6, p = i & 63;
            const double lr = (double)args.in[6][i], li = (double)args.in[7][i], dt = exp((double)args.in[8][g]);
            const double mag = exp(lr * dt); double sn, cs; sincos_d(li * dt, sn, cs);
            const double ar = mag * cs, aim = mag * sn, nr = ar - 1.0, ni = aim, den = lr * lr + li * li;
            const double cr = (nr * lr + ni * li) / den, ci = (ni * lr - nr * li) / den;
            double pr = ar, pi = aim;
#pragma unroll 1
            for (int k = 0; k < 7; ++k) { const double t = pr * pr - pi * pi; pi = 2.0 * pr * pi; pr = t; }
            *(f32x4*)(ws + WS_SSMA + (size_t)i * 16) = (f32x4){(float)ar, (float)aim, (float)pr, (float)pi};
            const int nt0 = (p >> 5) * 2, cc = p & 31;
            bf16* BM_ = (bf16*)(ws + WS_SSMB); bf16* CM_ = (bf16*)(ws + WS_SSMC);
#pragma unroll 1
            for (int h = 0; h < 16; ++h) { const double br = (double)args.in[9][(size_t)i * 16 + h], bi = (double)args.in[10][(size_t)i * 16 + h];
                const float bbr = (float)(cr * br - ci * bi), bbi = (float)(cr * bi + ci * br);
                BM_[((size_t)(g * 4 + nt0) * 32 + cc) * 16 + h] = (bf16)(cvtpk(bbr, 0.f) & 0xffffu);
                BM_[((size_t)(g * 4 + nt0 + 1) * 32 + cc) * 16 + h] = (bf16)(cvtpk(bbi, 0.f) & 0xffffu);
                const float c_r = args.in[11][((size_t)g * 16 + h) * 64 + p], c_i = args.in[12][((size_t)g * 16 + h) * 64 + p];
                CM_[((size_t)g * 16 + h) * 128 + 2 * p] = (bf16)(cvtpk(c_r, 0.f) & 0xffffu);
                CM_[((size_t)g * 16 + h) * 128 + 2 * p + 1] = (bf16)(cvtpk(-c_i, 0.f) & 0xffffu); }
          } }
    }
    SEAM(0);

    if (IN(1)) {
        __syncthreads();
        {
            pg8::Gemm g{(const bf16*)(ws + WS_MEMN), (const bf16*)(ws + WS_WMKV), 2048, 512, 1024, 1024, 1024, 0}; pg8::StaticOrder S; S.init(2048, 512, G, bx);
            pg8::EpiMKf E{(bf16*)(ws + WS_MK)}; pg8::gemm_phase(lds, g, S, E); }
        {
            pg8::Gemm g{(const bf16*)(ws + WS_WMKV) + (size_t)512 * 1024, (const bf16*)(ws + WS_MEMN), 512, 2048, 1024, 1024, 1024, 0}; pg8::StaticOrder S; S.init(512, 2048, G, (bx + G - 16) % G);
            pg8::EpiVTf E{(bf16*)(ws + WS_MVT), 1, 0}; pg8::gemm_phase(lds, g, S, E); }
        {
            pg8::Gemm g{(const bf16*)(ws + WS_XN), (const bf16*)(ws + WS_WIN), M, NIN, 1024, 1024, 1024, 0}; pg8::StaticOrder S; S.init(M, NIN, G, bx);
            pg8::EpiInProj E{(bf16*)(ws + WS_U), (bf16*)(ws + WS_Q), (bf16*)(ws + WS_K), (bf16*)(ws + WS_MQ), (bf16*)(ws + WS_GATES), args.in[5]}; pg8::gemm_phase(lds, g, S, E); }
#pragma unroll 1
        for (int gi = 0; gi < 3; ++gi) {
            const int d = 1 << (2 * gi);
            pg8::Gemm g{(const bf16*)(ws + WS_WV) + (size_t)gi * 256 * 1024, (const bf16*)(ws + WS_XN), 256, M, 1024, 1024, d * 1024, d}; pg8::StaticOrder S; S.init(256, M, G, bx);
            pg8::EpiVTf E{(bf16*)(ws + WS_VT), 0, gi}; pg8::gemm_phase(lds, g, S, E); }
    }
    SEAM(1);

    if (IN(2)) {
        for (int rep = 0; rep < PROBE_REP; ++rep)
        for (int it0 = gw; it0 < 12288; it0 += NGW) { const int it = 12287 - it0;
            const int qb = it & 127, rest = it >> 7, hh = rest & 3, b = (rest >> 2) & 7, g = rest >> 5;
            const int sh = 2 * g, d = 1 << sh, Ld = 8192 >> sh; const int pp0 = qb * 64, r = pp0 / Ld, j0 = pp0 % Ld;
            const size_t hb = ((size_t)(g * 8 + b) * 4 + hh) * 8192;
            const bf16* Qp = (const bf16*)(ws + WS_Q) + (hb + pp0) * 64;
            const bf16* Kt = (const bf16*)(ws + WS_K) + (hb + (size_t)r * Ld) * 64;
            const bf16* Vt = (const bf16*)(ws + WS_VT) + (hb + (size_t)r * Ld) * 64;
            f32x16 O[2][2]; float mr[2], l[2];
            sattn_wave(Qp, Kt, Vt, j0, lane, O, mr, l);
            const int c = lane & 31, hi = lane >> 5;
#pragma unroll
            for (int q = 0; q < 2; ++q) { const float inv = 1.f / l[q];
                const size_t tok = (size_t)b * 8192 + (size_t)(j0 + 32 * q + c) * d + r;
                bf16* og = (bf16*)(ws + WS_OG) + tok * 768 + g * 256 + hh * 64;
#pragma unroll
                for (int t = 0; t < 2; ++t)
#pragma unroll
                    for (int a = 0; a < 4; ++a) { v2u w; w.x = cvtpk(O[q][t][4 * a] * inv, O[q][t][4 * a + 1] * inv); w.y = cvtpk(O[q][t][4 * a + 2] * inv, O[q][t][4 * a + 3] * inv);
                        *(v2u*)(og + 32 * t + 8 * a + 4 * hi) = w; }
                if (hi == 0) ((float*)(ws + WS_LSE))[tok * 12 + g * 4 + hh] = mr[q] * 0.125f + __logf(l[q]); }
        }
        for (int it0 = gw; it0 < 8192; it0 += NGW) { const int it = 8191 - it0;
            const int qb = it & 255, h = (it >> 8) & 3, b = it >> 10;
            bf16* Qp = (bf16*)(ws + WS_MQ) + ((size_t)b * 8192 + qb * 32) * 512 + h * 128;
            const bf16* Kt = (const bf16*)(ws + WS_MK) + (size_t)(b * 4 + h) * 8 * 4096;
            const bf16* Vt = (const bf16*)(ws + WS_MVT) + (size_t)(b * 4 + h) * 8 * 4096;
            f32x16 O[4]; float mr, l;
            attn_wave<128, false>(Qp, 512, Kt, Vt, 0, 7, 0, lane, O, mr, l);
            const int c = lane & 31, hi = lane >> 5; const float inv = 1.f / l;
            bf16* om = Qp + (size_t)c * 512;
#pragma unroll
            for (int t = 0; t < 4; ++t)
#pragma unroll
                for (int a = 0; a < 4; ++a) { v2u w; w.x = cvtpk(O[t][4 * a] * inv, O[t][4 * a + 1] * inv); w.y = cvtpk(O[t][4 * a + 2] * inv, O[t][4 * a + 3] * inv);
                    *(v2u*)(om + 32 * t + 8 * a + 4 * hi) = w; }
        }
        for (int rep = 0; rep < PROBE_REP; ++rep)
        for (int it = gw; it < 8192; it += NGW) { const int sp = it & 31, g = (it >> 5) & 31, b = it >> 10; ssm_wave<false>(ws, args.in[13], b, g, 2 * sp, 1, 1, lds + wave * 16384, lane); }
    }
    SEAM(2);

    if (IN(3)) {
        for (int rep = 0; rep < PROBE_P3; ++rep)
        for (int it = gw; it < 2048; it += NGW) { const int qd = it & 7, g = (it >> 3) & 31, b = it >> 8;
            ssm_wave<true>(ws, args.in[13], b, g, 8 * qd, 4, 4, lds + wave * 16384, lane); }
        for (int m2 = gw; m2 < M / 2; m2 += NGW) { const size_t tok = (size_t)m2 * 2 + (lane >> 5); const int cc = (lane & 31) * 8, hh = cc >> 6;
            const float* ls = (const float*)(ws + WS_LSE) + tok * 12 + hh; const float l0 = ls[0], l1 = ls[4], l2 = ls[8];
            const float mx = fmaxf(l0, fmaxf(l1, l2)); const float e0 = __expf(l0 - mx), e1 = __expf(l1 - mx), e2 = __expf(l2 - mx); const float inv = 1.f / (e0 + e1 + e2);
            const bf16* og = (const bf16*)(ws + WS_OG) + tok * 768 + cc;
            pg8::f32x4 a0, a1, b0, b1, c0, c1; pg8::unpack8(*(const v4u*)og, a0, a1); pg8::unpack8(*(const v4u*)(og + 256), b0, b1); pg8::unpack8(*(const v4u*)(og + 512), c0, c1);
            const float w0 = e0 * inv, w1 = e1 * inv, w2 = e2 * inv;
            const pg8::f32x4 r0 = a0 * w0 + b0 * w1 + c0 * w2, r1 = a1 * w0 + b1 * w1 + c1 * w2;
            *(v4u*)((bf16*)(ws + WS_OMRG) + tok * 256 + cc) = pg8::pack8(r0, r1); }
    }
    SEAM(3);

    if (IN(4)) {
        __syncthreads();
        pg8::Gemm g{(const bf16*)(ws + WS_YG), (const bf16*)(ws + WS_WGLU), M, 512, 512, 512, 512, 0}; pg8::StaticOrder S; S.init(M, 512, G, bx);
        pg8::EpiGlu E{(const bf16*)(ws + WS_YG), (bf16*)(ws + WS_Y2), args.in[15]}; pg8::gemm_phase(lds, g, S, E);
    }
    SEAM(4);

    if (IN(5)) {
        __syncthreads();
        pg8::StaticOrder S; S.init(M, 1024, G, bx);
        { pg8::Gemm g{(const bf16*)(ws + WS_Y2), (const bf16*)(ws + WS_WSSM), M, 1024, 512, 512, 512, 0};
          pg8::EpiBranch<0> E{(const bf16*)(ws + WS_GATES), (bf16*)(ws + WS_MG), 0}; pg8::gemm_phase(lds, g, S, E); }
        { pg8::Gemm g{(const bf16*)(ws + WS_OMRG), (const bf16*)(ws + WS_WATT), M, 1024, 256, 256, 256, 0};
          pg8::EpiBranch<1> E{(const bf16*)(ws + WS_GATES), (bf16*)(ws + WS_MG), 1024}; pg8::gemm_phase(lds, g, S, E); }
        { pg8::Gemm g{(const bf16*)(ws + WS_MQ), (const bf16*)(ws + WS_WMEM), M, 1024, 512, 512, 512, 0};
          pg8::EpiBranch<1> E{(const bf16*)(ws + WS_GATES), (bf16*)(ws + WS_MG), 2048}; pg8::gemm_phase(lds, g, S, E); }
    }
    SEAM(5);

    if (IN(6)) {
        __syncthreads();
        pg8::Gemm g{(const bf16*)(ws + WS_MG), (const bf16*)(ws + WS_WO), M, 1024, 1024, 1024, 1024, 0}; pg8::StaticOrder S; S.init(M, 1024, G, bx);
        pg8::EpiResid<0> E{(const bf16*)(ws + WS_XN), (const float*)(ws + WS_XS), args.in[2], (bf16*)(ws + WS_HB), (float*)(ws + WS_SSP1)}; pg8::gemm_phase(lds, g, S, E);
    }
    SEAM(6);

    if (IN(7)) {
        __syncthreads();
        pg8::Gemm g{(const bf16*)(ws + WS_HB), (const bf16*)(ws + WS_WUP), M, FF, 1024, 1024, 1024, 0}; pg8::StaticOrder S; S.init(M, FF, G, bx);
        pg8::EpiUp E{(const float*)(ws + WS_SSP1), (bf16*)(ws + WS_ACT)};
        pg8::gemm_phase(lds, g, S, E);
        if (PROBE_G7 > 1) pg8::gemm_phase(lds, g, S, E);
    }
    SEAM(7);

    if (IN(8)) {
        __syncthreads();
        pg8::Gemm g{(const bf16*)(ws + WS_ACT), (const bf16*)(ws + WS_WDN), M, 1024, FF, FF, FF, 0}; pg8::StaticOrder S; S.init(M, 1024, G, bx, 1);
        pg8::EpiResid<1> E{nullptr, nullptr, nullptr, (bf16*)(ws + WS_HB), (float*)(ws + WS_SSP2)}; pg8::gemm_phase(lds, g, S, E);
    }
    SEAM(8);

    if (IN(9)) {
        const f32x4* gr = (const f32x4*)args.in[24];
        const int c8a = lane * 8, c8b = (lane + 64) * 8;
        const f32x4 ga0 = gr[c8a / 4], ga1 = gr[c8a / 4 + 1], gb0 = gr[c8b / 4], gb1 = gr[c8b / 4 + 1];
        for (int m = gw * 4; m < M; m += NGW * 4) {
            float pv[4]; v4u ha[4], hb4[4];
#pragma unroll
            for (int r = 0; r < 4; ++r) { pv[r] = (lane < 16) ? ((const float*)(ws + WS_SSP2))[(size_t)(m + r) * 16 + lane] : 0.f;
                const bf16* hr = (const bf16*)(ws + WS_HB) + (size_t)(m + r) * D; ha[r] = *(const v4u*)(hr + c8a); hb4[r] = *(const v4u*)(hr + c8b); }
#pragma unroll
            for (int r = 0; r < 4; ++r) { const float rs = 1.0f / sqrtf(wave_sum(pv[r]) * (1.f / 1024.f) + 1e-6f);
                f32x4* xr = (f32x4*)(args.out + (size_t)(m + r) * D); pg8::f32x4 v0, v1;
                pg8::unpack8(ha[r], v0, v1); xr[c8a / 4] = v0 * rs * ga0; xr[c8a / 4 + 1] = v1 * rs * ga1;
                pg8::unpack8(hb4[r], v0, v1); xr[c8b / 4] = v0 * rs * gb0; xr[c8b / 4 + 1] = v1 * rs * gb1; } }
    }
#undef IN
#undef SEAM
}

#ifndef DBG_PH
#define DBG_PH 0
#endif
struct DumpSeg { size_t off; unsigned n; unsigned pad; };
struct DumpArgs { float* out; const unsigned char* ws; DumpSeg s[6]; };
__global__ void dbg_dump(DumpArgs a) {
    size_t base = 0;
    float mag = 1e12f;
    for (int k = 0; k < 6; ++k, mag *= 0.1f) { const unsigned short* src = (const unsigned short*)(a.ws + a.s[k].off);
        for (size_t i = (size_t)blockIdx.x * blockDim.x + threadIdx.x; i < a.s[k].n; i += (size_t)gridDim.x * blockDim.x) a.out[base + i] = ((src[i] & 0x7f80u) == 0x7f80u) ? mag : 0.f;
        base += a.s[k].n; }
    for (size_t i = base + (size_t)blockIdx.x * blockDim.x + threadIdx.x; i < (size_t)M * D; i += (size_t)gridDim.x * blockDim.x) a.out[i] = 0.f;
}
extern "C" void kernel_launch(void* const* d_in, const int* in_sizes, int n_in, void* d_out, int out_size, void* d_ws, size_t ws_size, hipStream_t stream) {
    static int grid = 0;
    if (grid == 0) {
        if (n_in != 25 || out_size != M * D || ws_size < WS_END) { fprintf(stderr, "kernel_launch: unexpected shapes (n_in %d out %d ws %zu)\n", n_in, out_size, ws_size); grid = -1; return; }
        int dev = 0, cus = 0, per_cu = 0;
        if (hipGetDevice(&dev) != hipSuccess || hipDeviceGetAttribute(&cus, hipDeviceAttributeMultiprocessorCount, dev) != hipSuccess) { grid = -1; return; }
        if (hipOccupancyMaxActiveBlocksPerMultiprocessor(&per_cu, (const void*)fwd_megakernel, NWAVES * 64, 0) != hipSuccess || per_cu < 1) { fprintf(stderr, "kernel_launch: occupancy query says %d\n", per_cu); per_cu = 1; }
        (void)hipGetLastError();
        grid = cus;
    }
    if (grid < 0) return;
    Args a{};
    for (int i = 0; i < 25; ++i) a.in[i] = (const float*)d_in[i];
    a.out = (float*)d_out; a.ws = (unsigned char*)d_ws;
#if MK_N_LAUNCHES == 1
    if (hipMemsetAsync(d_ws, 0, 65536, stream) != hipSuccess) { fprintf(stderr, "kernel_launch: memset of the barrier words failed\n"); return; }
    a.ph_lo = 0; a.ph_hi = N_PHASES;
    void* kargs[] = {&a};
    hipError_t e = hipLaunchCooperativeKernel((const void*)fwd_megakernel, dim3(grid), dim3(NWAVES * 64), kargs, 0, stream);
    if (e != hipSuccess) fprintf(stderr, "kernel_launch: cooperative launch failed: %s (grid %d)\n", hipGetErrorString(e), grid);
#else
    const int np = DBG_PH ? DBG_PH + 1 : N_PHASES;
    for (int p = 0; p < np; ++p) { a.ph_lo = p; a.ph_hi = p + 1; hipLaunchKernelGGL(fwd_megakernel, dim3(grid), dim3(NWAVES * 64), 0, stream, a); }
#if DBG_PH && DBG_PH < 8
    { DumpArgs da{}; da.out = (float*)d_out; da.ws = (const unsigned char*)d_ws;
      DBG_SEGS
      hipLaunchKernelGGL(dbg_dump, dim3(2048), dim3(256), 0, stream, da); }
#endif
#endif
}
```

```cpp
#include <hip/hip_runtime.h>
#include <hip/hip_cooperative_groups.h>
#include <cstdio>
#include <cstdint>
namespace cg = cooperative_groups;

#define DBG_PH 0
#define DBG_SEGS da.s[0] = {WS_GATES, 12u << 20, 0}; da.s[1] = {WS_OG, 12u << 20, 0}; da.s[2] = {WS_MQ, 12u << 20, 0}; da.s[3] = {WS_YG, 8u << 20, 0}; da.s[4] = {WS_OMRG, 8u << 20, 0}; da.s[5] = {WS_MG, 12u << 20, 0};
#ifndef PROBE_G7
#define PROBE_G7 1
#endif
#ifndef PROBE_REP
#define PROBE_REP 1
#define PROBE_P3 1
#endif
#ifndef MK_N_LAUNCHES
#define MK_N_LAUNCHES 1
#endif

namespace pg8 {
#define PG8_LAS __attribute__((address_space(3)))
typedef unsigned short bf16_t;
typedef short bf16x8 __attribute__((ext_vector_type(8)));
typedef float f32x4 __attribute__((ext_vector_type(4)));
typedef unsigned u32x4 __attribute__((ext_vector_type(4)));
constexpr int BM = 256, BK = 64, HALF = 128, HTB = HALF * BK * 2, STAGE_BYTES = 8 * HTB, NXCD = 8, WGM = 8;

__host__ __device__ __forceinline__ int lds_byte(int r, int c) { const int st = (r >> 4) * 2 + (c >> 5), rr = r & 15, cc = c & 31, ob = rr * 64 + cc * 2; return st * 1024 + (ob ^ (((ob >> 9) & 1) << 5)); }
__host__ __device__ __forceinline__ void stage_rc(int b, int& R, int& C) { const int st = b / 1024, sb = b % 1024, swz = sb ^ (((sb >> 9) & 1) << 5); R = (st >> 1) * 16 + swz / 64; C = (st & 1) * 32 + (swz % 64) / 2; }
__host__ __device__ __forceinline__ int perm32(int rho) { const int n = rho >> 4, i = rho & 15; return 8 * (i >> 2) + 4 * n + (i & 3); }

struct Unit { int pm, pn; };
struct Gemm { const bf16_t* A; const bf16_t* Bt; int M, N, K; int lda, ldb; int bdil; };
__device__ __forceinline__ const char* a_tile(const Gemm& g, int pm) { return (const char*)g.A + (size_t)pm * 256 * (size_t)g.lda * 2; }
__device__ __forceinline__ const char* b_tile(const Gemm& g, int pn) {
    if (g.bdil == 0) return (const char*)g.Bt + (size_t)pn * 256 * (size_t)g.ldb * 2;
    const int d = g.bdil, Ld = 8192 / d, b = pn >> 5, pp0 = (pn & 31) * 256, r = pp0 / Ld, j0 = pp0 % Ld;
    return (const char*)g.Bt + ((size_t)b * 8192 + (size_t)j0 * d + r) * 1024 * 2;
}

struct StaticOrder {
    int nM, nN, nwg, G, c, rev, revi;
    __host__ __device__ void init(int M, int N, int G_, int c_, int rev_ = 0, int revi_ = 0) { nM = M / BM; nN = N / BM; nwg = nM * nN; G = G_; c = c_; rev = rev_; revi = revi_; }
    __host__ __device__ bool next(int i, Unit& u) const {
        if ((long)i * G + c >= nwg) return false;
        const long L = (long)(revi ? (nwg / G - 1 - i) : i) * G + c;
        int wgid = (int)L; { const int q = nwg / NXCD, r = nwg % NXCD, xcd = wgid % NXCD, off = wgid / NXCD; wgid = (xcd < r ? xcd * (q + 1) : r * (q + 1) + (xcd - r) * q) + off; }
        const int nig = WGM * nN, gid = wgid / nig, fm = gid * WGM, gsz = (nM - fm) < WGM ? (nM - fm) : WGM;
        u.pm = fm + ((wgid % nig) % gsz); u.pn = (wgid % nig) / gsz; if (rev) u.pm = nM - 1 - u.pm; return true;
    }
};

typedef float f32x2_ __attribute__((ext_vector_type(2))); typedef __bf16 bf16x2_ __attribute__((ext_vector_type(2)));
__device__ __forceinline__ unsigned cvt_pk_bf16(float lo, float hi) { f32x2_ v = {lo, hi}; bf16x2_ b = __builtin_convertvector(v, bf16x2_); return __builtin_bit_cast(unsigned, b); }
__device__ __forceinline__ float bf_lo(unsigned w) { return __builtin_bit_cast(float, w << 16); }
__device__ __forceinline__ float bf_hi(unsigned w) { return __builtin_bit_cast(float, w & 0xffff0000u); }
__device__ __forceinline__ u32x4 pack8(const f32x4 v0, const f32x4 v1) { u32x4 w; w.x = cvt_pk_bf16(v0[0], v0[1]); w.y = cvt_pk_bf16(v0[2], v0[3]); w.z = cvt_pk_bf16(v1[0], v1[1]); w.w = cvt_pk_bf16(v1[2], v1[3]); return w; }
__device__ __forceinline__ void unpack8(const u32x4 w, f32x4& v0, f32x4& v1) { v0 = (f32x4){bf_lo(w.x), bf_hi(w.x), bf_lo(w.y), bf_hi(w.y)}; v1 = (f32x4){bf_lo(w.z), bf_hi(w.z), bf_lo(w.w), bf_hi(w.w)}; }
typedef unsigned u32x2 __attribute__((ext_vector_type(2)));
__device__ __forceinline__ unsigned q8x4(const f32x4 v) {
    unsigned r = 0u;
    r = __builtin_amdgcn_cvt_pk_u8_f32(__builtin_rintf(v[0] * 255.f), 0, r); r = __builtin_amdgcn_cvt_pk_u8_f32(__builtin_rintf(v[1] * 255.f), 1, r);
    r = __builtin_amdgcn_cvt_pk_u8_f32(__builtin_rintf(v[2] * 255.f), 2, r); r = __builtin_amdgcn_cvt_pk_u8_f32(__builtin_rintf(v[3] * 255.f), 3, r); return r; }
__device__ __forceinline__ f32x4 dq8x4(unsigned w) { const float k = 1.f / 255.f;
    return (f32x4){(float)(w & 0xffu) * k, (float)((w >> 8) & 0xffu) * k, (float)((w >> 16) & 0xffu) * k, (float)(w >> 24) * k}; }
__device__ __forceinline__ float sigm(float x) { return __builtin_amdgcn_rcpf(1.f + __builtin_amdgcn_exp2f(-1.4426950408889634f * x)); }

#define EPI_LOOP _Pragma("unroll") for (int ai = 0; ai < 2; ++ai) _Pragma("unroll") for (int m = 0; m < 4; ++m) _Pragma("unroll") for (int bj = 0; bj < 2; ++bj)
#define EPI_ROW (u.pm * 256 + ai * 128 + wr * 64 + m * 16 + fr)
#define EPI_COL (u.pn * 256 + bj * 128 + wc * 32 + 8 * fq)
typedef f32x4 AccT[2][2][4][2];

struct EpiPlain {
    bf16_t* O; size_t ldc;
    __device__ __forceinline__ void operator()(const AccT& acc, const Unit& u, int wr, int wc, int fr, int fq) const {
        EPI_LOOP { const int row = EPI_ROW, col = EPI_COL; *(u32x4*)(O + (size_t)row * ldc + col) = pack8(acc[ai][bj][m][0], acc[ai][bj][m][1]); }
    }
};
struct EpiVTf {
    bf16_t* O; int mem; int g;
    __device__ __forceinline__ void operator()(const AccT& acc, const Unit& u, int wr, int wc, int fr, int fq) const {
        EPI_LOOP { const int row = EPI_ROW, col = EPI_COL;
            int e, kk; size_t tb;
            if (mem) { const int h = row >> 7, b = col >> 8; e = row & 127; kk = col & 255; tb = ((size_t)((b * 4 + h) * 8 + (kk >> 5))) * 4096; }
            else { const int hh = row >> 6, b = col >> 13; e = row & 63; kk = col & 8191; tb = (((size_t)(g * 8 + b) * 4 + hh) * 8192) * 64 + (size_t)(kk >> 5) * 2048; }
            const int t = e >> 5, c = e & 31, k0 = kk & 31, s2 = k0 >> 4, half = (k0 >> 3) & 1;
            bf16_t* d0 = O + tb + (((t * 2 + s2) * 2 + 0) * 32 + c) * 8 + half * 4;
            const f32x4 v0 = acc[ai][bj][m][0], v1 = acc[ai][bj][m][1];
            typedef unsigned u32x2 __attribute__((ext_vector_type(2)));
            u32x2 w0, w1; w0.x = cvt_pk_bf16(v0[0], v0[1]); w0.y = cvt_pk_bf16(v0[2], v0[3]); w1.x = cvt_pk_bf16(v1[0], v1[1]); w1.y = cvt_pk_bf16(v1[2], v1[3]);
            *(u32x2*)d0 = w0; *(u32x2*)(d0 + 256) = w1; }
    }
};
struct EpiMKf {
    bf16_t* O;
    __device__ __forceinline__ void operator()(const AccT& acc, const Unit& u, int wr, int wc, int fr, int fq) const {
        EPI_LOOP { const int row = EPI_ROW, col = EPI_COL; const int b = row >> 8, key = row & 255, h = col >> 7, e = col & 127;
            *(u32x4*)(O + ((size_t)((b * 4 + h) * 8 + (key >> 5))) * 4096 + (((e >> 4) * 2 + ((e >> 3) & 1)) * 32 + (key & 31)) * 8) = pack8(acc[ai][bj][m][0], acc[ai][bj][m][1]); }
    }
};
struct EpiInProj {
    bf16_t *U, *Q, *Kb, *MQ, *GATES; const float* b_gate;
    __device__ __forceinline__ void operator()(const AccT& acc, const Unit& u, int wr, int wc, int fr, int fq) const {
        const int pn = u.pn;
        if (pn < 2) { EPI_LOOP { const int row = EPI_ROW, col = EPI_COL; *(u32x4*)(U + (size_t)row * 512 + col) = pack8(acc[ai][bj][m][0], acc[ai][bj][m][1]); } }
        else if (pn < 8) {
            const int g = (pn < 5) ? pn - 2 : pn - 5; bf16_t* base = (pn < 5) ? Q : Kb; const int sh = 2 * g  , Ld = 8192 >> sh, dm = (1 << sh) - 1;
            const bool isk = (pn >= 5);
            EPI_LOOP { const int row = EPI_ROW, colw = bj * 128 + wc * 32 + 8 * fq; const int hh = colw >> 6, e = colw & 63, b = row >> 13, t = row & 8191;
                const int pp = (t & dm) * Ld + (t >> sh);
                const size_t hbase = (((size_t)(g * 8 + b) * 4 + hh) * 8192) * 64;
                const size_t off = isk ? hbase + (size_t)(pp >> 5) * 2048 + ((((e >> 4) * 2 + ((e >> 3) & 1)) * 32 + (pp & 31)) * 8) : hbase + (size_t)pp * 64 + e;
                *(u32x4*)(base + off) = pack8(acc[ai][bj][m][0], acc[ai][bj][m][1]); }
        }
        else if (pn < 10) { EPI_LOOP { const int row = EPI_ROW, col = EPI_COL - 2048; *(u32x4*)(MQ + (size_t)row * 512 + col) = pack8(acc[ai][bj][m][0], acc[ai][bj][m][1]); } }
        else {
            f32x4 bb0[2], bb1[2];
#pragma unroll
            for (int bj = 0; bj < 2; ++bj) { const int col = EPI_COL - 2560; bb0[bj] = *(const f32x4*)(b_gate + col); bb1[bj] = *(const f32x4*)(b_gate + col + 4); }
            EPI_LOOP { const int row = EPI_ROW, col = EPI_COL - 2560;
                f32x4 v0 = acc[ai][bj][m][0] + bb0[bj], v1 = acc[ai][bj][m][1] + bb1[bj];
#pragma unroll
                for (int i = 0; i < 4; ++i) { v0[i] = sigm(v0[i]); v1[i] = sigm(v1[i]); }
                u32x2 w; w.x = q8x4(v0); w.y = q8x4(v1);
                *(u32x2*)((unsigned char*)GATES + (size_t)row * 3072 + col) = w; }
        }
    }
};
struct EpiGlu {
    const bf16_t* YG; bf16_t* Y2; const float* b;
    __device__ __forceinline__ void operator()(const AccT& acc, const Unit& u, int wr, int wc, int fr, int fq) const {
        f32x4 bb0[2], bb1[2];
#pragma unroll
        for (int bj = 0; bj < 2; ++bj) { const int col = EPI_COL; bb0[bj] = *(const f32x4*)(b + col); bb1[bj] = *(const f32x4*)(b + col + 4); }
#pragma unroll
        for (int ai = 0; ai < 2; ++ai) {
            u32x4 yv[4][2];
#pragma unroll
            for (int m = 0; m < 4; ++m)
#pragma unroll
                for (int bj = 0; bj < 2; ++bj) { const int row = EPI_ROW, col = EPI_COL; yv[m][bj] = *(const u32x4*)(YG + (size_t)row * 512 + col); }
#pragma unroll
            for (int m = 0; m < 4; ++m)
#pragma unroll
                for (int bj = 0; bj < 2; ++bj) { const int row = EPI_ROW, col = EPI_COL;
                    f32x4 y0, y1; unpack8(yv[m][bj], y0, y1);
                    f32x4 v0 = acc[ai][bj][m][0] + bb0[bj], v1 = acc[ai][bj][m][1] + bb1[bj];
#pragma unroll
                    for (int i = 0; i < 4; ++i) { v0[i] = y0[i] * sigm(v0[i]); v1[i] = y1[i] * sigm(v1[i]); }
                    *(u32x4*)(Y2 + (size_t)row * 512 + col) = pack8(v0, v1); }
        }
    }
};
template <int MODE> struct EpiBranch {
    const bf16_t* GATES; bf16_t* MG; int goff;
    __device__ __forceinline__ void operator()(const AccT& acc, const Unit& u, int wr, int wc, int fr, int fq) const {
#pragma unroll
        for (int ai = 0; ai < 2; ++ai) {
            u32x2 gv[4][2]; u32x4 pv[4][2];
#pragma unroll
            for (int m = 0; m < 4; ++m)
#pragma unroll
                for (int bj = 0; bj < 2; ++bj) { const int row = EPI_ROW, col = EPI_COL; gv[m][bj] = *(const u32x2*)((const unsigned char*)GATES + (size_t)row * 3072 + goff + col);
                    if (MODE == 1) pv[m][bj] = *(const u32x4*)(MG + (size_t)row * 1024 + col); }
#pragma unroll
            for (int m = 0; m < 4; ++m)
#pragma unroll
                for (int bj = 0; bj < 2; ++bj) { const int row = EPI_ROW, col = EPI_COL; const f32x4 g0 = dq8x4(gv[m][bj].x), g1 = dq8x4(gv[m][bj].y);
                    f32x4 v0 = acc[ai][bj][m][0] * g0, v1 = acc[ai][bj][m][1] * g1;
                    if (MODE == 1) { f32x4 p0, p1; unpack8(pv[m][bj], p0, p1); v0 += p0; v1 += p1; }
                    *(u32x4*)(MG + (size_t)row * 1024 + col) = pack8(v0, v1); }
        }
    }
};
template <int MODE> struct EpiResid {
    const bf16_t* XN; const float* XS; const float* G1; bf16_t* HB; float* SS;
    __device__ __forceinline__ void operator()(const AccT& acc, const Unit& u, int wr, int wc, int fr, int fq) const {
        f32x4 ig0[2], ig1[2];
        if (MODE == 0) {
#pragma unroll
            for (int bj = 0; bj < 2; ++bj) { const int col = EPI_COL; const f32x4 a = *(const f32x4*)(G1 + col), b = *(const f32x4*)(G1 + col + 4);
#pragma unroll
                for (int i = 0; i < 4; ++i) { ig0[bj][i] = 1.0f / a[i]; ig1[bj][i] = 1.0f / b[i]; } }
        }
#pragma unroll
        for (int ai = 0; ai < 2; ++ai) {
            u32x4 hv[4][2]; float xs[4];
#pragma unroll
            for (int m = 0; m < 4; ++m) { const int row = EPI_ROW; if (MODE == 0) xs[m] = XS[row];
#pragma unroll
                for (int bj = 0; bj < 2; ++bj) { const int col = EPI_COL; const size_t o = (size_t)row * 1024 + col;
                    hv[m][bj] = *(const u32x4*)((MODE == 0 ? XN : HB) + o); } }
#pragma unroll
            for (int m = 0; m < 4; ++m) { const int row = EPI_ROW; float ss = 0.f;
#pragma unroll
                for (int bj = 0; bj < 2; ++bj) { const int col = EPI_COL; const size_t o = (size_t)row * 1024 + col;
                    f32x4 r0, r1; unpack8(hv[m][bj], r0, r1);
                    if (MODE == 0) { r0 = r0 * xs[m] * ig0[bj]; r1 = r1 * xs[m] * ig1[bj]; }
                    const f32x4 v0 = acc[ai][bj][m][0] + r0, v1 = acc[ai][bj][m][1] + r1;
                    *(u32x4*)(HB + o) = pack8(v0, v1);
                    ss += (v0[0] * v0[0] + v0[1] * v0[1]) + (v0[2] * v0[2] + v0[3] * v0[3]) + (v1[0] * v1[0] + v1[1] * v1[1]) + (v1[2] * v1[2] + v1[3] * v1[3]); }
                ss += __shfl_xor(ss, 16); ss += __shfl_xor(ss, 32);
                if (fq == 0) SS[(size_t)row * 16 + u.pn * 4 + wc] = ss; }
        }
    }
};
struct EpiUp {
    const float* SS; bf16_t* ACT;
    __device__ __forceinline__ void operator()(const AccT& acc, const Unit& u, int wr, int wc, int fr, int fq) const {
        float rsv[2][4];
#pragma unroll
        for (int ai = 0; ai < 2; ++ai) { f32x4 q[4][4];
#pragma unroll
            for (int m = 0; m < 4; ++m) { const int row = EPI_ROW; const f32x4* sp = (const f32x4*)(SS + (size_t)row * 16);
#pragma unroll
                for (int k = 0; k < 4; ++k) q[m][k] = sp[k]; }
#pragma unroll
            for (int m = 0; m < 4; ++m) { const float tot = ((q[m][0][0] + q[m][0][1]) + (q[m][0][2] + q[m][0][3])) + ((q[m][1][0] + q[m][1][1]) + (q[m][1][2] + q[m][1][3])) + ((q[m][2][0] + q[m][2][1]) + (q[m][2][2] + q[m][2][3])) + ((q[m][3][0] + q[m][3][1]) + (q[m][3][2] + q[m][3][3]));
                rsv[ai][m] = 1.0f / sqrtf(tot * (1.f / 1024.f) + 1e-6f); } }
#pragma unroll
        for (int ai = 0; ai < 2; ++ai)
#pragma unroll
            for (int m = 0; m < 4; ++m) { const int row = EPI_ROW; const float rs = rsv[ai][m];
#pragma unroll
                for (int bj = 0; bj < 2; ++bj) { const int col = EPI_COL; f32x4 v0 = acc[ai][bj][m][0] * rs, v1 = acc[ai][bj][m][1] * rs;
#pragma unroll
                    for (int i = 0; i < 4; ++i) { const float a = fmaxf(v0[i], 0.f), b = fmaxf(v1[i], 0.f); v0[i] = a * a; v1[i] = b * b; }
                    *(u32x4*)(ACT + (size_t)row * 4096 + col) = pack8(v0, v1); } }
    }
};

template <class Epi>
__device__ __forceinline__ void gemm_phase(PG8_LAS unsigned char* lds, const Gemm g, const StaticOrder& S, const Epi& E) {
    const int tid = threadIdx.x, wid = __builtin_amdgcn_readfirstlane(tid >> 6), lane = tid & 63, wr = wid >> 2, wc = wid & 3, fr = lane & 15, fq = lane >> 4;
    const int K = g.K, nt = K / BK;
    unsigned voffA[2], voffB[2];
#pragma unroll
    for (int i = 0; i < 2; ++i) { int R, C; stage_rc(tid * 16 + i * 8192, R, C); const int Rb = (R & ~31) + perm32(R & 31);
        voffA[i] = (unsigned)(R * g.lda + C) * 2u; voffB[i] = (unsigned)(Rb * g.ldb + C) * 2u; }
    const size_t kstep = (size_t)(BK * 2);
    const size_t hstepA = (size_t)HALF * g.lda * 2, hstepB = (size_t)HALF * g.ldb * 2;
    const unsigned ldsw = (unsigned)wid * 1024u;
    const int aoff = lds_byte(wr * 64 + fr, fq * 8), boff = lds_byte(wc * 32 + fr, fq * 8);
#define PG8_SA(b, h) (((b) * 2 + (h)) * HTB)
#define PG8_SB(b, h) ((4 + (b) * 2 + (h)) * HTB)
#define PG8_STAGE(bufoff, gbase, voff) do { _Pragma("unroll") for (int _i = 0; _i < 2; ++_i) \
        __builtin_amdgcn_global_load_lds((const unsigned*)((const char*)(gbase) + (voff)[_i]), (PG8_LAS unsigned*)(lds + (bufoff) + ldsw + _i * 8192), 16, 0, 0); } while (0)
#define PG8_LDA(dst, b, h) do { _Pragma("unroll") for (int m = 0; m < 4; ++m) _Pragma("unroll") for (int k = 0; k < 2; ++k) dst[m][k] = *(const PG8_LAS bf16x8*)(lds + PG8_SA(b, h) + aoff + m * 2048 + k * 1024); } while (0)
#define PG8_LDB(dst, b, h) do { _Pragma("unroll") for (int n = 0; n < 2; ++n) _Pragma("unroll") for (int k = 0; k < 2; ++k) dst[n][k] = *(const PG8_LAS bf16x8*)(lds + PG8_SB(b, h) + boff + n * 2048 + k * 1024); } while (0)
#define PG8_MMA(ai, bj, At, Bt) do { __builtin_amdgcn_s_setprio(1); _Pragma("unroll") for (int m = 0; m < 4; ++m) _Pragma("unroll") for (int n = 0; n < 2; ++n) _Pragma("unroll") for (int k = 0; k < 2; ++k) \
        acc[ai][bj][m][n] = __builtin_amdgcn_mfma_f32_16x16x32_bf16(Bt[n][k], At[m][k], acc[ai][bj][m][n], 0, 0, 0); __builtin_amdgcn_s_setprio(0); } while (0)
#define PG8_WAIT_V(n) asm volatile("s_waitcnt vmcnt(" #n ")" ::: "memory")
#define PG8_WAIT_L(n) asm volatile("s_waitcnt lgkmcnt(" #n ")" ::: "memory")
#define PG8_BAR __builtin_amdgcn_s_barrier()
#define PG8_SCHED __builtin_amdgcn_sched_barrier(0)
    Unit cur, nxt; int ui = 0;
    if (!S.next(0, cur)) return;
    f32x4 acc[2][2][4][2];
#pragma unroll
    for (int a = 0; a < 2; ++a)
#pragma unroll
        for (int b = 0; b < 2; ++b)
#pragma unroll
            for (int m = 0; m < 4; ++m)
#pragma unroll
                for (int n = 0; n < 2; ++n) acc[a][b][m][n] = (f32x4){0.f, 0.f, 0.f, 0.f};
    bf16x8 At[4][2], B0[2][2], B1[2][2];
    const char* cA = a_tile(g, cur.pm); const char* cB = b_tile(g, cur.pn);
    PG8_STAGE(PG8_SB(0, 0), cB, voffB); PG8_STAGE(PG8_SB(0, 1), cB + hstepB, voffB); PG8_STAGE(PG8_SA(0, 0), cA, voffA); PG8_STAGE(PG8_SA(0, 1), cA + hstepA, voffA);
    if (wr == 1) PG8_BAR;
    PG8_WAIT_V(2); PG8_BAR;
    PG8_STAGE(PG8_SB(1, 0), cB + kstep, voffB); PG8_STAGE(PG8_SA(1, 0), cA + kstep, voffA); PG8_STAGE(PG8_SB(1, 1), cB + hstepB + kstep, voffB);
    PG8_WAIT_V(6); PG8_BAR;
    for (;;) {
        const bool has_next = S.next(ui + 1, nxt);
        const char* nA = has_next ? a_tile(g, nxt.pm) : cA; const char* nB = has_next ? b_tile(g, nxt.pn) : cB;
        for (int t = 0; t < nt; t += 2) {
            const bool last = (t == nt - 2);
            const char* a1 = cA + (size_t)(t + 1) * kstep;
            const char* a2 = last ? nA : cA + (size_t)(t + 2) * kstep; const char* b2 = last ? nB : cB + (size_t)(t + 2) * kstep;
            const char* a3 = a2 + kstep; const char* b3 = b2 + kstep;
            PG8_LDB(B0, 0, 0); PG8_LDB(B1, 0, 1); PG8_SCHED; PG8_LDA(At, 0, 0); PG8_STAGE(PG8_SA(1, 1), a1 + hstepA, voffA);
            PG8_WAIT_V(8); PG8_WAIT_L(0); PG8_BAR; PG8_MMA(0, 0, At, B0); PG8_MMA(0, 1, At, B1); PG8_BAR; PG8_SCHED;
            PG8_LDA(At, 0, 1); PG8_STAGE(PG8_SB(0, 0), b2, voffB); PG8_STAGE(PG8_SB(0, 1), b2 + hstepB, voffB); PG8_STAGE(PG8_SA(0, 0), a2, voffA);
            PG8_WAIT_V(8); PG8_WAIT_L(0); PG8_BAR; PG8_MMA(1, 0, At, B0); PG8_MMA(1, 1, At, B1); PG8_BAR; PG8_SCHED;
            PG8_LDB(B0, 1, 0); PG8_LDB(B1, 1, 1); PG8_SCHED; PG8_LDA(At, 1, 0); PG8_STAGE(PG8_SA(0, 1), a2 + hstepA, voffA);
            PG8_WAIT_V(8); PG8_WAIT_L(0); PG8_BAR; PG8_MMA(0, 0, At, B0); PG8_MMA(0, 1, At, B1); PG8_BAR; PG8_SCHED;
            PG8_LDA(At, 1, 1); PG8_STAGE(PG8_SB(1, 0), b3, voffB); PG8_STAGE(PG8_SB(1, 1), b3 + hstepB, voffB); PG8_STAGE(PG8_SA(1, 0), a3, voffA);
            PG8_WAIT_V(8); PG8_WAIT_L(0); PG8_BAR; PG8_MMA(1, 0, At, B0); PG8_MMA(1, 1, At, B1); PG8_BAR; PG8_SCHED;
        }
        if (wr == 0) PG8_BAR;
        E(acc, cur, wr, wc, fr, fq);
        if (!has_next) break;
#pragma unroll
        for (int a = 0; a < 2; ++a)
#pragma unroll
            for (int b = 0; b < 2; ++b)
#pragma unroll
                for (int m = 0; m < 4; ++m)
#pragma unroll
                    for (int n = 0; n < 2; ++n) acc[a][b][m][n] = (f32x4){0.f, 0.f, 0.f, 0.f};
        cur = nxt; cA = nA; cB = nB; ++ui;
        if (wr == 1) PG8_BAR;
    }
    PG8_WAIT_V(0);
    PG8_BAR;
#undef PG8_SA
#undef PG8_SB
#undef PG8_STAGE
#undef PG8_LDA
#undef PG8_LDB
#undef PG8_MMA
#undef PG8_WAIT_V
#undef PG8_WAIT_L
#undef PG8_BAR
#undef PG8_SCHED
}
}

constexpr int NWAVES = 8;
constexpr int BATCH = 8, SEQ = 8192, D = 1024, M = BATCH * SEQ, FF = 4096;
constexpr int NIN = 5632;
constexpr int N_PHASES = 10;

constexpr size_t MiB = 1u << 20;
constexpr size_t WS_BAR = 0;
constexpr size_t WS_SSMA = 512 * 1024;
constexpr size_t WS_SSMB = 576 * 1024;
constexpr size_t WS_SSMC = 704 * 1024;
constexpr size_t WS_WIN = 2 * MiB;
constexpr size_t WS_WV = 13 * MiB;
constexpr size_t WS_WGLU = 15 * MiB;
constexpr size_t WS_WSSM = 16 * MiB;
constexpr size_t WS_WATT = 17 * MiB;
constexpr size_t WS_WMKV = 18 * MiB;
constexpr size_t WS_WMEM = 20 * MiB;
constexpr size_t WS_WO = 21 * MiB;
constexpr size_t WS_WUP = 23 * MiB;
constexpr size_t WS_WDN = 31 * MiB;
constexpr size_t WS_MEMN = 40 * MiB;
constexpr size_t WS_MK = 44 * MiB;
constexpr size_t WS_MVT = 46 * MiB;
constexpr size_t WS_E = 48 * MiB;
constexpr size_t WS_SSP1 = 56 * MiB, WS_SSP2 = 60 * MiB;
constexpr size_t WS_XN = 64 * MiB;
constexpr size_t WS_OG = 512 * MiB, WS_LSE = 608 * MiB;
constexpr size_t WS_XS = 128 * 1024;
constexpr size_t WS_U = 192 * MiB;
constexpr size_t WS_MQ = 256 * MiB;
constexpr size_t WS_HB = 192 * MiB;
constexpr size_t WS_GATES = 320 * MiB;
constexpr size_t WS_Q = 704 * MiB, WS_K = 800 * MiB, WS_VT = 896 * MiB;
constexpr size_t WS_YG = 704 * MiB, WS_Y2 = 768 * MiB, WS_OMRG = 832 * MiB, WS_MG = 864 * MiB;
constexpr size_t WS_ACT = 320 * MiB;
constexpr size_t WS_END = 992 * MiB;

constexpr int LDS_BYTES = 147456;

#define LAS __attribute__((address_space(3)))
typedef unsigned short bf16;
typedef unsigned v4u __attribute__((ext_vector_type(4)));
typedef unsigned v2u __attribute__((ext_vector_type(2)));
typedef float f32x4 __attribute__((ext_vector_type(4)));
typedef float f32x2 __attribute__((ext_vector_type(2)));
typedef float f32x16 __attribute__((ext_vector_type(16)));
typedef short bf16x8 __attribute__((ext_vector_type(8)));
typedef short s16x4 __attribute__((ext_vector_type(4)));
typedef __bf16 bf16x2_t __attribute__((ext_vector_type(2)));
__device__ __forceinline__ unsigned cvtpk(float lo, float hi) { f32x2 v = {lo, hi}; bf16x2_t b = __builtin_convertvector(v, bf16x2_t); return __builtin_bit_cast(unsigned, b); }
__device__ __forceinline__ float wave_sum(float v) {
#pragma unroll
    for (int o = 1; o < 64; o <<= 1) v += __shfl_xor(v, o);
    return v;
}
__device__ __forceinline__ float bf2f(bf16 b) { return __builtin_bit_cast(float, (unsigned)b << 16); }

struct Args { const float* in[25]; float* out; unsigned char* ws; int ph_lo, ph_hi; };

__device__ __forceinline__ void p0_transpose_item(const float* W, int ldw, int c0, int K, int nblk, bf16* WT, int row_off, const float* scale, LAS float* scr, int item, int lane) {
    const int kb = item / nblk, nb = item % nblk, k0 = 64 * kb, n0 = 32 * nb;
#pragma unroll 8
    for (int i = 0; i < 32; ++i) { const int kk = 2 * i + (lane >> 5); float v = W[(size_t)(k0 + kk) * ldw + c0 + n0 + (lane & 31)]; if (scale) v *= scale[k0 + kk]; scr[kk * 33 + (lane & 31)] = v; }
    asm volatile("s_waitcnt lgkmcnt(0)" ::: "memory");
    const int c = lane & 7;
#pragma unroll
    for (int j = 0; j < 4; ++j) { const int n = (lane >> 3) + 8 * j; const LAS float* s = scr + (8 * c) * 33 + n;
        v4u o; o.x = cvtpk(s[0 * 33], s[1 * 33]); o.y = cvtpk(s[2 * 33], s[3 * 33]); o.z = cvtpk(s[4 * 33], s[5 * 33]); o.w = cvtpk(s[6 * 33], s[7 * 33]);
        *(v4u*)(WT + (size_t)(row_off + n0 + n) * K + k0 + 8 * c) = o; }
    asm volatile("s_waitcnt lgkmcnt(0)" ::: "memory");
}
template <int NR>
__device__ __forceinline__ void rms_rows_to_bf16(const float* xrow, size_t rs, const float* g, bf16* orow, int lane, float* xs_out) {
    const f32x4* gr = (const f32x4*)g + lane;
    f32x4 v[NR][4]; float s[NR];
#pragma unroll
    for (int r = 0; r < NR; ++r) { const f32x4* xr = (const f32x4*)(xrow + r * rs) + lane; s[r] = 0.f;
#pragma unroll
        for (int j = 0; j < 4; ++j) v[r][j] = xr[64 * j]; }
    f32x4 gg[4];
#pragma unroll
    for (int j = 0; j < 4; ++j) gg[j] = gr[64 * j];
#pragma unroll
    for (int r = 0; r < NR; ++r) {
#pragma unroll
        for (int j = 0; j < 4; ++j) s[r] += (v[r][j].x * v[r][j].x + v[r][j].y * v[r][j].y) + (v[r][j].z * v[r][j].z + v[r][j].w * v[r][j].w);
        const float nrm = sqrtf(wave_sum(s[r]) * (1.f / 1024.f) + 1e-6f), rstd = 1.f / nrm;
        if (xs_out && lane == 0) xs_out[r] = nrm;
        unsigned long long* o8 = (unsigned long long*)(orow + r * rs) + lane;
#pragma unroll
        for (int j = 0; j < 4; ++j)
            o8[64 * j] = (unsigned long long)cvtpk(v[r][j].x * rstd * gg[j].x, v[r][j].y * rstd * gg[j].y) | ((unsigned long long)cvtpk(v[r][j].z * rstd * gg[j].z, v[r][j].w * rstd * gg[j].w) << 32); }
}
__device__ __forceinline__ void sincos_d(double x, double& s, double& c) {
    const double k = rint(x * 0.15915494309189535); const double y = (x - k * 6.283185307179586) - k * 2.4492935982947064e-16;
    const double y2 = y * y; double ts = 1.0, tc = 1.0;
#pragma unroll 1
    for (int n = 27; n >= 3; n -= 2) { ts = 1.0 - ts * y2 / (double)(n * (n - 1)); tc = 1.0 - tc * y2 / (double)((n - 1) * (n - 2)); }
    s = y * ts; c = tc;
}

template <int E, bool MASK>
__device__ __forceinline__ void attn_wave(const bf16* Qp, int ldq, const bf16* Kt, const bf16* Vt,
                                          int kt0, int kt1, int j0, int lane, f32x16 (&O)[E / 32], float& m_out, float& l_out) {
    constexpr int TE = 32 * E;
    const int c = lane & 31, hi = lane >> 5;
    bf16x8 qf[E / 16];
#pragma unroll
    for (int s = 0; s < E / 16; ++s) qf[s] = *(const bf16x8*)(Qp + (size_t)c * ldq + 16 * s + 8 * hi);
    float mrun = -1e30f, l = 0.f;
#pragma unroll
    for (int t = 0; t < E / 32; ++t)
#pragma unroll
        for (int i = 0; i < 16; ++i) O[t][i] = 0.f;
    const float c2 = (E == 64 ? 0.125f : 0.08838834764831845f) * 1.4426950408889634f;
    bf16x8 kf[E / 16];
#pragma unroll
    for (int s = 0; s < E / 16; ++s) kf[s] = *(const bf16x8*)(Kt + (size_t)kt0 * TE + s * 512 + lane * 8);
    for (int kt = kt0; kt <= kt1; ++kt) {
        bf16x8 vfr[E / 32][2];
#pragma unroll
        for (int t = 0; t < E / 32; ++t)
#pragma unroll
            for (int s2 = 0; s2 < 2; ++s2) vfr[t][s2] = *(const bf16x8*)(Vt + (size_t)kt * TE + (t * 2 + s2) * 512 + lane * 8);
        bf16x8 kn[E / 16];
        { const int ktn = (kt < kt1) ? kt + 1 : kt1;
#pragma unroll
          for (int s = 0; s < E / 16; ++s) kn[s] = *(const bf16x8*)(Kt + (size_t)ktn * TE + s * 512 + lane * 8); }
        f32x16 S;
#pragma unroll
        for (int i = 0; i < 16; ++i) S[i] = 0.f;
#pragma unroll
        for (int s = 0; s < E / 16; ++s) S = __builtin_amdgcn_mfma_f32_32x32x16_bf16(kf[s], qf[s], S, 0, 0, 0);
        if (MASK) {
            const bool full = (kt * 32 + 31 <= j0) && (kt * 32 + 128 >= j0 + 31);
            if (!full) { const int qj = j0 + c;
#pragma unroll
                for (int i = 0; i < 16; ++i) { const int kj = kt * 32 + (i & 3) + 8 * (i >> 2) + 4 * hi; const bool valid = (kj <= qj) && (kj + 128 >= qj); S[i] = valid ? S[i] : -1e30f; } }
        }
        float mx = S[0];
#pragma unroll
        for (int i = 1; i < 16; ++i) mx = fmaxf(mx, S[i]);
        mx = fmaxf(mx, __shfl_xor(mx, 32));
        const float mn = fmaxf(mrun, mx); const float alpha = __builtin_amdgcn_exp2f((mrun - mn) * c2); mrun = mn;
        float ps = 0.f;
#pragma unroll
        for (int i = 0; i < 16; ++i) { const float p = __builtin_amdgcn_exp2f((S[i] - mn) * c2); S[i] = p; ps += p; }
        l = l * alpha + ps;
#pragma unroll
        for (int t = 0; t < E / 32; ++t)
#pragma unroll
            for (int i = 0; i < 16; ++i) O[t][i] *= alpha;
        bf16x8 pk[2];
#pragma unroll
        for (int s2 = 0; s2 < 2; ++s2) { v4u w; w.x = cvtpk(S[8 * s2 + 0], S[8 * s2 + 1]); w.y = cvtpk(S[8 * s2 + 2], S[8 * s2 + 3]); w.z = cvtpk(S[8 * s2 + 4], S[8 * s2 + 5]); w.w = cvtpk(S[8 * s2 + 6], S[8 * s2 + 7]); pk[s2] = __builtin_bit_cast(bf16x8, w); }
#pragma unroll
        for (int t = 0; t < E / 32; ++t)
#pragma unroll
            for (int s2 = 0; s2 < 2; ++s2) O[t] = __builtin_amdgcn_mfma_f32_32x32x16_bf16(vfr[t][s2], pk[s2], O[t], 0, 0, 0);
#pragma unroll
        for (int s = 0; s < E / 16; ++s) kf[s] = kn[s];
    }
    l += __shfl_xor(l, 32);
    m_out = mrun; l_out = l;
}

__device__ __forceinline__ void sattn_wave(const bf16* Qp, const bf16* Kt, const bf16* Vt, int j0, int lane, f32x16 (&O)[2][2], float (&m_out)[2], float (&l_out)[2]) {
    const int c = lane & 31, hi = lane >> 5;
    bf16x8 qf[2][4];
#pragma unroll
    for (int q = 0; q < 2; ++q)
#pragma unroll
        for (int s = 0; s < 4; ++s) qf[q][s] = *(const bf16x8*)(Qp + (size_t)(32 * q + c) * 64 + 16 * s + 8 * hi);
    float mrun[2] = {-1e30f, -1e30f}, l[2] = {0.f, 0.f};
#pragma unroll
    for (int q = 0; q < 2; ++q)
#pragma unroll
        for (int t = 0; t < 2; ++t)
#pragma unroll
            for (int i = 0; i < 16; ++i) O[q][t][i] = 0.f;
    const float c2 = 0.125f * 1.4426950408889634f;
    const int kb = j0 >> 5, kt_end = kb + 1, kt_beg = (kb >= 4) ? kb - 4 : 0;
    bf16x8 kf[4], vfr[2][2];
#pragma unroll
    for (int s = 0; s < 4; ++s) kf[s] = *(const bf16x8*)(Kt + (size_t)kt_beg * 2048 + s * 512 + lane * 8);
#pragma unroll
    for (int t = 0; t < 2; ++t)
#pragma unroll
        for (int s2 = 0; s2 < 2; ++s2) vfr[t][s2] = *(const bf16x8*)(Vt + (size_t)kt_beg * 2048 + (t * 2 + s2) * 512 + lane * 8);
    for (int kt = kt_beg; kt <= kt_end; ++kt) {
        const int ktn = (kt < kt_end) ? kt + 1 : kt_end;
        bf16x8 kn[4], vn[2][2];
#pragma unroll
        for (int s = 0; s < 4; ++s) kn[s] = *(const bf16x8*)(Kt + (size_t)ktn * 2048 + s * 512 + lane * 8);
#pragma unroll
        for (int t = 0; t < 2; ++t)
#pragma unroll
            for (int s2 = 0; s2 < 2; ++s2) vn[t][s2] = *(const bf16x8*)(Vt + (size_t)ktn * 2048 + (t * 2 + s2) * 512 + lane * 8);
#pragma unroll
        for (int q = 0; q < 2; ++q) {
            const int kq = kb + q;
            if (kt <= kq && kt + 4 >= kq) {
                f32x16 S;
#pragma unroll
                for (int i = 0; i < 16; ++i) S[i] = 0.f;
#pragma unroll
                for (int s = 0; s < 4; ++s) S = __builtin_amdgcn_mfma_f32_32x32x16_bf16(kf[s], qf[q][s], S, 0, 0, 0);
                const int jq = j0 + 32 * q;
                const bool full = (kt * 32 + 31 <= jq) && (kt * 32 + 128 >= jq + 31);
                if (!full) { const int qj = jq + c;
#pragma unroll
                    for (int i = 0; i < 16; ++i) { const int kj = kt * 32 + (i & 3) + 8 * (i >> 2) + 4 * hi; const bool valid = (kj <= qj) && (kj + 128 >= qj); S[i] = valid ? S[i] : -1e30f; } }
                float mx = S[0];
#pragma unroll
                for (int i = 1; i < 16; ++i) mx = fmaxf(mx, S[i]);
                mx = fmaxf(mx, __shfl_xor(mx, 32));
                const float mn = fmaxf(mrun[q], mx); const float alpha = __builtin_amdgcn_exp2f((mrun[q] - mn) * c2); mrun[q] = mn;
                float ps = 0.f;
#pragma unroll
                for (int i = 0; i < 16; ++i) { const float p = __builtin_amdgcn_exp2f((S[i] - mn) * c2); S[i] = p; ps += p; }
                l[q] = l[q] * alpha + ps;
#pragma unroll
                for (int t = 0; t < 2; ++t)
#pragma unroll
                    for (int i = 0; i < 16; ++i) O[q][t][i] *= alpha;
                bf16x8 pk[2];
#pragma unroll
                for (int s2 = 0; s2 < 2; ++s2) { v4u w; w.x = cvtpk(S[8 * s2 + 0], S[8 * s2 + 1]); w.y = cvtpk(S[8 * s2 + 2], S[8 * s2 + 3]); w.z = cvtpk(S[8 * s2 + 4], S[8 * s2 + 5]); w.w = cvtpk(S[8 * s2 + 6], S[8 * s2 + 7]); pk[s2] = __builtin_bit_cast(bf16x8, w); }
#pragma unroll
                for (int t = 0; t < 2; ++t)
#pragma unroll
                    for (int s2 = 0; s2 < 2; ++s2) O[q][t] = __builtin_amdgcn_mfma_f32_32x32x16_bf16(vfr[t][s2], pk[s2], O[q][t], 0, 0, 0);
            }
        }
#pragma unroll
        for (int s = 0; s < 4; ++s) kf[s] = kn[s];
#pragma unroll
        for (int t = 0; t < 2; ++t)
#pragma unroll
            for (int s2 = 0; s2 < 2; ++s2) vfr[t][s2] = vn[t][s2];
    }
#pragma unroll
    for (int q = 0; q < 2; ++q) { l[q] += __shfl_xor(l[q], 32); m_out[q] = mrun[q]; l_out[q] = l[q]; }
}

constexpr int SSM_LROW = 272;
template <bool PASSB>
__device__ __forceinline__ void ssm_wave(const unsigned char* ws, const float* dd, int b, int g, int segbase, int hstride, int nsp, LAS unsigned char* sb, int lane) {
    const int c = lane & 31, hi = lane >> 5;
    const f32x4 pa0 = *(const f32x4*)(ws + WS_SSMA + (size_t)(g * 64 + c) * 16), pa1 = *(const f32x4*)(ws + WS_SSMA + (size_t)(g * 64 + c + 32) * 16);
    bf16x8 bfr[4];
#pragma unroll
    for (int n = 0; n < 4; ++n) bfr[n] = *(const bf16x8*)(ws + WS_SSMB + ((size_t)((g * 4 + n) * 32 + c) * 16 + 8 * hi) * 2);
    const bf16* U = (const bf16*)(ws + WS_U);
    float s0r = 0.f, s0i = 0.f, s1r = 0.f, s1i = 0.f;
    f32x2* Eb = (f32x2*)(ws + WS_E) + (size_t)(b * 32 + g) * 64 * 64;
    if (PASSB) {
        const int seg = segbase + hstride * hi;
#pragma unroll 8
        for (int sq = 0; sq < seg; ++sq) { const f32x2 e0 = Eb[sq * 64 + c], e1 = Eb[sq * 64 + c + 32];
            const float n0r = pa0.z * s0r - pa0.w * s0i + e0.x, n0i = pa0.z * s0i + pa0.w * s0r + e0.y; s0r = n0r; s0i = n0i;
            const float n1r = pa1.z * s1r - pa1.w * s1i + e1.x, n1i = pa1.z * s1i + pa1.w * s1r + e1.y; s1r = n1r; s1i = n1i; }
    }
    bf16x8 cfr[4];
    if (PASSB) {
#pragma unroll
        for (int ks = 0; ks < 4; ++ks) cfr[ks] = *(const bf16x8*)(ws + WS_SSMC + ((size_t)(g * 16 + (lane & 15)) * 128 + 32 * ks + 8 * (lane >> 4)) * 2);
    }
    const int segsel = (c >> 2) & 1, toff = (c & 3) + 4 * (c >> 3);
    const float dsk = dd[g * 16 + (lane & 15)];
    for (int kp = 0; kp < nsp; ++kp) {
        if (!PASSB) { s0r = 0.f; s0i = 0.f; s1r = 0.f; s1i = 0.f; }
        const int seg0 = segbase + kp;
        const size_t tokA = (size_t)b * 8192 + (size_t)(seg0 + hstride * segsel) * 128 + toff;
        bf16x8 ufn = *(const bf16x8*)(U + tokA * 512 + g * 16 + 8 * hi);
        for (int blk = 0; blk < 8; ++blk) {
            const bf16x8 uf = ufn; { const int bn = (blk < 7) ? blk + 1 : 7; ufn = *(const bf16x8*)(U + (tokA + bn * 16) * 512 + g * 16 + 8 * hi); }
            bf16 uu[2][4];
            if (PASSB) {
#pragma unroll
                for (int ss = 0; ss < 2; ++ss)
#pragma unroll
                    for (int rg = 0; rg < 4; ++rg) uu[ss][rg] = U[((size_t)b * 8192 + (size_t)(seg0 + hstride * ss) * 128 + blk * 16 + (lane >> 4) * 4 + rg) * 512 + g * 16 + (lane & 15)];
            }
            f32x16 z;
#pragma unroll
            for (int i = 0; i < 16; ++i) z[i] = 0.f;
            const f32x16 BU0 = __builtin_amdgcn_mfma_f32_32x32x16_bf16(uf, bfr[0], z, 0, 0, 0), BU1 = __builtin_amdgcn_mfma_f32_32x32x16_bf16(uf, bfr[1], z, 0, 0, 0);
            const f32x16 BU2 = __builtin_amdgcn_mfma_f32_32x32x16_bf16(uf, bfr[2], z, 0, 0, 0), BU3 = __builtin_amdgcn_mfma_f32_32x32x16_bf16(uf, bfr[3], z, 0, 0, 0);
#pragma unroll
            for (int i = 0; i < 16; ++i) {
                const float n0r = pa0.x * s0r - pa0.y * s0i + BU0[i], n0i = pa0.x * s0i + pa0.y * s0r + BU1[i]; s0r = n0r; s0i = n0i;
                const float n1r = pa1.x * s1r - pa1.y * s1i + BU2[i], n1i = pa1.x * s1i + pa1.y * s1r + BU3[i]; s1r = n1r; s1i = n1i;
                if (PASSB) { LAS unsigned char* rowp = sb + (hi * 16 + i) * SSM_LROW + 4 * c;
                    *(LAS unsigned*)rowp = cvtpk(s0r, s0i); *(LAS unsigned*)(rowp + 128) = cvtpk(s1r, s1i); }
            }
            if (PASSB) {
                asm volatile("s_waitcnt lgkmcnt(0)" ::: "memory");
#pragma unroll
                for (int ss = 0; ss < 2; ++ss) {
                    pg8::f32x4 Y = {0.f, 0.f, 0.f, 0.f};
#pragma unroll
                    for (int ks = 0; ks < 4; ++ks) { const bf16x8 af = *(const LAS bf16x8*)(sb + (ss * 16 + (lane & 15)) * SSM_LROW + (32 * ks + 8 * (lane >> 4)) * 2);
                        Y = __builtin_amdgcn_mfma_f32_16x16x32_bf16(af, cfr[ks], Y, 0, 0, 0); }
#pragma unroll
                    for (int rg = 0; rg < 4; ++rg) { const size_t tok = (size_t)b * 8192 + (size_t)(seg0 + hstride * ss) * 128 + blk * 16 + (lane >> 4) * 4 + rg; const size_t o = tok * 512 + g * 16 + (lane & 15);
                        const float y = Y[rg] + dsk * bf2f(uu[ss][rg]);
                        const float zz = 0.7978845608028654f * (y + 0.044715f * y * y * y);
                        const float gl = y * __builtin_amdgcn_rcpf(1.f + __builtin_amdgcn_exp2f(-2.885390081777927f * zz));
                        ((bf16*)(ws + WS_YG))[o] = (bf16)(cvtpk(gl, 0.f) & 0xffffu); }
                }
                asm volatile("s_waitcnt lgkmcnt(0)" ::: "memory");
            }
        }
        if (!PASSB) { const int seg = seg0 + hstride * hi; Eb[seg * 64 + c] = (f32x2){s0r, s0i}; Eb[seg * 64 + c + 32] = (f32x2){s1r, s1i}; }
    }
}

#define RLX_AGENT __ATOMIC_RELAXED, __HIP_MEMORY_SCOPE_AGENT
#define XB_TMO      128
#define XB_XCNT(j)  (256  + 64 * (j))
#define XB_XSUB(j)  (1280 + 64 * (j))
#define XB_XGEN(j)  (2304 + 64 * (j))
#define XB_TOP      3328
#define XB_TOPGEN   3392
#define XCD_BAR_WORDS 3456
#define XB_SPIN_CAP (1u << 18)

__device__ __forceinline__ unsigned xb_ld(unsigned* p)              { return __hip_atomic_load(p, __ATOMIC_RELAXED, __HIP_MEMORY_SCOPE_AGENT); }
__device__ __forceinline__ unsigned xb_add(unsigned* p, unsigned v) { return __hip_atomic_fetch_add(p, v, __ATOMIC_RELAXED, __HIP_MEMORY_SCOPE_AGENT); }
__device__ __forceinline__ unsigned xb_xcc_id() { return (unsigned)__builtin_amdgcn_s_getreg((3 << 11) | 20) & 0xFu; }
#define XB_SPIN(cond, bar) do { unsigned _sp = 0; while (cond) { __builtin_amdgcn_s_sleep(1); \
    if ((++_sp & 255u) == 0u) { if (xb_ld(&(bar)[XB_TMO])) break; if (_sp > XB_SPIN_CAP) { atomicAdd(&(bar)[XB_TMO], 1u); break; } } } } while (0)

struct XcdBarrier {
    unsigned* bar; unsigned x;
    volatile LAS unsigned* st;
};

__device__ __forceinline__ XcdBarrier xcd_barrier_post(unsigned* bar, volatile LAS unsigned* st) {
    XcdBarrier b; b.bar = bar; b.x = xb_xcc_id(); b.st = st;
    if (threadIdx.x == 0) (void)xb_add(&bar[XB_XCNT(b.x)], 1u);
    return b;
}
__device__ __forceinline__ void xcd_barrier_complete(unsigned* bar, unsigned x, unsigned& nloc, unsigned& nx) {
    const unsigned G = gridDim.x * gridDim.y * gridDim.z;
    unsigned sum, cnt, mine, sp = 0u;
    for (;;) {
        sum = 0u; cnt = 0u; mine = 0u;
#pragma unroll
        for (unsigned j = 0; j < 16; ++j) { const unsigned c = xb_ld(&bar[XB_XCNT(j)]); sum += c; cnt += (c > 0u) ? 1u : 0u; mine = (j == x) ? c : mine; }
        if (sum == G) break;
        __builtin_amdgcn_s_sleep(1);
        if ((++sp & 255u) == 0u) { if (xb_ld(&bar[XB_TMO])) break; if (sp > XB_SPIN_CAP) { atomicAdd(&bar[XB_TMO], 1u); break; } }
    }
    nloc = mine > 0u ? mine : 1u; nx = cnt > 0u ? cnt : 1u;
}

__device__ __forceinline__ void xcd_barrier(const XcdBarrier& b) {
    asm volatile("s_waitcnt vmcnt(0)" ::: "memory");
    __syncthreads();
    if (threadIdx.x == 0) {
        unsigned* bar = b.bar;
        __builtin_amdgcn_s_waitcnt(0);
        unsigned nloc = b.st[0], nx = b.st[1];
        if (nloc == 0u) { xcd_barrier_complete(bar, b.x, nloc, nx); b.st[0] = nloc; b.st[1] = nx; }
        const unsigned old = xb_add(&bar[XB_XSUB(b.x)], 1u);
        const unsigned gen = old / nloc;
        if (old + 1u == (gen + 1u) * nloc) {
            __builtin_amdgcn_fence(__ATOMIC_RELEASE, "agent");
            asm volatile("s_waitcnt vmcnt(0)" ::: "memory");
            const unsigned og = xb_add(&bar[XB_TOP], 1u);
            const unsigned tg = og / nx;
            if (og + 1u == (tg + 1u) * nx) xb_add(&bar[XB_TOPGEN], 1u);
            else XB_SPIN(xb_ld(&bar[XB_TOPGEN]) == tg, bar);
            __builtin_amdgcn_fence(__ATOMIC_ACQUIRE, "agent");
            xb_add(&bar[XB_XGEN(b.x)], 1u);
            asm volatile("s_waitcnt vmcnt(0)" ::: "memory");
        } else {
            XB_SPIN(xb_ld(&bar[XB_XGEN(b.x)]) == gen, bar);
            __builtin_amdgcn_fence(__ATOMIC_ACQUIRE, "agent");
            asm volatile("s_waitcnt vmcnt(0)" ::: "memory");
        }
    }
    __syncthreads();
}

__global__ void __launch_bounds__(NWAVES * 64, 2) fwd_megakernel(Args args) {
    __shared__ __attribute__((aligned(16))) unsigned char lds_raw[LDS_BYTES];
    LAS unsigned char* lds = (LAS unsigned char*)lds_raw;
    const int tid = threadIdx.x, lane = tid & 63, wave = __builtin_amdgcn_readfirstlane(tid >> 6);
    const int G = gridDim.x; const int bx = blockIdx.x; const int vcu = (G % 8 == 0) ? (bx % 8) * (G / 8) + bx / 8 : bx;
    const int gw = vcu * NWAVES + wave, NGW = G * NWAVES;
    unsigned char* ws = args.ws;
    const int lo = args.ph_lo, hi_ph = args.ph_hi;
    volatile LAS unsigned* MISC = (volatile LAS unsigned*)(lds + 131072 + 320);
    if (tid < 32) MISC[tid] = 0u;
    __syncthreads();
    XcdBarrier bar; bar.bar = (unsigned*)ws; bar.x = 0; bar.st = nullptr;
    if (hi_ph - lo > 1) bar = xcd_barrier_post((unsigned*)ws, MISC + 8);
    if (lo == 0x7fffffff) cg::this_grid().sync();
#define IN(k) (lo <= (k) && (k) < hi_ph)
#define SEAM(k) do { if (IN(k) && IN((k) + 1)) { xcd_barrier(bar); } } while (0)

    if (IN(0)) {
        LAS float* scr = (LAS float*)(lds + wave * 16384);
        const float* w_in = args.in[4];
        constexpr int I0 = 16 * 64, I1 = 16 * 24, I2 = 16 * 112, I3 = 8 * 16, I4 = 8 * 32, I5 = 4 * 32, I6 = 16 * 32, I7 = 8 * 32, I8 = 16 * 32, I9 = 16 * 128, I10 = 64 * 32;
        constexpr int NITEMS = I0 + I1 + I2 + I3 + I4 + I5 + I6 + I7 + I8 + I9 + I10;
        for (int it = gw; it < NITEMS; it += NGW) {
            int r = it;
            if (r < I0) { p0_transpose_item(w_in, 6400, 0, 1024, 64, (bf16*)(ws + WS_WIN), 0, nullptr, scr, r, lane); continue; } r -= I0;
            if (r < I1) { p0_transpose_item(w_in, 6400, 2048, 1024, 24, (bf16*)(ws + WS_WV), 0, nullptr, scr, r, lane); continue; } r -= I1;
            if (r < I2) { p0_transpose_item(w_in, 6400, 2816, 1024, 112, (bf16*)(ws + WS_WIN), 2048, nullptr, scr, r, lane); continue; } r -= I2;
            if (r < I3) { p0_transpose_item(args.in[14], 512, 0, 512, 16, (bf16*)(ws + WS_WGLU), 0, nullptr, scr, r, lane); continue; } r -= I3;
            if (r < I4) { p0_transpose_item(args.in[16], 1024, 0, 512, 32, (bf16*)(ws + WS_WSSM), 0, nullptr, scr, r, lane); continue; } r -= I4;
            if (r < I5) { p0_transpose_item(args.in[17], 1024, 0, 256, 32, (bf16*)(ws + WS_WATT), 0, nullptr, scr, r, lane); continue; } r -= I5;
            if (r < I6) { p0_transpose_item(args.in[18], 1024, 0, 1024, 32, (bf16*)(ws + WS_WMKV), 0, nullptr, scr, r, lane); continue; } r -= I6;
            if (r < I7) { p0_transpose_item(args.in[19], 1024, 0, 512, 32, (bf16*)(ws + WS_WMEM), 0, nullptr, scr, r, lane); continue; } r -= I7;
            if (r < I8) { p0_transpose_item(args.in[20], 1024, 0, 1024, 32, (bf16*)(ws + WS_WO), 0, nullptr, scr, r, lane); continue; } r -= I8;
            if (r < I9) { p0_transpose_item(args.in[22], 4096, 0, 1024, 128, (bf16*)(ws + WS_WUP), 0, args.in[21], scr, r, lane); continue; } r -= I9;
            p0_transpose_item(args.in[23], 1024, 0, 4096, 32, (bf16*)(ws + WS_WDN), 0, nullptr, scr, r, lane);
        }
        for (int m = gw * 4; m < M; m += NGW * 4) rms_rows_to_bf16<4>(args.in[0] + (size_t)m * D, (size_t)D, args.in[2], (bf16*)(ws + WS_XN) + (size_t)m * D, lane, (float*)(ws + WS_XS) + m);
        for (int m = gw; m < 2048; m += NGW) rms_rows_to_bf16<1>(args.in[1] + (size_t)m * D, (size_t)D, args.in[3], (bf16*)(ws + WS_MEMN) + (size_t)m * D, lane, nullptr);
        { const int i = bx * 512 + tid;
          if (i < 2048) { const int g = i >> 6, p = i & 63;
            const double lr = (double)args.in[6][i], li = (double)args.in[7][i], dt = exp((double)args.in[8][g]);
            const double mag = exp(lr * dt); double sn, cs; sincos_d(li * dt, sn, cs);
            const double ar = mag * cs, aim = mag * sn, nr = ar - 1.0, ni = aim, den = lr * lr + li * li;
            const double cr = (nr * lr + ni * li) / den, ci = (ni * lr - nr * li) / den;
            double pr = ar, pi = aim;
#pragma unroll 1
            for (int k = 0; k < 7; ++k) { const double t = pr * pr - pi * pi; pi = 2.0 * pr * pi; pr = t; }
            *(f32x4*)(ws + WS_SSMA + (size_t)i * 16) = (f32x4){(float)ar, (float)aim, (float)pr, (float)pi};
            const int nt0 = (p >> 5) * 2, cc = p & 31;
            bf16* BM_ = (bf16*)(ws + WS_SSMB); bf16* CM_ = (bf16*)(ws + WS_SSMC);
#pragma unroll 1
            for (int h = 0; h < 16; ++h) { const double br = (double)args.in[9][(size_t)i * 16 + h], bi = (double)args.in[10][(size_t)i * 16 + h];
                const float bbr = (float)(cr * br - ci * bi), bbi = (float)(cr * bi + ci * br);
                BM_[((size_t)(g * 4 + nt0) * 32 + cc) * 16 + h] = (bf16)(cvtpk(bbr, 0.f) & 0xffffu);
                BM_[((size_t)(g * 4 + nt0 + 1) * 32 + cc) * 16 + h] = (bf16)(cvtpk(bbi, 0.f) & 0xffffu);
                const float c_r = args.in[11][((size_t)g * 16 + h) * 64 + p], c_i = args.in[12][((size_t)g * 16 + h) * 64 + p];
                CM_[((size_t)g * 16 + h) * 128 + 2 * p] = (bf16)(cvtpk(c_r, 0.f) & 0xffffu);
                CM_[((size_t)g * 16 + h) * 128 + 2 * p + 1] = (bf16)(cvtpk(-c_i, 0.f) & 0xffffu); }
          } }
    }
    SEAM(0);

    if (IN(1)) {
        __syncthreads();
        {
            pg8::Gemm g{(const bf16*)(ws + WS_MEMN), (const bf16*)(ws + WS_WMKV), 2048, 512, 1024, 1024, 1024, 0}; pg8::StaticOrder S; S.init(2048, 512, G, bx);
            pg8::EpiMKf E{(bf16*)(ws + WS_MK)}; pg8::gemm_phase(lds, g, S, E); }
        {
            pg8::Gemm g{(const bf16*)(ws + WS_WMKV) + (size_t)512 * 1024, (const bf16*)(ws + WS_MEMN), 512, 2048, 1024, 1024, 1024, 0}; pg8::StaticOrder S; S.init(512, 2048, G, (bx + G - 16) % G);
            pg8::EpiVTf E{(bf16*)(ws + WS_MVT), 1, 0}; pg8::gemm_phase(lds, g, S, E); }
        {
            pg8::Gemm g{(const bf16*)(ws + WS_XN), (const bf16*)(ws + WS_WIN), M, NIN, 1024, 1024, 1024, 0}; pg8::StaticOrder S; S.init(M, NIN, G, bx);
            pg8::EpiInProj E{(bf16*)(ws + WS_U), (bf16*)(ws + WS_Q), (bf16*)(ws + WS_K), (bf16*)(ws + WS_MQ), (bf16*)(ws + WS_GATES), args.in[5]}; pg8::gemm_phase(lds, g, S, E); }
#pragma unroll 1
        for (int gi = 0; gi < 3; ++gi) {
            const int d = 1 << (2 * gi);
            pg8::Gemm g{(const bf16*)(ws + WS_WV) + (size_t)gi * 256 * 1024, (const bf16*)(ws + WS_XN), 256, M, 1024, 1024, d * 1024, d}; pg8::StaticOrder S; S.init(256, M, G, bx);
            pg8::EpiVTf E{(bf16*)(ws + WS_VT), 0, gi}; pg8::gemm_phase(lds, g, S, E); }
    }
    SEAM(1);

    if (IN(2)) {
        for (int rep = 0; rep < PROBE_REP; ++rep)
        for (int it0 = gw; it0 < 12288; it0 += NGW) { const int it = 12287 - it0;
            const int qb = it & 127, rest = it >> 7, hh = rest & 3, b = (rest >> 2) & 7, g = rest >> 5;
            const int sh = 2 * g, d = 1 << sh, Ld = 8192 >> sh; const int pp0 = qb * 64, r = pp0 / Ld, j0 = pp0 % Ld;
            const size_t hb = ((size_t)(g * 8 + b) * 4 + hh) * 8192;
            const bf16* Qp = (const bf16*)(ws + WS_Q) + (hb + pp0) * 64;
            const bf16* Kt = (const bf16*)(ws + WS_K) + (hb + (size_t)r * Ld) * 64;
            const bf16* Vt = (const bf16*)(ws + WS_VT) + (hb + (size_t)r * Ld) * 64;
            f32x16 O[2][2]; float mr[2], l[2];
            sattn_wave(Qp, Kt, Vt, j0, lane, O, mr, l);
            const int c = lane & 31, hi = lane >> 5;
#pragma unroll
            for (int q = 0; q < 2; ++q) { const float inv = 1.f / l[q];
                const size_t tok = (size_t)b * 8192 + (size_t)(j0 + 32 * q + c) * d + r;
                bf16* og = (bf16*)(ws + WS_OG) + tok * 768 + g * 256 + hh * 64;
#pragma unroll
                for (int t = 0; t < 2; ++t)
#pragma unroll
                    for (int a = 0; a < 4; ++a) { v2u w; w.x = cvtpk(O[q][t][4 * a] * inv, O[q][t][4 * a + 1] * inv); w.y = cvtpk(O[q][t][4 * a + 2] * inv, O[q][t][4 * a + 3] * inv);
                        *(v2u*)(og + 32 * t + 8 * a + 4 * hi) = w; }
                if (hi == 0) ((float*)(ws + WS_LSE))[tok * 12 + g * 4 + hh] = mr[q] * 0.125f + __logf(l[q]); }
        }
        for (int it0 = gw; it0 < 8192; it0 += NGW) { const int it = 8191 - it0;
            const int qb = it & 255, h = (it >> 8) & 3, b = it >> 10;
            bf16* Qp = (bf16*)(ws + WS_MQ) + ((size_t)b * 8192 + qb * 32) * 512 + h * 128;
            const bf16* Kt = (const bf16*)(ws + WS_MK) + (size_t)(b * 4 + h) * 8 * 4096;
            const bf16* Vt = (const bf16*)(ws + WS_MVT) + (size_t)(b * 4 + h) * 8 * 4096;
            f32x16 O[4]; float mr, l;
            attn_wave<128, false>(Qp, 512, Kt, Vt, 0, 7, 0, lane, O, mr, l);
            const int c = lane & 31, hi = lane >> 5; const float inv = 1.f / l;
            bf16* om = Qp + (size_t)c * 512;
#pragma unroll
            for (int t = 0; t < 4; ++t)
#pragma unroll
                for (int a = 0; a < 4; ++a) { v2u w; w.x = cvtpk(O[t][4 * a] * inv, O[t][4 * a + 1] * inv); w.y = cvtpk(O[t][4 * a + 2] * inv, O[t][4 * a + 3] * inv);
                    *(v2u*)(om + 32 * t + 8 * a + 4 * hi) = w; }
        }
        for (int rep = 0; rep < PROBE_REP; ++rep)
        for (int it = gw; it < 8192; it += NGW) { const int sp = it & 31, g = (it >> 5) & 31, b = it >> 10; ssm_wave<false>(ws, args.in[13], b, g, 2 * sp, 1, 1, lds + wave * 16384, lane); }
    }
    SEAM(2);

    if (IN(3)) {
        for (int rep = 0; rep < PROBE_P3; ++rep)
        for (int it = gw; it < 2048; it += NGW) { const int qd = it & 7, g = (it >> 3) & 31, b = it >> 8;
            ssm_wave<true>(ws, args.in[13], b, g, 8 * qd, 4, 4, lds + wave * 16384, lane); }
        for (int m2 = gw; m2 < M / 2; m2 += NGW) { const size_t tok = (size_t)m2 * 2 + (lane >> 5); const int cc = (lane & 31) * 8, hh = cc >> 6;
            const float* ls = (const float*)(ws + WS_LSE) + tok * 12 + hh; const float l0 = ls[0], l1 = ls[4], l2 = ls[8];
            const float mx = fmaxf(l0, fmaxf(l1, l2)); const float e0 = __expf(l0 - mx), e1 = __expf(l1 - mx), e2 = __expf(l2 - mx); const float inv = 1.f / (e0 + e1 + e2);
            const bf16* og = (const bf16*)(ws + WS_OG) + tok * 768 + cc;
            pg8::f32x4 a0, a1, b0, b1, c0, c1; pg8::unpack8(*(const v4u*)og, a0, a1); pg8::unpack8(*(const v4u*)(og + 256), b0, b1); pg8::unpack8(*(const v4u*)(og + 512), c0, c1);
            const float w0 = e0 * inv, w1 = e1 * inv, w2 = e2 * inv;
            const pg8::f32x4 r0 = a0 * w0 + b0 * w1 + c0 * w2, r1 = a1 * w0 + b1 * w1 + c1 * w2;
            *(v4u*)((bf16*)(ws + WS_OMRG) + tok * 256 + cc) = pg8::pack8(r0, r1); }
    }
    SEAM(3);

    if (IN(4)) {
        __syncthreads();
        pg8::Gemm g{(const bf16*)(ws + WS_YG), (const bf16*)(ws + WS_WGLU), M, 512, 512, 512, 512, 0}; pg8::StaticOrder S; S.init(M, 512, G, bx);
        pg8::EpiGlu E{(const bf16*)(ws + WS_YG), (bf16*)(ws + WS_Y2), args.in[15]}; pg8::gemm_phase(lds, g, S, E);
    }
    SEAM(4);

    if (IN(5)) {
        __syncthreads();
        pg8::StaticOrder S; S.init(M, 1024, G, bx); pg8::StaticOrder SR; SR.init(M, 1024, G, bx, 0, 1);
        { pg8::Gemm g{(const bf16*)(ws + WS_Y2), (const bf16*)(ws + WS_WSSM), M, 1024, 512, 512, 512, 0};
          pg8::EpiBranch<0> E{(const bf16*)(ws + WS_GATES), (bf16*)(ws + WS_MG), 0}; pg8::gemm_phase(lds, g, S, E); }
        { pg8::Gemm g{(const bf16*)(ws + WS_OMRG), (const bf16*)(ws + WS_WATT), M, 1024, 256, 256, 256, 0};
          pg8::EpiBranch<1> E{(const bf16*)(ws + WS_GATES), (bf16*)(ws + WS_MG), 1024}; pg8::gemm_phase(lds, g, SR, E); }
        { pg8::Gemm g{(const bf16*)(ws + WS_MQ), (const bf16*)(ws + WS_WMEM), M, 1024, 512, 512, 512, 0};
          pg8::EpiBranch<1> E{(const bf16*)(ws + WS_GATES), (bf16*)(ws + WS_MG), 2048}; pg8::gemm_phase(lds, g, S, E); }
    }
    SEAM(5);

    if (IN(6)) {
        __syncthreads();
        pg8::Gemm g{(const bf16*)(ws + WS_MG), (const bf16*)(ws + WS_WO), M, 1024, 1024, 1024, 1024, 0}; pg8::StaticOrder S; S.init(M, 1024, G, bx);
        pg8::EpiResid<0> E{(const bf16*)(ws + WS_XN), (const float*)(ws + WS_XS), args.in[2], (bf16*)(ws + WS_HB), (float*)(ws + WS_SSP1)}; pg8::gemm_phase(lds, g, S, E);
    }
    SEAM(6);

    if (IN(7)) {
        __syncthreads();
        pg8::Gemm g{(const bf16*)(ws + WS_HB), (const bf16*)(ws + WS_WUP), M, FF, 1024, 1024, 1024, 0}; pg8::StaticOrder S; S.init(M, FF, G, bx);
        pg8::EpiUp E{(const float*)(ws + WS_SSP1), (bf16*)(ws + WS_ACT)};
        pg8::gemm_phase(lds, g, S, E);
        if (PROBE_G7 > 1) pg8::gemm_phase(lds, g, S, E);
    }
    SEAM(7);

    if (IN(8)) {
        __syncthreads();
        pg8::Gemm g{(const bf16*)(ws + WS_ACT), (const bf16*)(ws + WS_WDN), M, 1024, FF, FF, FF, 0}; pg8::StaticOrder S; S.init(M, 1024, G, bx, 1);
        pg8::EpiResid<1> E{nullptr, nullptr, nullptr, (bf16*)(ws + WS_HB), (float*)(ws + WS_SSP2)}; pg8::gemm_phase(lds, g, S, E);
    }
    SEAM(8);

    if (IN(9)) {
        const f32x4* gr = (const f32x4*)args.in[24];
        const int c8a = lane * 8, c8b = (lane + 64) * 8;
        const f32x4 ga0 = gr[c8a / 4], ga1 = gr[c8a / 4 + 1], gb0 = gr[c8b / 4], gb1 = gr[c8b / 4 + 1];
        for (int m = gw * 4; m < M; m += NGW * 4) {
            float pv[4]; v4u ha[4], hb4[4];
#pragma unroll
            for (int r = 0; r < 4; ++r) { pv[r] = (lane < 16) ? ((const float*)(ws + WS_SSP2))[(size_t)(m + r) * 16 + lane] : 0.f;
                const bf16* hr = (const bf16*)(ws + WS_HB) + (size_t)(m + r) * D; ha[r] = *(const v4u*)(hr + c8a); hb4[r] = *(const v4u*)(hr + c8b); }
#pragma unroll
            for (int r = 0; r < 4; ++r) { const float rs = 1.0f / sqrtf(wave_sum(pv[r]) * (1.f / 1024.f) + 1e-6f);
                f32x4* xr = (f32x4*)(args.out + (size_t)(m + r) * D); pg8::f32x4 v0, v1;
                pg8::unpack8(ha[r], v0, v1); xr[c8a / 4] = v0 * rs * ga0; xr[c8a / 4 + 1] = v1 * rs * ga1;
                pg8::unpack8(hb4[r], v0, v1); xr[c8b / 4] = v0 * rs * gb0; xr[c8b / 4 + 1] = v1 * rs * gb1; } }
    }
#undef IN
#undef SEAM
}

#ifndef DBG_PH
#define DBG_PH 0
#endif
struct DumpSeg { size_t off; unsigned n; unsigned pad; };
struct DumpArgs { float* out; const unsigned char* ws; DumpSeg s[6]; };
__global__ void dbg_dump(DumpArgs a) {
    size_t base = 0;
    float mag = 1e12f;
    for (int k = 0; k < 6; ++k, mag *= 0.1f) { const unsigned short* src = (const unsigned short*)(a.ws + a.s[k].off);
        for (size_t i = (size_t)blockIdx.x * blockDim.x + threadIdx.x; i < a.s[k].n; i += (size_t)gridDim.x * blockDim.x) a.out[base + i] = ((src[i] & 0x7f80u) == 0x7f80u) ? mag : 0.f;
        base += a.s[k].n; }
    for (size_t i = base + (size_t)blockIdx.x * blockDim.x + threadIdx.x; i < (size_t)M * D; i += (size_t)gridDim.x * blockDim.x) a.out[i] = 0.f;
}
extern "C" void kernel_launch(void* const* d_in, const int* in_sizes, int n_in, void* d_out, int out_size, void* d_ws, size_t ws_size, hipStream_t stream) {
    static int grid = 0;
    if (grid == 0) {
        if (n_in != 25 || out_size != M * D || ws_size < WS_END) { fprintf(stderr, "kernel_launch: unexpected shapes (n_in %d out %d ws %zu)\n", n_in, out_size, ws_size); grid = -1; return; }
        int dev = 0, cus = 0, per_cu = 0;
        if (hipGetDevice(&dev) != hipSuccess || hipDeviceGetAttribute(&cus, hipDeviceAttributeMultiprocessorCount, dev) != hipSuccess) { grid = -1; return; }
        if (hipOccupancyMaxActiveBlocksPerMultiprocessor(&per_cu, (const void*)fwd_megakernel, NWAVES * 64, 0) != hipSuccess || per_cu < 1) { fprintf(stderr, "kernel_launch: occupancy query says %d\n", per_cu); per_cu = 1; }
        (void)hipGetLastError();
        grid = cus;
    }
    if (grid < 0) return;
    Args a{};
    for (int i = 0; i < 25; ++i) a.in[i] = (const float*)d_in[i];
    a.out = (float*)d_out; a.ws = (unsigned char*)d_ws;
#if MK_N_LAUNCHES == 1
    if (hipMemsetAsync(d_ws, 0, 65536, stream) != hipSuccess) { fprintf(stderr, "kernel_launch: memset of the barrier words failed\n"); return; }
    a.ph_lo = 0; a.ph_hi = N_PHASES;
    void* kargs[] = {&a};
    hipError_t e = hipLaunchCooperativeKernel((const void*)fwd_megakernel, dim3(grid), dim3(NWAVES * 64), kargs, 0, stream);
    if (e != hipSuccess) fprintf(stderr, "kernel_launch: cooperative launch failed: %s (grid %d)\n", hipGetErrorString(e), grid);
#else
    const int np = DBG_PH ? DBG_PH + 1 : N_PHASES;
    for (int p = 0; p < np; ++p) { a.ph_lo = p; a.ph_hi = p + 1; hipLaunchKernelGGL(fwd_megakernel, dim3(grid), dim3(NWAVES * 64), 0, stream, a); }
#if DBG_PH && DBG_PH < 8
    { DumpArgs da{}; da.out = (float*)d_out; da.ws = (const unsigned char*)d_ws;
      DBG_SEGS
      hipLaunchKernelGGL(dbg_dump, dim3(2048), dim3(256), 0, stream, da); }
#endif
#endif
}
```
